# Optimizing an MI355X kernel written in HIP

```python
import math
import jax, jax.numpy as jnp
from jax import lax
import numpy as np

D_MODEL = 2048
BATCH = 8
SEQ = 4096
DEPTH = 2

N_HEADS = 16
HEAD_DIM = D_MODEL // N_HEADS
ROT_DIM = HEAD_DIM // 4
ROPE_THETA = 500000.0
NSA_KV_GROUPS = 4
NSA_CMP_LEN = 32
NSA_CMP_STRIDE = 16
NSA_CMP_HIDDEN = 2 * HEAD_DIM
NSA_SLC_LEN = 64
NSA_N_SEL = 16
NSA_WINDOW = 512
NSA_QBLOCK = 32
NSA_FORCE_BONUS = 1000.0
FOX_QBLOCK = 128
D_FF_DENSE = 5632
N_EXPERTS = 8
TOP_K = 2
D_FF_EXPERT = 7168
MOE_CHUNK = 128
RMS_EPS = 1e-6
NEG_INF = -1e30
N_NSA_LAYERS = (DEPTH + 1) // 2
N_FOX_LAYERS = DEPTH // 2
NSA_IN_DIM = N_HEADS * HEAD_DIM + 6 * NSA_KV_GROUPS * HEAD_DIM + 3 * N_HEADS
FOX_IN_DIM = 3 * N_HEADS * HEAD_DIM + N_HEADS

kernel_name = "hybrid_nsa_fox_moe_sandwich"


def rms_norm(x, g):
    xf = x.astype(jnp.float32)
    y = xf * lax.rsqrt(jnp.mean(xf * xf, axis=-1, keepdims=True) + RMS_EPS)
    return (y * g.astype(jnp.float32)).astype(x.dtype)


def masked_softmax(s, mask):
    s = jnp.where(mask, s, NEG_INF)
    m = jnp.max(s, axis=-1, keepdims=True)
    e = jnp.where(mask, jnp.exp(s - m), 0.0)
    return e / jnp.maximum(jnp.sum(e, axis=-1, keepdims=True), 1e-30)


def rotary_tables(S):
    pos = jnp.arange(S, dtype=jnp.float32)
    inv = ROPE_THETA ** (-jnp.arange(0, ROT_DIM, 2, dtype=jnp.float32) / ROT_DIM)
    ang = pos[:, None] * inv[None, :]
    return jnp.cos(ang), jnp.sin(ang)


def partial_rotary(x, cos, sin):
    half = ROT_DIM // 2
    c = cos[None, :, None, :].astype(x.dtype)
    s = sin[None, :, None, :].astype(x.dtype)
    x1 = x[..., :half]
    x2 = x[..., half:ROT_DIM]
    return jnp.concatenate([x1 * c - x2 * s, x2 * c + x1 * s, x[..., ROT_DIM:]], axis=-1)


def nsa_mixer(h, w_in, cmp_pos_k, cmp_pos_v, cmp_wk1, cmp_wk2, cmp_wv1, cmp_wv2, w_out):
    B, S, _ = h.shape
    H, G, dh = N_HEADS, NSA_KV_GROUPS, HEAD_DIM
    R = H // G
    L, STRIDE, LS, W, QB = NSA_CMP_LEN, NSA_CMP_STRIDE, NSA_SLC_LEN, NSA_WINDOW, NSA_QBLOCK
    q_dim, kv_dim = H * dh, G * dh
    proj = h @ w_in
    cuts = [int(c) for c in np.cumsum([q_dim] + [kv_dim] * 6)]
    q, kc, vc, ksl, vsl, kw, vw, g = jnp.split(proj, cuts, axis=-1)
    q = q.reshape(B, S, H, dh)
    kc, vc, ksl, vsl, kw, vw = [t.reshape(B, S, G, dh) for t in (kc, vc, ksl, vsl, kw, vw)]
    gates = jax.nn.sigmoid(g.astype(jnp.float32)).astype(h.dtype).reshape(B, S, 3, G, R)
    cos, sin = rotary_tables(S)
    q = partial_rotary(q, cos, sin)
    kc = partial_rotary(kc, cos, sin)
    ksl = partial_rotary(ksl, cos, sin)
    kw = partial_rotary(kw, cos, sin)
    scale = 1.0 / math.sqrt(dh)

    nc = (S - L) // STRIDE + 1
    cmp_start = jnp.arange(nc) * STRIDE
    cmp_end = cmp_start + L - 1
    blk_idx = cmp_start[:, None] + jnp.arange(L)[None, :]

    def compress(t, pos, w1, w2):
        tb = t[:, blk_idx] + pos[:, None, :]
        tb = tb.transpose(0, 1, 3, 2, 4).reshape(B, nc, G, L * dh)
        return jax.nn.gelu(tb @ w1) @ w2

    ck = compress(kc, cmp_pos_k, cmp_wk1, cmp_wk2)
    cv = compress(vc, cmp_pos_v, cmp_wv1, cmp_wv2)

    ns = S // LS
    slc_start = jnp.arange(ns) * LS
    overlap = ((cmp_start[:, None] < slc_start[None, :] + LS)
               & (cmp_end[:, None] >= slc_start[None, :])).astype(jnp.float32)
    k_blocks = ksl.reshape(B, ns, LS, G, dh).transpose(0, 3, 1, 2, 4)
    v_blocks = vsl.reshape(B, ns, LS, G, dh).transpose(0, 3, 1, 2, 4)
    n_sel = min(NSA_N_SEL, ns)
    b_ix = jnp.arange(B)[:, None, None, None]
    g_ix = jnp.arange(G)[None, :, None, None]
    blk_ids = jnp.arange(ns)

    kw_pad = jnp.pad(kw, ((0, 0), (W, 0), (0, 0), (0, 0)))
    vw_pad = jnp.pad(vw, ((0, 0), (W, 0), (0, 0), (0, 0)))

    def block(qb):
        t0 = qb * QB
        qpos = t0 + jnp.arange(QB)
        qblk = lax.dynamic_slice_in_dim(q, t0, QB, axis=1).reshape(B, QB, G, R, dh)
        gblk = lax.dynamic_slice_in_dim(gates, t0, QB, axis=1)

        s = jnp.einsum('bqgrd,bcgd->bgrqc', qblk, ck).astype(jnp.float32) * scale
        p_cmp = masked_softmax(s, cmp_end[None, :] <= qpos[:, None])
        o_cmp = jnp.einsum('bgrqc,bcgd->bqgrd', p_cmp.astype(cv.dtype), cv)

        imp = jnp.einsum('bgrqc,cn->bgqn', p_cmp, overlap)
        jq = (qpos // LS)[:, None]
        forced = (blk_ids == 0) | (blk_ids == jq) | (blk_ids == jq - 1)
        score = jnp.where(blk_ids <= jq, imp + forced * NSA_FORCE_BONUS, -1.0)
        _, sel = lax.top_k(score, n_sel)
        k_sel = k_blocks[b_ix, g_ix, sel].reshape(B, G, QB, n_sel * LS, dh)
        v_sel = v_blocks[b_ix, g_ix, sel].reshape(B, G, QB, n_sel * LS, dh)
        kpos = (sel[..., None] * LS + jnp.arange(LS)).reshape(B, G, QB, n_sel * LS)
        s = jnp.einsum('bqgrd,bgqmd->bgrqm', qblk, k_sel).astype(jnp.float32) * scale
        p = masked_softmax(s, (kpos <= qpos[:, None])[:, :, None])
        o_slc = jnp.einsum('bgrqm,bgqmd->bqgrd', p.astype(v_sel.dtype), v_sel)

        kwb = lax.dynamic_slice_in_dim(kw_pad, t0, QB + W, axis=1)
        vwb = lax.dynamic_slice_in_dim(vw_pad, t0, QB + W, axis=1)
        kpos_w = t0 - W + jnp.arange(QB + W)
        mask_w = ((kpos_w[None, :] <= qpos[:, None]) & (kpos_w[None, :] > qpos[:, None] - W)
                  & (kpos_w[None, :] >= 0))
        s = jnp.einsum('bqgrd,bkgd->bgrqk', qblk, kwb).astype(jnp.float32) * scale
        p = masked_softmax(s, mask_w)
        o_win = jnp.einsum('bgrqk,bkgd->bqgrd', p.astype(vwb.dtype), vwb)

        o = (gblk[:, :, 0, :, :, None] * o_cmp + gblk[:, :, 1, :, :, None] * o_slc
             + gblk[:, :, 2, :, :, None] * o_win)
        return o.reshape(B, QB, H * dh)

    out = lax.map(block, jnp.arange(S // QB))
    out = out.transpose(1, 0, 2, 3).reshape(B, S, H * dh)
    return out @ w_out


def fox_mixer(h, w_in, f_bias, w_out):
    B, S, _ = h.shape
    H, dh, QB = N_HEADS, HEAD_DIM, FOX_QBLOCK
    proj = h @ w_in
    q, k, v, fl = jnp.split(proj, [H * dh, 2 * H * dh, 3 * H * dh], axis=-1)
    q = q.reshape(B, S, H, dh)
    k = k.reshape(B, S, H, dh)
    v = v.reshape(B, S, H, dh)
    log_f = jax.nn.log_sigmoid(fl.astype(jnp.float32) + f_bias.astype(jnp.float32))
    c = jnp.cumsum(log_f, axis=1).transpose(0, 2, 1)
    kpos = jnp.arange(S)
    scale = 1.0 / math.sqrt(dh)

    def block(qb):
        t0 = qb * QB
        qpos = t0 + jnp.arange(QB)
        qblk = lax.dynamic_slice_in_dim(q, t0, QB, axis=1)
        cq = lax.dynamic_slice_in_dim(c, t0, QB, axis=2)
        s = (jnp.einsum('bqhd,bkhd->bhqk', qblk, k).astype(jnp.float32) * scale
             + cq[..., None] - c[:, :, None, :])
        p = masked_softmax(s, kpos[None, :] <= qpos[:, None])
        o = jnp.einsum('bhqk,bkhd->bqhd', p.astype(v.dtype), v)
        return o.reshape(B, QB, H * dh)

    out = lax.map(block, jnp.arange(S // QB))
    out = out.transpose(1, 0, 2, 3).reshape(B, S, H * dh)
    return out @ w_out


def swiglu(h, w_gate, w_up, w_down):
    return (jax.nn.silu(h @ w_gate) * (h @ w_up)) @ w_down


def moe_swiglu(h, w_router, w_gate, w_up, w_down):
    B, S, D = h.shape
    logits = (h @ w_router).astype(jnp.float32)
    top_val, top_idx = lax.top_k(logits, TOP_K)
    top_w = jax.nn.softmax(top_val, axis=-1)
    gate = jnp.sum(jax.nn.one_hot(top_idx, N_EXPERTS, dtype=jnp.float32) * top_w[..., None], axis=-2)
    nch = S // MOE_CHUNK
    xc = h.reshape(B, nch, MOE_CHUNK, D).transpose(1, 0, 2, 3)
    gc = gate.astype(h.dtype).reshape(B, nch, MOE_CHUNK, N_EXPERTS).transpose(1, 0, 2, 3)

    def chunk(args):
        xb, gb = args
        a = jnp.einsum('btd,edf->btef', xb, w_gate)
        u = jnp.einsum('btd,edf->btef', xb, w_up)
        return jnp.einsum('btef,efd->btd', jax.nn.silu(a) * u * gb[..., None], w_down)

    y = lax.map(chunk, (xc, gc))
    return y.transpose(1, 0, 2, 3).reshape(B, S, D)


def setup_inputs(seed: int = 0) -> dict:
    key = jax.random.key(seed)
    ks = jax.random.split(key, 24)
    f32 = jnp.float32
    D, dh = D_MODEL, HEAD_DIM
    na, nf = N_NSA_LAYERS, N_FOX_LAYERS

    def nrm(k, shape, scale):
        return jax.random.normal(k, shape, f32) * scale

    return {
        "x": nrm(ks[0], (BATCH, SEQ, D), 1.0),
        "ln_gains": 1.0 + nrm(ks[1], (DEPTH, 4, D), 0.05),
        "nsa_w_in": nrm(ks[2], (na, D, NSA_IN_DIM), D ** -0.5),
        "nsa_cmp_pos_k": nrm(ks[3], (na, NSA_CMP_LEN, dh), 0.1),
        "nsa_cmp_pos_v": nrm(ks[4], (na, NSA_CMP_LEN, dh), 0.1),
        "nsa_cmp_wk1": nrm(ks[5], (na, NSA_CMP_LEN * dh, NSA_CMP_HIDDEN), (NSA_CMP_LEN * dh) ** -0.5),
        "nsa_cmp_wk2": nrm(ks[6], (na, NSA_CMP_HIDDEN, dh), NSA_CMP_HIDDEN ** -0.5),
        "nsa_cmp_wv1": nrm(ks[7], (na, NSA_CMP_LEN * dh, NSA_CMP_HIDDEN), (NSA_CMP_LEN * dh) ** -0.5),
        "nsa_cmp_wv2": nrm(ks[8], (na, NSA_CMP_HIDDEN, dh), NSA_CMP_HIDDEN ** -0.5),
        "nsa_w_out": nrm(ks[9], (na, N_HEADS * dh, D), (N_HEADS * dh) ** -0.5),
        "fox_w_in": nrm(ks[10], (nf, D, FOX_IN_DIM), D ** -0.5),
        "fox_f_bias": jax.random.uniform(ks[11], (nf, N_HEADS), f32, 1.0, 4.0),
        "fox_w_out": nrm(ks[12], (nf, N_HEADS * dh, D), (N_HEADS * dh) ** -0.5),
        "ffn_w_gate": nrm(ks[13], (na, D, D_FF_DENSE), D ** -0.5),
        "ffn_w_up": nrm(ks[14], (na, D, D_FF_DENSE), D ** -0.5),
        "ffn_w_down": nrm(ks[15], (na, D_FF_DENSE, D), D_FF_DENSE ** -0.5),
        "moe_router": nrm(ks[16], (nf, D, N_EXPERTS), D ** -0.5),
        "moe_w_gate": nrm(ks[17], (nf, N_EXPERTS, D, D_FF_EXPERT), D ** -0.5),
        "moe_w_up": nrm(ks[18], (nf, N_EXPERTS, D, D_FF_EXPERT), D ** -0.5),
        "moe_w_down": nrm(ks[19], (nf, N_EXPERTS, D_FF_EXPERT, D), D_FF_EXPERT ** -0.5),
    }


def reference(x, ln_gains, nsa_w_in, nsa_cmp_pos_k, nsa_cmp_pos_v, nsa_cmp_wk1, nsa_cmp_wk2,
              nsa_cmp_wv1, nsa_cmp_wv2, nsa_w_out, fox_w_in, fox_f_bias, fox_w_out,
              ffn_w_gate, ffn_w_up, ffn_w_down, moe_router, moe_w_gate, moe_w_up, moe_w_down):
    for i in range(DEPTH):
        j = i // 2
        hn = rms_norm(x, ln_gains[i, 0])
        if i % 2 == 0:
            m = nsa_mixer(hn, nsa_w_in[j], nsa_cmp_pos_k[j], nsa_cmp_pos_v[j], nsa_cmp_wk1[j],
                          nsa_cmp_wk2[j], nsa_cmp_wv1[j], nsa_cmp_wv2[j], nsa_w_out[j])
        else:
            m = fox_mixer(hn, fox_w_in[j], fox_f_bias[j], fox_w_out[j])
        x = x + rms_norm(m, ln_gains[i, 1])
        hn = rms_norm(x, ln_gains[i, 2])
        if i % 2 == 0:
            f = swiglu(hn, ffn_w_gate[j], ffn_w_up[j], ffn_w_down[j])
        else:
            f = moe_swiglu(hn, moe_router[j], moe_w_gate[j], moe_w_up[j], moe_w_down[j])
        x = x + rms_norm(f, ln_gains[i, 3])
    return x
```

```cpp
#include <hip/hip_runtime.h>
#include <cstdio>
#include <cstdint>

#ifndef MK_N_LAUNCHES
#define MK_N_LAUNCHES 0
#endif

constexpr int NB = 8, SEQ = 4096, DM = 2048, MTOK = NB * SEQ;
constexpr int NH = 16, HD = 128, NG = 4;
constexpr int NSA_NV = 5168, NSA_N = 5376;
constexpr int FOX_NV = 6160, FOX_N = 6400;
constexpr int FFD = 5632, NE = 8, FFE = 7168;
constexpr float RMS_EPS = 1e-6f;

#define GAS __attribute__((address_space(1)))
#define LAS __attribute__((address_space(3)))
typedef unsigned short bf16;
typedef unsigned v4u __attribute__((ext_vector_type(4)));
typedef float f32x4 __attribute__((ext_vector_type(4)));
typedef short bf16x8 __attribute__((ext_vector_type(8)));
typedef GAS unsigned gu32;
typedef GAS unsigned long long gu64;
#define RLX_AGENT __ATOMIC_RELAXED, __HIP_MEMORY_SCOPE_AGENT
#define LDS_WAIT() asm volatile("s_waitcnt lgkmcnt(0)" ::: "memory")
#define VM_WAIT() asm volatile("s_waitcnt vmcnt(0)" ::: "memory")
__device__ __forceinline__ unsigned long long rt() { return __builtin_amdgcn_s_memrealtime(); }
__device__ __forceinline__ unsigned f2bf(float f) { unsigned u = __builtin_bit_cast(unsigned, f); return (u + 0x7fffu + ((u >> 16) & 1u)) >> 16; }
__device__ __forceinline__ unsigned pk2(float lo, float hi) { return f2bf(lo) | (f2bf(hi) << 16); }

#define XB_TMO      128
#define XB_XCNT(j)  (256  + 64 * (j))
#define XB_XSUB(j)  (1280 + 64 * (j))
#define XB_XGEN(j)  (2304 + 64 * (j))
#define XB_TOP      3328
#define XB_TOPGEN   3392
#define XCD_BAR_WORDS 3456
#define XB_SPIN_CAP (1u << 20)

__device__ __forceinline__ unsigned xb_ld(unsigned* p)              { return __hip_atomic_load(p, __ATOMIC_RELAXED, __HIP_MEMORY_SCOPE_AGENT); }
__device__ __forceinline__ unsigned xb_add(unsigned* p, unsigned v) { return __hip_atomic_fetch_add(p, v, __ATOMIC_RELAXED, __HIP_MEMORY_SCOPE_AGENT); }
__device__ __forceinline__ unsigned xb_xcc_id() { return (unsigned)__builtin_amdgcn_s_getreg((3 << 11) | 20) & 0xFu; }
#define XB_SPIN(cond, bar) do { unsigned _sp = 0; while (cond) { __builtin_amdgcn_s_sleep(1); \
    if ((++_sp & 255u) == 0u) { if (xb_ld(&(bar)[XB_TMO])) break; if (_sp > XB_SPIN_CAP) { atomicAdd(&(bar)[XB_TMO], 1u); break; } } } } while (0)

struct XcdBarrier {
    unsigned* bar; unsigned x;
    volatile LAS unsigned* st;
};

__device__ __forceinline__ XcdBarrier xcd_barrier_post(unsigned* bar, volatile LAS unsigned* st) {
    XcdBarrier b; b.bar = bar; b.x = xb_xcc_id(); b.st = st;
    if (threadIdx.x == 0) (void)xb_add(&bar[XB_XCNT(b.x)], 1u);
    return b;
}
__device__ __forceinline__ void xcd_barrier_complete(unsigned* bar, unsigned x, unsigned& nloc, unsigned& nx) {
    const unsigned G = gridDim.x * gridDim.y * gridDim.z;
    unsigned sum, cnt, mine, sp = 0u;
    for (;;) {
        sum = 0u; cnt = 0u; mine = 0u;
#pragma unroll
        for (unsigned j = 0; j < 16; ++j) { const unsigned c = xb_ld(&bar[XB_XCNT(j)]); sum += c; cnt += (c > 0u) ? 1u : 0u; mine = (j == x) ? c : mine; }
        if (sum == G) break;
        __builtin_amdgcn_s_sleep(1);
        if ((++sp & 255u) == 0u) { if (xb_ld(&bar[XB_TMO])) break; if (sp > XB_SPIN_CAP) { atomicAdd(&bar[XB_TMO], 1u); break; } }
    }
    nloc = mine > 0u ? mine : 1u; nx = cnt > 0u ? cnt : 1u;
}

__device__ __forceinline__ void xcd_barrier(const XcdBarrier& b) {
    asm volatile("s_waitcnt vmcnt(0)" ::: "memory");
    __syncthreads();
    if (threadIdx.x == 0) {
        unsigned* bar = b.bar;
        __builtin_amdgcn_s_waitcnt(0);
        unsigned nloc = b.st[0], nx = b.st[1];
        if (nloc == 0u) { xcd_barrier_complete(bar, b.x, nloc, nx); b.st[0] = nloc; b.st[1] = nx; }
        const unsigned old = xb_add(&bar[XB_XSUB(b.x)], 1u);
        const unsigned gen = old / nloc;
        if (old + 1u == (gen + 1u) * nloc) {
            __builtin_amdgcn_fence(__ATOMIC_RELEASE, "agent");
            asm volatile("s_waitcnt vmcnt(0)" ::: "memory");
            const unsigned og = xb_add(&bar[XB_TOP], 1u);
            const unsigned tg = og / nx;
            if (og + 1u == (tg + 1u) * nx) xb_add(&bar[XB_TOPGEN], 1u);
            else XB_SPIN(xb_ld(&bar[XB_TOPGEN]) == tg, bar);
            __builtin_amdgcn_fence(__ATOMIC_ACQUIRE, "agent");
            xb_add(&bar[XB_XGEN(b.x)], 1u);
            asm volatile("s_waitcnt vmcnt(0)" ::: "memory");
        } else {
            XB_SPIN(xb_ld(&bar[XB_XGEN(b.x)]) == gen, bar);
            __builtin_amdgcn_fence(__ATOMIC_ACQUIRE, "agent");
            asm volatile("s_waitcnt vmcnt(0)" ::: "memory");
        }
    }
    __syncthreads();
}


namespace pg8 {
#define PG8_LAS __attribute__((address_space(3)))
typedef unsigned short bf16_t;
typedef short bf16x8 __attribute__((ext_vector_type(8)));
typedef float f32x4 __attribute__((ext_vector_type(4)));
typedef unsigned u32x4 __attribute__((ext_vector_type(4)));
constexpr int BM = 256, BK = 64, HALF = 128, HTB = HALF * BK * 2  , STAGE_BYTES = 8 * HTB, NXCD = 8, WGM = 8;

__host__ __device__ __forceinline__ int lds_byte(int r, int c) { const int st = (r >> 4) * 2 + (c >> 5), rr = r & 15, cc = c & 31, ob = rr * 64 + cc * 2; return st * 1024 + (ob ^ (((ob >> 9) & 1) << 5)); }
__host__ __device__ __forceinline__ void stage_rc(int b, int& R, int& C) { const int st = b / 1024, sb = b % 1024, swz = sb ^ (((sb >> 9) & 1) << 5); R = (st >> 1) * 16 + swz / 64; C = (st & 1) * 32 + (swz % 64) / 2; }
__host__ __device__ __forceinline__ int perm32(int rho) { const int n = rho >> 4, i = rho & 15; return 8 * (i >> 2) + 4 * n + (i & 3); }

struct Unit { int pm, pn, pa, pb; };
struct Gemm { const bf16_t* A; const bf16_t* Bt; int M, N, K; };

struct StaticOrder {
    int nM, nN, nwg, G, c;
    __host__ __device__ void init(int M, int N, int G_, int c_) { nM = M / BM; nN = N / BM; nwg = nM * nN; G = G_; c = c_; }
    __host__ __device__ bool next(int i, Unit& u) const {
        const long L = (long)i * G + c; if (L >= nwg) return false;
        int wgid = (int)L; { const int q = nwg / NXCD, r = nwg % NXCD, xcd = wgid % NXCD, off = wgid / NXCD; wgid = (xcd < r ? xcd * (q + 1) : r * (q + 1) + (xcd - r) * q) + off; }
        const int nig = WGM * nN, gid = wgid / nig, fm = gid * WGM, gsz = (nM - fm) < WGM ? (nM - fm) : WGM;
        u.pm = fm + ((wgid % nig) % gsz); u.pn = (wgid % nig) / gsz; u.pa = u.pm; u.pb = u.pn; return true;
    }
    __device__ __forceinline__ void a_ready(const Unit&) const {}
    __device__ __forceinline__ void done(const Unit&) const {}
};

__device__ __forceinline__ unsigned cvt_pk_bf16(float lo, float hi) { unsigned r; asm volatile("v_cvt_pk_bf16_f32 %0, %1, %2" : "=v"(r) : "v"(lo), "v"(hi)); return r; }
typedef float f32x2 __attribute__((ext_vector_type(2)));
__device__ __forceinline__ u32x4 pack8_bf16(const f32x4 a, const f32x4 b) { u32x4 w; w.x = cvt_pk_bf16(a[0], a[1]); w.y = cvt_pk_bf16(a[2], a[3]); w.z = cvt_pk_bf16(b[0], b[1]); w.w = cvt_pk_bf16(b[2], b[3]); return w; }

struct EpiBf16Plain {
    static constexpr bool PERM = true, AFTER_DRAIN = false;
    bf16_t* O; int ldc;
    __device__ __forceinline__ void operator()(const f32x4 (&acc)[2][2][4][2], const Unit& u, int wr, int wc, int fr, int fq) const {
        const int row0 = u.pm * BM + wr * 64 + fr, col0 = u.pn * BM + wc * 32 + 8 * fq;
#pragma unroll
        for (int ai = 0; ai < 2; ++ai)
#pragma unroll
            for (int m = 0; m < 4; ++m) { bf16_t* rowp = O + (size_t)(row0 + ai * HALF + m * 16) * ldc + col0;
#pragma unroll
                for (int bj = 0; bj < 2; ++bj) *(u32x4*)(rowp + bj * HALF) = pack8_bf16(acc[ai][bj][m][0], acc[ai][bj][m][1]); }
    }
};
struct EpiF32Cmp {
    static constexpr bool PERM = false, AFTER_DRAIN = false;
    float* O; int ldc;
    __device__ __forceinline__ void operator()(const f32x4 (&acc)[2][2][4][2], const Unit& u, int wr, int wc, int fr, int fq) const {
        const int row0 = u.pm * BM + wr * 64 + fr, col0 = (u.pn & 1) * BM + wc * 32 + 4 * fq;
#pragma unroll
        for (int ai = 0; ai < 2; ++ai)
#pragma unroll
            for (int m = 0; m < 4; ++m) { float* rowp = O + (size_t)(row0 + ai * HALF + m * 16) * ldc + col0;
#pragma unroll
                for (int bj = 0; bj < 2; ++bj)
#pragma unroll
                    for (int n = 0; n < 2; ++n) *(f32x4*)(rowp + bj * HALF + n * 16) = acc[ai][bj][m][n]; }
    }
};
struct EpiSwiGLU {
    static constexpr bool PERM = true, AFTER_DRAIN = false;
    bf16_t* O; int ldc;
    __device__ __forceinline__ void operator()(const f32x4 (&acc)[2][2][4][2], const Unit& u, int wr, int wc, int fr, int fq) const {
        const int row0 = u.pm * BM + wr * 64 + fr, col0 = u.pn * HALF + wc * 32 + 8 * fq;
#pragma unroll
        for (int ai = 0; ai < 2; ++ai)
#pragma unroll
            for (int m = 0; m < 4; ++m) { f32x4 h[2];
#pragma unroll
                for (int n = 0; n < 2; ++n) { const f32x4 g = acc[ai][0][m][n], up = acc[ai][1][m][n];
#pragma unroll
                    for (int j = 0; j < 4; ++j) { const float e = __builtin_amdgcn_exp2f(-1.4426950408889634f * g[j]); h[n][j] = g[j] * __builtin_amdgcn_rcpf(1.0f + e) * up[j]; } }
                *(u32x4*)(O + (size_t)(row0 + ai * HALF + m * 16) * ldc + col0) = pack8_bf16(h[0], h[1]); }
    }
};
struct EpiNsaIn {
    static constexpr bool PERM = true, AFTER_DRAIN = false;
    bf16_t* Q; bf16_t* KV; float* gates; const float* cosT; const float* sinT;
    __device__ __forceinline__ void operator()(const f32x4 (&acc)[2][2][4][2], const Unit& u, int wr, int wc, int fr, int fq) const {
        const int pn = u.pn, row0 = u.pm * BM + wr * 64 + fr;
        if (pn == 20) {
            if (wc == 0 || (wc == 1 && fq < 2)) {
#pragma unroll
                for (int ai = 0; ai < 2; ++ai)
#pragma unroll
                    for (int m = 0; m < 4; ++m) { float* gp = gates + (size_t)(row0 + ai * HALF + m * 16) * 48 + wc * 32 + 8 * fq;
#pragma unroll
                        for (int n = 0; n < 2; ++n) { const f32x4 a = acc[ai][0][m][n]; f32x4 s;
#pragma unroll
                            for (int j = 0; j < 4; ++j) s[j] = __builtin_amdgcn_rcpf(1.0f + __builtin_amdgcn_exp2f(-1.4426950408889634f * a[j]));
                            *(f32x4*)(gp + 4 * n) = s; } }
            }
            return;
        }
        bf16_t* base; int ldc, colt; bool rot, chunk;
        if (pn < 8) { base = Q; ldc = DM; colt = pn * BM; rot = true; chunk = false; }
        else { const int sec = (pn - 8) >> 1; base = KV + (size_t)sec * ((size_t)MTOK * 512); ldc = 512; colt = (pn & 1) * BM; rot = (sec & 1) == 0; chunk = sec < 2; }
        const bool dorot = rot && wc == 0;
#pragma unroll
        for (int ai = 0; ai < 2; ++ai)
#pragma unroll
            for (int m = 0; m < 4; ++m) { const int row = row0 + ai * HALF + m * 16, pos = row & (SEQ - 1);
                f32x4 c0, c1, s0, s1;
                if (dorot) { const float* cp = cosT + pos * 16 + 8 * (fq & 1); const float* sp = sinT + pos * 16 + 8 * (fq & 1);
                    c0 = *(const f32x4*)cp; c1 = *(const f32x4*)(cp + 4); s0 = *(const f32x4*)sp; s1 = *(const f32x4*)(sp + 4); }
#pragma unroll
                for (int bj = 0; bj < 2; ++bj) { f32x4 v0 = acc[ai][bj][m][0], v1 = acc[ai][bj][m][1];
                    if (dorot) { f32x4 o0, o1;
#pragma unroll
                        for (int j = 0; j < 4; ++j) { o0[j] = __shfl_xor(v0[j], 32); o1[j] = __shfl_xor(v1[j], 32); }
                        if (fq < 2) { v0 = v0 * c0 - o0 * s0; v1 = v1 * c1 - o1 * s1; }
                        else        { v0 = v0 * c0 + o0 * s0; v1 = v1 * c1 + o1 * s1; } }
                    const int col = colt + bj * HALF + wc * 32 + 8 * fq;
                    size_t off;
                    if (!chunk) off = (size_t)row * ldc + col;
                    else { const int b = row >> 12, t = row & (SEQ - 1), g = col >> 7, d = col & 127; off = ((size_t)((b * 256 + (t >> 4)) * 4 + g) * 16 + (t & 15)) * 128 + d; }
                    *(u32x4*)(base + off) = pack8_bf16(v0, v1); } }
    }
};
struct EpiFoxIn {
    static constexpr bool PERM = true, AFTER_DRAIN = false;
    bf16_t* QKV; float* fl;
    __device__ __forceinline__ void operator()(const f32x4 (&acc)[2][2][4][2], const Unit& u, int wr, int wc, int fr, int fq) const {
        const int pn = u.pn, row0 = u.pm * BM + wr * 64 + fr;
        if (pn == 24) {
            if (wc == 0 && fq < 2) {
#pragma unroll
                for (int ai = 0; ai < 2; ++ai)
#pragma unroll
                    for (int m = 0; m < 4; ++m) { float* gp = fl + (size_t)(row0 + ai * HALF + m * 16) * 16 + 8 * fq;
                        *(f32x4*)gp = acc[ai][0][m][0]; *(f32x4*)(gp + 4) = acc[ai][0][m][1]; }
            }
            return;
        }
        bf16_t* base = QKV + (size_t)(pn >> 3) * ((size_t)MTOK * DM); const int col0 = (pn & 7) * BM + wc * 32 + 8 * fq;
#pragma unroll
        for (int ai = 0; ai < 2; ++ai)
#pragma unroll
            for (int m = 0; m < 4; ++m) { bf16_t* rowp = base + (size_t)(row0 + ai * HALF + m * 16) * DM + col0;
#pragma unroll
                for (int bj = 0; bj < 2; ++bj) *(u32x4*)(rowp + bj * HALF) = pack8_bf16(acc[ai][bj][m][0], acc[ai][bj][m][1]); }
    }
};
struct CmpOrder {
    int G, c;
    __device__ bool next(int i, Unit& u) const { const int L = i * G + c; if (L >= 128) return false; u.pa = L >> 1; u.pm = u.pa; u.pb = 2 * (u.pa >= 32) + (L & 1); u.pn = u.pb; return true; }
    __device__ __forceinline__ void a_ready(const Unit&) const {}
    __device__ __forceinline__ void done(const Unit&) const {}
};
template <bool DOWN> struct MoeOrder {
    int t0, nt, nN, G, c; int tb1, tb2, tb3, tb4, tb5, tb6, tb7;
    __device__ bool next(int i, Unit& u) const {
        const int nwg = nt * nN; const long L = (long)i * G + c; if (L >= nwg) return false;
        int wgid = (int)L; { const int q = nwg / NXCD, r = nwg % NXCD, xcd = wgid % NXCD, off = wgid / NXCD; wgid = (xcd < r ? xcd * (q + 1) : r * (q + 1) + (xcd - r) * q) + off; }
        const int nig = WGM * nN, gid = wgid / nig, fm = gid * WGM, gsz = (nt - fm) < WGM ? (nt - fm) : WGM;
        const int pl = fm + ((wgid % nig) % gsz), pn = (wgid % nig) / gsz, pg = t0 + pl;
        const int e = (pg >= tb1) + (pg >= tb2) + (pg >= tb3) + (pg >= tb4) + (pg >= tb5) + (pg >= tb6) + (pg >= tb7);
        u.pn = pn; u.pb = e * nN + pn;
        if (DOWN) { u.pa = pl; u.pm = pg; } else { u.pa = pg; u.pm = pl; }
        return true;
    }
    __device__ __forceinline__ void a_ready(const Unit&) const {}
    __device__ __forceinline__ void done(const Unit&) const {}
};

template <class Epi, class Sched, bool ALIGN_EPI = false, bool SP2 = false>
__device__ __forceinline__ void gemm_phase(PG8_LAS unsigned char* lds, const Gemm g, const Sched& S, const Epi& E) {
    const int tid = threadIdx.x, wid = __builtin_amdgcn_readfirstlane(tid >> 6), lane = tid & 63, wr = wid >> 2, wc = wid & 3, fr = lane & 15, fq = lane >> 4;
    const int K = g.K, nt = K / BK;
    unsigned voffA[2], voffB[2];
#pragma unroll
    for (int i = 0; i < 2; ++i) { int R, C; stage_rc(tid * 16 + i * 8192, R, C); const int Rb = Epi::PERM ? ((R & ~31) + perm32(R & 31)) : R;
        voffA[i] = (unsigned)(R * K + C) * 2u; voffB[i] = (unsigned)(Rb * K + C) * 2u; }
    const size_t kstep = (size_t)(BK * 2);
    const size_t hstep = (size_t)HALF * K * 2;
    const size_t tstep = 2 * hstep;
    const unsigned ldsw = (unsigned)wid * 1024u;
    const int aoff = lds_byte(wr * 64 + fr, fq * 8), boff = lds_byte(wc * 32 + fr, fq * 8);
#define PG8_SA(b, h) (((b) * 2 + (h)) * HTB)
#define PG8_SB(b, h) ((4 + (b) * 2 + (h)) * HTB)
#define PG8_STAGE(bufoff, gbase, voff) do { _Pragma("unroll") for (int _i = 0; _i < 2; ++_i) \
        __builtin_amdgcn_global_load_lds((const unsigned*)((const char*)(gbase) + (voff)[_i]), (PG8_LAS unsigned*)(lds + (bufoff) + ldsw + _i * 8192), 16, 0, 0); } while (0)
#define PG8_LDA(dst, b, h) do { _Pragma("unroll") for (int m = 0; m < 4; ++m) _Pragma("unroll") for (int k = 0; k < 2; ++k) dst[m][k] = *(const PG8_LAS bf16x8*)(lds + PG8_SA(b, h) + aoff + m * 2048 + k * 1024); } while (0)
#define PG8_LDB(dst, b, h) do { _Pragma("unroll") for (int n = 0; n < 2; ++n) _Pragma("unroll") for (int k = 0; k < 2; ++k) dst[n][k] = *(const PG8_LAS bf16x8*)(lds + PG8_SB(b, h) + boff + n * 2048 + k * 1024); } while (0)
#define PG8_MMA(ai, bj, At, Bt) do { __builtin_amdgcn_s_setprio(1); _Pragma("unroll") for (int m = 0; m < 4; ++m) _Pragma("unroll") for (int n = 0; n < 2; ++n) _Pragma("unroll") for (int k = 0; k < 2; ++k) \
        acc[ai][bj][m][n] = __builtin_amdgcn_mfma_f32_16x16x32_bf16(Bt[n][k], At[m][k], acc[ai][bj][m][n], 0, 0, 0); __builtin_amdgcn_s_setprio(0); } while (0)
#define PG8_WAIT_V(n) asm volatile("s_waitcnt vmcnt(" #n ")" ::: "memory")
#define PG8_WAIT_L(n) asm volatile("s_waitcnt lgkmcnt(" #n ")" ::: "memory")
#define PG8_BAR __builtin_amdgcn_s_barrier()
#define PG8_SCHED __builtin_amdgcn_sched_barrier(0)
    Unit cur, nxt; int ui = 0;
    if (!S.next(0, cur)) return;
    f32x4 acc[2][2][4][2];
#pragma unroll
    for (int a = 0; a < 2; ++a)
#pragma unroll
        for (int b = 0; b < 2; ++b)
#pragma unroll
            for (int m = 0; m < 4; ++m)
#pragma unroll
                for (int n = 0; n < 2; ++n) acc[a][b][m][n] = (f32x4){0.f, 0.f, 0.f, 0.f};
    bf16x8 At[4][2], B0[2][2], B1[2][2];
    const char* cA = (const char*)g.A + (size_t)cur.pa * tstep; const char* cB = (const char*)g.Bt + (size_t)cur.pb * tstep;
    S.a_ready(cur);
    if constexpr (SP2) {
        PG8_STAGE(PG8_SB(0, 0), cB, voffB); PG8_STAGE(PG8_SB(0, 1), cB + hstep, voffB); PG8_STAGE(PG8_SA(0, 0), cA, voffA); PG8_STAGE(PG8_SA(0, 1), cA + hstep, voffA);
        if (wr == 1) PG8_BAR;
        PG8_WAIT_V(2); PG8_BAR;
        PG8_STAGE(PG8_SB(1, 0), cB + kstep, voffB); PG8_STAGE(PG8_SA(1, 0), cA + kstep, voffA); PG8_STAGE(PG8_SB(1, 1), cB + hstep + kstep, voffB);
        PG8_WAIT_V(6); PG8_BAR;
    } else {
        PG8_STAGE(PG8_SB(0, 0), cB, voffB); PG8_STAGE(PG8_SA(0, 0), cA, voffA); PG8_STAGE(PG8_SB(0, 1), cB + hstep, voffB); PG8_STAGE(PG8_SA(0, 1), cA + hstep, voffA);
        if (wr == 1) PG8_BAR;
        PG8_WAIT_V(4); PG8_BAR;
        PG8_STAGE(PG8_SB(1, 0), cB + kstep, voffB); PG8_STAGE(PG8_SA(1, 0), cA + kstep, voffA); PG8_STAGE(PG8_SB(1, 1), cB + hstep + kstep, voffB);
        PG8_WAIT_V(6); PG8_BAR;
    }
    for (;;) {
        const bool has_next = S.next(ui + 1, nxt);
        const char* nA = has_next ? (const char*)g.A + (size_t)nxt.pa * tstep : cA; const char* nB = has_next ? (const char*)g.Bt + (size_t)nxt.pb * tstep : cB;
        for (int t = 0; t < nt; t += 2) {
            const bool last = (t == nt - 2);
            const char* a1 = cA + (size_t)(t + 1) * kstep;
            const char* a2 = last ? nA : cA + (size_t)(t + 2) * kstep; const char* b2 = last ? nB : cB + (size_t)(t + 2) * kstep;
            const char* a3 = a2 + kstep; const char* b3 = b2 + kstep;
            if (last && has_next) S.a_ready(nxt);
            if constexpr (SP2) {
            PG8_LDB(B0, 0, 0); PG8_LDB(B1, 0, 1); PG8_SCHED; PG8_LDA(At, 0, 0); PG8_STAGE(PG8_SA(1, 1), a1 + hstep, voffA);
            PG8_WAIT_V(8); PG8_WAIT_L(0); PG8_BAR; PG8_MMA(0, 0, At, B0); PG8_MMA(0, 1, At, B1); PG8_BAR; PG8_SCHED;
            PG8_LDA(At, 0, 1); PG8_STAGE(PG8_SB(0, 0), b2, voffB); PG8_STAGE(PG8_SB(0, 1), b2 + hstep, voffB); PG8_STAGE(PG8_SA(0, 0), a2, voffA);
            PG8_WAIT_V(8); PG8_WAIT_L(0); PG8_BAR; PG8_MMA(1, 0, At, B0); PG8_MMA(1, 1, At, B1); PG8_BAR; PG8_SCHED;
            PG8_LDB(B0, 1, 0); PG8_LDB(B1, 1, 1); PG8_SCHED; PG8_LDA(At, 1, 0); PG8_STAGE(PG8_SA(0, 1), a2 + hstep, voffA);
            PG8_WAIT_V(8); PG8_WAIT_L(0); PG8_BAR; PG8_MMA(0, 0, At, B0); PG8_MMA(0, 1, At, B1); PG8_BAR; PG8_SCHED;
            PG8_LDA(At, 1, 1); PG8_STAGE(PG8_SB(1, 0), b3, voffB); PG8_STAGE(PG8_SB(1, 1), b3 + hstep, voffB); PG8_STAGE(PG8_SA(1, 0), a3, voffA);
            PG8_WAIT_V(8); PG8_WAIT_L(0); PG8_BAR; PG8_MMA(1, 0, At, B0); PG8_MMA(1, 1, At, B1); PG8_BAR; PG8_SCHED;
            } else {
            PG8_LDB(B0, 0, 0); PG8_SCHED; PG8_LDA(At, 0, 0); PG8_STAGE(PG8_SA(1, 1), a1 + hstep, voffA);
            PG8_WAIT_L(8); PG8_BAR; PG8_WAIT_L(0); PG8_MMA(0, 0, At, B0); PG8_BAR; PG8_SCHED;
            PG8_LDB(B1, 0, 1); PG8_STAGE(PG8_SB(0, 0), b2, voffB);
            PG8_BAR; PG8_WAIT_L(0); PG8_MMA(0, 1, At, B1); PG8_BAR;
            PG8_LDA(At, 0, 1); PG8_STAGE(PG8_SA(0, 0), a2, voffA);
            PG8_BAR; PG8_WAIT_L(0); PG8_MMA(1, 0, At, B0); PG8_BAR; PG8_SCHED;
            PG8_STAGE(PG8_SB(0, 1), b2 + hstep, voffB);
            PG8_WAIT_V(6); PG8_BAR; PG8_MMA(1, 1, At, B1); PG8_BAR;
            PG8_LDB(B0, 1, 0); PG8_SCHED; PG8_LDA(At, 1, 0); PG8_STAGE(PG8_SA(0, 1), a2 + hstep, voffA);
            PG8_WAIT_L(8); PG8_BAR; PG8_WAIT_L(0); PG8_MMA(0, 0, At, B0); PG8_BAR; PG8_SCHED;
            PG8_LDB(B1, 1, 1); PG8_STAGE(PG8_SB(1, 0), b3, voffB);
            PG8_BAR; PG8_WAIT_L(0); PG8_MMA(0, 1, At, B1); PG8_BAR;
            PG8_LDA(At, 1, 1); PG8_STAGE(PG8_SA(1, 0), a3, voffA);
            PG8_BAR; PG8_WAIT_L(0); PG8_MMA(1, 0, At, B0); PG8_BAR; PG8_SCHED;
            PG8_STAGE(PG8_SB(1, 1), b3 + hstep, voffB);
            PG8_WAIT_V(6); PG8_BAR; PG8_MMA(1, 1, At, B1); PG8_BAR;
            }
        }
        if constexpr (ALIGN_EPI) { if (wr == 0) PG8_BAR; }
        if constexpr (!Epi::AFTER_DRAIN) { E(acc, cur, wr, wc, fr, fq); S.done(cur); }
        if (!has_next) break;
#pragma unroll
        for (int a = 0; a < 2; ++a)
#pragma unroll
            for (int b = 0; b < 2; ++b)
#pragma unroll
                for (int m = 0; m < 4; ++m)
#pragma unroll
                    for (int n = 0; n < 2; ++n) acc[a][b][m][n] = (f32x4){0.f, 0.f, 0.f, 0.f};
        cur = nxt; cA = nA; cB = nB; ++ui;
        if constexpr (ALIGN_EPI) { if (wr == 1) PG8_BAR; }
    }
    PG8_WAIT_V(0);
    if constexpr (!ALIGN_EPI) { if (wr == 0) PG8_BAR; }
    PG8_BAR;
    if constexpr (Epi::AFTER_DRAIN) { E.fused(acc, cur, wr, wc, fr, fq, lds, wid, lane); S.done(cur); }
#undef PG8_SA
#undef PG8_SB
#undef PG8_STAGE
#undef PG8_LDA
#undef PG8_LDB
#undef PG8_MMA
#undef PG8_WAIT_V
#undef PG8_WAIT_L
#undef PG8_BAR
#undef PG8_SCHED
}
}

namespace att {
typedef unsigned short bf16;
typedef short bf16x8 __attribute__((ext_vector_type(8)));
typedef short s16x4 __attribute__((ext_vector_type(4)));
typedef float f32x16 __attribute__((ext_vector_type(16)));
typedef float f32x4 __attribute__((ext_vector_type(4)));
typedef unsigned u32x4 __attribute__((ext_vector_type(4)));
constexpr int D = 128, NW = 8, QBLK = 32, KVBLK = 64, QB = NW * QBLK;
constexpr int SHM_V = KVBLK * D * 2, SHM_K = KVBLK * D * 2;
constexpr float SCALE = 0.08838834764831845f, THR = 8.f;
constexpr int WS_OFF = 2 * SHM_V + 2 * SHM_K, CB_OFF = WS_OFF + NW * 64 * 4, ATT_LDS = CB_OFF + 512;
enum { MODE_WIN = 0, MODE_SLC = 1, MODE_FOX = 2 };

#define KSWZ(row, colB) ((row) * 256 + ((colB) ^ (((row) & 7) << 4)))
#define SBAR() __builtin_amdgcn_sched_barrier(0)
__device__ __forceinline__ int v_st(int k, int c) { const int kk = (k & ~0xC) | ((k & 4) << 1) | ((k & 8) >> 1); return ((kk >> 3) * 4 + (c >> 5)) * 512 + ((kk & 7) * 32 + (c & 31)) * 2; }
__device__ __forceinline__ int v_rd_base(int lane) { return ((lane & 3) << 3) | (((lane >> 2) & 3) << 6) | (((lane >> 4) & 1) << 5) | (((lane >> 5) & 1) << 8); }
constexpr int v_rd_off(int d0, int ks, int half) { return d0 * 512 + ks * 4096 + half * 2048; }
__device__ __forceinline__ int crow(int r, int hi) { return (r & 3) + 8 * (r >> 2) + 4 * hi; }
__device__ __forceinline__ unsigned cvtpk(float lo, float hi) { unsigned r; asm volatile("v_cvt_pk_bf16_f32 %0, %1, %2" : "=v"(r) : "v"(lo), "v"(hi)); return r; }
__device__ __forceinline__ bf16x8 load8(const bf16* p) { return *reinterpret_cast<const bf16x8*>(p); }
__device__ __forceinline__ float bf_lo(unsigned w) { return __uint_as_float(w << 16); }
__device__ __forceinline__ float bf_hi(unsigned w) { return __uint_as_float(w & 0xffff0000u); }
__device__ __forceinline__ void mask_tile(f32x16& p0, f32x16& p1, int dq, unsigned W) {
    const float NEG = -__builtin_inff();
#pragma unroll
    for (int r = 0; r < 16; ++r) {
        const int c = (r & 3) + 8 * (r >> 2);
        if ((unsigned)(dq - c) >= W) p0[r] = NEG;
        if ((unsigned)(dq - c - 32) >= W) p1[r] = NEG;
    }
}
template <bool RS>
__device__ __forceinline__ void partialSM(f32x16& p0, f32x16& p1, float& m_reg, float& mn, float& alpha, bool sel) {
    float pmax = p0[0]; for (int r = 1; r < 16; ++r) pmax = fmaxf(pmax, p0[r]); for (int r = 0; r < 16; ++r) pmax = fmaxf(pmax, p1[r]);
    { auto rr = __builtin_amdgcn_permlane32_swap(__float_as_uint(pmax), __float_as_uint(pmax), false, false);
      pmax = fmaxf(__uint_as_float(rr[0]), __uint_as_float(rr[1])); }
    if (RS) pmax = sel ? pmax : -__builtin_inff();
    constexpr float C2 = 1.4426950408889634f * SCALE;
    if (__builtin_expect(__all((pmax - m_reg) * SCALE <= THR), 1)) { mn = m_reg; alpha = 1.f; }
    else { mn = fmaxf(m_reg, pmax); alpha = __builtin_amdgcn_exp2f((m_reg - mn) * C2); m_reg = mn; }
    float mnL = -mn * C2;
    if (RS) mnL = sel ? mnL : -__builtin_inff();
    for (int r = 0; r < 16; ++r) p0[r] = fmaf(p0[r], C2, mnL); for (int r = 0; r < 16; ++r) p1[r] = fmaf(p1[r], C2, mnL);
    for (int r = 0; r < 16; ++r) p0[r] = __builtin_amdgcn_exp2f(p0[r]);
}
#define ATT_PK4(P, B_, OUT) do { unsigned a0 = cvtpk(P[B_+0], P[B_+1]), a1 = cvtpk(P[B_+2], P[B_+3]);                          \
        unsigned b0 = cvtpk(P[B_+4], P[B_+5]), b1 = cvtpk(P[B_+6], P[B_+7]);                                             \
        auto r0 = __builtin_amdgcn_permlane32_swap(a0, b0, false, false); auto r1 = __builtin_amdgcn_permlane32_swap(a1, b1, false, false); \
        u32x4 w = {r0[0], r1[0], r0[1], r1[1]}; OUT = *reinterpret_cast<bf16x8*>(&w); } while (0)
__device__ __forceinline__ void finishSM(f32x16& p0, f32x16& p1, float alpha, float& l_reg, bf16x8& pa0, bf16x8& pa1, bf16x8& pa2, bf16x8& pa3) {
    for (int r = 0; r < 16; ++r) p1[r] = __builtin_amdgcn_exp2f(p1[r]);
    float ps = 0; for (int r = 0; r < 16; ++r) ps += p0[r]; for (int r = 0; r < 16; ++r) ps += p1[r];
    { auto rr = __builtin_amdgcn_permlane32_swap(__float_as_uint(ps), __float_as_uint(ps), false, false);
      ps = __uint_as_float(rr[0]) + __uint_as_float(rr[1]); }
    l_reg = l_reg * alpha + ps;
    ATT_PK4(p0, 0, pa0); ATT_PK4(p0, 8, pa1); ATT_PK4(p1, 0, pa2); ATT_PK4(p1, 8, pa3);
}
template <int KB, int MODE>
__device__ __forceinline__ void qkt(f32x16& p0, f32x16& p1, const char* K_lds, const char* C_lds, int r32, int hi, const bf16x8* qr, float cq) {
    if (MODE == MODE_FOX) {
        const char* cb = C_lds + KB * 256 + hi * 16;
#pragma unroll
        for (int i = 0; i < 4; ++i) { const f32x4 a = *reinterpret_cast<const f32x4*>(cb + i * 32); const f32x4 b = *reinterpret_cast<const f32x4*>(cb + 128 + i * 32);
#pragma unroll
            for (int j = 0; j < 4; ++j) { p0[4 * i + j] = cq - a[j]; p1[4 * i + j] = cq - b[j]; } }
    } else { p0 = f32x16{}; p1 = f32x16{}; }
    const char* kb[4];
#pragma unroll
    for (int dd = 0; dd < 4; ++dd) kb[dd] = K_lds + KB * SHM_K + KSWZ(r32, (dd * 16 + hi * 8) * 2);
#pragma unroll
    for (int d0 = 0; d0 < 8; ++d0) { const char* a = kb[d0 & 3] + (d0 >> 2) * 128;
        bf16x8 b0 = *reinterpret_cast<const bf16x8*>(a);
        bf16x8 b1 = *reinterpret_cast<const bf16x8*>(a + 32 * 256);
        p0 = __builtin_amdgcn_mfma_f32_32x32x16_bf16(b0, qr[d0], p0, 0, 0, 0);
        p1 = __builtin_amdgcn_mfma_f32_32x32x16_bf16(b1, qr[d0], p1, 0, 0, 0); }
}
template <int VB>
__device__ __forceinline__ void pv_tile(f32x16* o, int vb0, bf16x8 pa0, bf16x8 pa1, bf16x8 pa2, bf16x8 pa3) {
#define TRRD(dst, off) asm volatile("ds_read_b64_tr_b16 %0, %1 offset:%2" : "=&v"(dst) : "v"(vb0), "i"(off) : "memory")
#define PV_D0(d0) do { s16x4 l0, l1, l2, l3, h0, h1, h2, h3; constexpr int b_ = VB * SHM_V + v_rd_off(d0, 0, 0);   \
        TRRD(l0, b_); TRRD(h0, b_ + 2048); TRRD(l1, b_ + 4096); TRRD(h1, b_ + 6144); TRRD(l2, b_ + 8192); TRRD(h2, b_ + 10240); TRRD(l3, b_ + 12288); TRRD(h3, b_ + 14336); \
        asm volatile("s_waitcnt lgkmcnt(0)" ::: "memory"); SBAR();   \
        o[d0] = __builtin_amdgcn_mfma_f32_32x32x16_bf16(pa0, (bf16x8){l0[0], l0[1], l0[2], l0[3], h0[0], h0[1], h0[2], h0[3]}, o[d0], 0, 0, 0);   \
        o[d0] = __builtin_amdgcn_mfma_f32_32x32x16_bf16(pa1, (bf16x8){l1[0], l1[1], l1[2], l1[3], h1[0], h1[1], h1[2], h1[3]}, o[d0], 0, 0, 0);   \
        o[d0] = __builtin_amdgcn_mfma_f32_32x32x16_bf16(pa2, (bf16x8){l2[0], l2[1], l2[2], l2[3], h2[0], h2[1], h2[2], h2[3]}, o[d0], 0, 0, 0);   \
        o[d0] = __builtin_amdgcn_mfma_f32_32x32x16_bf16(pa3, (bf16x8){l3[0], l3[1], l3[2], l3[3], h3[0], h3[1], h3[2], h3[3]}, o[d0], 0, 0, 0); } while (0)
    PV_D0(0); PV_D0(1); PV_D0(2); PV_D0(3);
#undef PV_D0
#undef TRRD
}

struct BlockRef { const bf16* Q; const bf16* K; const bf16* V; bf16* O; int P0; const float* aux; const unsigned long long* selm; };
struct Seam { bf16x8 qr[8]; bf16x8 st_v0, st_v1, st_k0, st_k1; float st_c; };
__device__ __forceinline__ int swa_jlo(int P0, int W) { const int lowk = P0 - W + 1; return lowk > 0 ? lowk / KVBLK : 0; }
#define ROW(p, k0, rr) ((p) + (unsigned)(((k0) + (rr)) * KS + sc))
#define VMW() asm volatile("s_waitcnt vmcnt(0)" ::: "memory")
#define VMWN(n) asm volatile("s_waitcnt vmcnt(%0)" :: "i"(n) : "memory")
#define SLOAD_H(Kp, Vp, Cp, k0) do { S.st_v0 = load8(ROW(Vp, k0, sr)); S.st_v1 = load8(ROW(Vp, k0, 32 + sr));              \
                         S.st_k0 = load8(ROW(Kp, k0, sr)); S.st_k1 = load8(ROW(Kp, k0, 32 + sr));                           \
                         if (MODE == MODE_FOX) { if (tid < 64) S.st_c = (Cp)[(k0) + tid]; } } while (0)
#define SWRITE_HK(bf) do { *(bf16x8*)(K_lds + (bf) * SHM_K + kws) = S.st_k0; *(bf16x8*)(K_lds + (bf) * SHM_K + kws + 32 * 256) = S.st_k1;   \
                         if (MODE == MODE_FOX) { if (tid < 64) *reinterpret_cast<float*>(C_lds + (bf) * 256 + tid * 4) = S.st_c; } } while (0)
#define SWRITE_HV(bf) do { *(bf16x8*)(V_lds + (bf) * SHM_V + vst0) = S.st_v0; *(bf16x8*)(V_lds + (bf) * SHM_V + vst1) = S.st_v1; } while (0)
#define SWRITE_H(bf) do { SWRITE_HV(bf); SWRITE_HK(bf); } while (0)
template <int MODE, int QS, int KS>
__device__ __forceinline__ void att_prime(const BlockRef& cur, int W, char* lds, Seam& S) {
    const int tid = threadIdx.x, wid = __builtin_amdgcn_readfirstlane(tid >> 6), lane = tid & 63, r32 = lane & 31, hi = lane >> 5;
    const int sr = tid >> 4, sc = (tid & 15) * 8, kws = KSWZ(sr, sc * 2); char* K_lds = lds + 2 * SHM_V; char* C_lds = lds + CB_OFF;
    const int kb0 = swa_jlo(cur.P0, W) * KVBLK;
#pragma unroll
    for (int d0 = 0; d0 < 8; ++d0) S.qr[d0] = load8(cur.Q + (unsigned)((wid * QBLK + r32) * QS + d0 * 16 + hi * 8));
    SLOAD_H(cur.K, cur.V, cur.aux, kb0); VMW(); SWRITE_HK(0);
    __syncthreads();
}
template <int MODE, int QS, int KS, int OS, bool ACCUM>
__device__ __forceinline__ void att_block(const BlockRef& cur, const BlockRef& nxt, int skv, int W, char* lds, Seam& S) {
    constexpr bool RS = MODE == MODE_SLC;
    const int tid = threadIdx.x, wid = __builtin_amdgcn_readfirstlane(tid >> 6), lane = tid & 63, r32 = lane & 31, hi = lane >> 5;
    const int j_lo = swa_jlo(cur.P0, W);
    int j_hi = (cur.P0 + QB - 1) / KVBLK + 1; if (j_hi > skv / KVBLK) j_hi = skv / KVBLK;
    const int NT = j_hi - j_lo;
    const int kbn = swa_jlo(nxt.P0, W) * KVBLK;
    const int qlo = cur.P0 + wid * QBLK, qm = qlo + r32 - 4 * hi;
    char* V_lds = lds; char* K_lds = lds + 2 * SHM_V; char* C_lds = lds + CB_OFF;
    float* ws = (float*)(lds + WS_OFF) + wid * 64; float* li_l = ws, * al_l = ws + 32;
    float m_reg = -1e30f, l_reg = 0; f32x16 o[4] = {};
    const int sr = tid >> 4, sc = (tid & 15) * 8, vst0 = v_st(sr, sc), vst1 = v_st(32 + sr, sc), kws = KSWZ(sr, sc * 2);
    const int vb0 = (int)(uintptr_t)V_lds + v_rd_base(lane);
    const bf16* Kh = cur.K; const bf16* Vh = cur.V; const float* Ch = cur.aux;
    float cq = 0.f, gate = 1.f; unsigned long long rmask = ~0ull;
    if (MODE == MODE_FOX) cq = cur.aux[qlo + r32]; else gate = cur.aux[(unsigned)((wid * QBLK + r32) * 48)];
    if (MODE == MODE_SLC) rmask = cur.selm[wid * QBLK + r32];
#define RESC(a) do { if (__any((a) < 1.f)) { if (hi == 0) al_l[r32] = (a); asm volatile("s_waitcnt lgkmcnt(0)" ::: "memory");              \
                     for (int d_ = 0; d_ < 4; ++d_) for (int r = 0; r < 16; ++r) o[d_][r] *= al_l[crow(r, hi)]; } } while (0)
#define KBASE(t) ((j_lo + (t)) * KVBLK)
#define SEL(t) (((rmask >> (j_lo + (t))) & 1ull) != 0ull)
#define MASKT(P0_, P1_, t) do { const int kb_ = KBASE(t); if (kb_ + KVBLK - 1 > qlo || kb_ <= qlo + QBLK - 1 - W) mask_tile(P0_, P1_, qm - kb_, (unsigned)W); } while (0)
#define SEAM_K0() do { VMWN(8); SWRITE_HK(0); SBAR(); } while (0)
    f32x16 pA0, pA1, pB0, pB1; float mnA, mnB, alA, alB; bf16x8 pa0, pa1, pa2, pa3;
    SWRITE_HV(0); SBAR();
    if (NT > 1) SLOAD_H(Kh, Vh, Ch, KBASE(1));
    SBAR(); qkt<0, MODE>(pA0, pA1, K_lds, C_lds, r32, hi, S.qr, cq);
    MASKT(pA0, pA1, 0); partialSM<RS>(pA0, pA1, m_reg, mnA, alA, SEL(0));
    if (NT > 1) { VMW(); SWRITE_H(1); }
    __syncthreads();
#define HALF_STEP(PX0, PX1, mnX, alX, PY0, PY1, alY, t, KB, VB, SB) do {                                                      \
        SBAR(); qkt<KB, MODE>(PX0, PX1, K_lds, C_lds, r32, hi, S.qr, cq);                                                     \
        finishSM(PY0, PY1, alY, l_reg, pa0, pa1, pa2, pa3); SBAR();                                                           \
        if ((t) + 1 < NT) { SLOAD_H(Kh, Vh, Ch, KBASE((t) + 1)); SBAR(); }                                                    \
        pv_tile<VB>(o, vb0, pa0, pa1, pa2, pa3); MASKT(PX0, PX1, (t)); partialSM<RS>(PX0, PX1, m_reg, mnX, alX, SEL(t));      \
        __syncthreads();                                                                                                      \
        if ((t) + 1 < NT) { VMW(); SWRITE_H(SB); }                                                                            \
        RESC(alX); __syncthreads(); } while (0)
    for (int t = 1; t + 1 < NT; t += 2) {
        HALF_STEP(pB0, pB1, mnB, alB, pA0, pA1, alA, t, 1, 0, 0);
        HALF_STEP(pA0, pA1, mnA, alA, pB0, pB1, alB, t + 1, 0, 1, 1);
    }
    const bool even = (NT & 1) == 0;
    if (even) { SBAR(); qkt<1, MODE>(pB0, pB1, K_lds, C_lds, r32, hi, S.qr, cq); SBAR(); }
    SLOAD_H(nxt.K, nxt.V, nxt.aux, kbn); SBAR();
#pragma unroll
    for (int d0 = 0; d0 < 8; ++d0) S.qr[d0] = load8(nxt.Q + (unsigned)((wid * QBLK + r32) * QS + d0 * 16 + hi * 8));
    SBAR();
    finishSM(pA0, pA1, alA, l_reg, pa0, pa1, pa2, pa3); SBAR();
    pv_tile<0>(o, vb0, pa0, pa1, pa2, pa3);
    if (even) { MASKT(pB0, pB1, NT - 1); partialSM<RS>(pB0, pB1, m_reg, mnB, alB, SEL(NT - 1)); __syncthreads(); RESC(alB);
        finishSM(pB0, pB1, alB, l_reg, pa0, pa1, pa2, pa3); SBAR(); pv_tile<1>(o, vb0, pa0, pa1, pa2, pa3); }
    SBAR(); SEAM_K0();
    if (hi == 0) li_l[r32] = gate / l_reg; asm volatile("s_waitcnt lgkmcnt(0)" ::: "memory");
    float rli[16];
#pragma unroll
    for (int r = 0; r < 16; ++r) rli[r] = li_l[crow(r, hi)];
    bf16* Ow = cur.O + (unsigned)(wid * QBLK * OS);
#pragma unroll
    for (int r = 0; r < 16; ++r) { const int orow = crow(r, hi);
#pragma unroll
        for (int d0 = 0; d0 < 4; ++d0) { float v = o[d0][r] * rli[r]; float vn = __shfl_xor(v, 1);
            if ((r32 & 1) == 0) { unsigned* ap = (unsigned*)(Ow + (unsigned)(orow * OS + d0 * 32 + r32));
                if (ACCUM) { const unsigned old = *ap; v += bf_lo(old); vn += bf_hi(old); }
                *ap = cvtpk(v, vn); } } }
    __syncthreads();
#undef RESC
#undef KBASE
#undef SEL
#undef MASKT
#undef SEAM_K0
#undef HALF_STEP
}
#undef ROW
#undef VMWN
#undef SLOAD_H
#undef SWRITE_HK
#undef SWRITE_HV
#undef SWRITE_H

struct AttnPtrs { const bf16* Q; const bf16* K; const bf16* V; bf16* O; const float* aux; const unsigned long long* selm; };
template <int MODE, int KS>
__device__ __forceinline__ BlockRef att_ref(const AttnPtrs& P, int b, int h, int qb) {
    BlockRef r; const size_t row0 = (size_t)b * SEQ + (size_t)qb * QB;
    r.Q = P.Q + row0 * DM + h * HD; r.O = P.O + row0 * DM + h * HD; r.P0 = qb * QB;
    if (MODE == MODE_FOX) { r.K = P.K + (size_t)b * SEQ * KS + h * HD; r.V = P.V + (size_t)b * SEQ * KS + h * HD; r.aux = P.aux + ((size_t)b * NH + h) * SEQ; r.selm = nullptr; }
    else { const int g = h >> 2; r.K = P.K + (size_t)b * SEQ * KS + g * HD; r.V = P.V + (size_t)b * SEQ * KS + g * HD;
           r.aux = P.aux + row0 * 48 + (MODE == MODE_SLC ? 16 : 32) + h; r.selm = MODE == MODE_SLC ? P.selm + ((size_t)b * NG + g) * SEQ + (size_t)qb * QB : nullptr; }
    return r;
}
template <int MODE, int KS, bool ACCUM>
__device__ __forceinline__ void attn_phase(char* lds, const AttnPtrs& P, int G, int c) {
    constexpr bool PAIRED = MODE != MODE_WIN; constexpr int W = MODE == MODE_WIN ? 512 : (1 << 20);
    constexpr int total = PAIRED ? NB * NH * 8 : NB * NH * 16;
    int L = c; if (L >= total) return;
    int pass = 0;
#define DEC(L_, pass_, out) do { const int b_ = (L_) & 7, s_ = (L_) >> 3; int h_, qb_; if (PAIRED) { h_ = s_ >> 3; const int x_ = s_ & 7; qb_ = (pass_) ? 15 - x_ : x_; } else { h_ = s_ >> 4; qb_ = s_ & 15; } \
        out = att_ref<MODE, KS>(P, b_, h_, qb_); } while (0)
    BlockRef cur; DEC(L, 0, cur);
    Seam S;
    att_prime<MODE, DM, KS>(cur, W, lds, S);
    for (;;) {
        const bool more_pass = PAIRED && pass == 0, more_item = L + G < total, last = !more_pass && !more_item;
        int passn = pass + 1, Ln = L;
        if (!more_pass) { passn = 0; Ln = more_item ? L + G : L; }
        BlockRef nxt; if (last) nxt = cur; else DEC(Ln, passn, nxt);
        att_block<MODE, DM, KS, DM, ACCUM>(cur, nxt, SEQ, W, lds, S);
        if (last) break;
        cur = nxt; pass = passn; L = Ln;
    }
#undef DEC
}
#undef VMW
constexpr int CMP_K_OFF = 4 * SHM_V, CMP_IMP_OFF = 8 * SHM_V, CMP_WS_OFF = CMP_IMP_OFF + 16896, CMP_LDS = CMP_WS_OFF + NW * 256;
template <int T> __device__ __forceinline__ void cmp_mask(f32x16& p0, f32x16& p1, int dq) {
    const float NEG = -__builtin_inff();
#pragma unroll
    for (int r = 0; r < 16; ++r) { const int cc = (r & 3) + 8 * (r >> 2); if (cc > dq) p0[r] = NEG; if (cc + 32 > dq) p1[r] = NEG; }
}
struct CmpPtrs { const bf16* Q; const bf16* CK; const bf16* CV; bf16* O; const float* gates; unsigned long long* selm; };
__device__ __forceinline__ void cmp_unit(char* lds, const CmpPtrs& P, int b, int g, int tb) {
    const int tid = threadIdx.x, wid = __builtin_amdgcn_readfirstlane(tid >> 6), lane = tid & 63, r32 = lane & 31, hi = lane >> 5;
    char* V_lds = lds; char* K_lds = lds + CMP_K_OFF; float* imp = (float*)(lds + CMP_IMP_OFF); float* li_l = (float*)(lds + CMP_WS_OFF) + wid * 64;
    const int t0 = tb * 64, tok = 8 * wid + (r32 & 7), head = r32 >> 3, h = 4 * g + head, pos = t0 + tok;
    const int nkeys = 4 * tb + 3 > 255 ? 255 : 4 * tb + 3, NT = (nkeys + 63) >> 6;
    constexpr float C2 = 1.4426950408889634f * SCALE;
    bf16x8 qr[8];
    { const bf16* qp = P.Q + ((size_t)b * SEQ + pos) * DM + h * HD + hi * 8;
#pragma unroll
      for (int d0 = 0; d0 < 8; ++d0) qr[d0] = load8(qp + d0 * 16); }
    const float gate = P.gates[((size_t)b * SEQ + pos) * 48 + h];
    { const int sr = tid >> 4, sc = (tid & 15) * 8, vst0 = v_st(sr, sc), vst1 = v_st(32 + sr, sc), kws = KSWZ(sr, sc * 2);
      const bf16* kp = P.CK + ((size_t)(b * 256) * NG + g) * HD + sc; const bf16* vp = P.CV + ((size_t)(b * 256) * NG + g) * HD + sc;
#pragma unroll
      for (int T = 0; T < 4; ++T) if (T < NT) {
          const size_t o0 = (size_t)(T * 64 + sr) * NG * HD, o1 = (size_t)(T * 64 + 32 + sr) * NG * HD;
          const bf16x8 k0 = load8(kp + o0), k1 = load8(kp + o1), v0 = load8(vp + o0), v1 = load8(vp + o1);
          *(bf16x8*)(K_lds + T * SHM_K + kws) = k0; *(bf16x8*)(K_lds + T * SHM_K + kws + 32 * 256) = k1;
          *(bf16x8*)(V_lds + T * SHM_V + vst0) = v0; *(bf16x8*)(V_lds + T * SHM_V + vst1) = v1; } }
    __syncthreads();
    const int cm = (pos - 31) >> 4;
    const int vb0 = (int)(uintptr_t)V_lds + v_rd_base(lane);
    float m_run = -1e30f, l_run = 0.f;
    f32x16 p0, p1;
#define CMP_PASS_A(T) if ((T) < NT) { SBAR(); qkt<T, MODE_WIN>(p0, p1, K_lds, nullptr, r32, hi, qr, 0.f); cmp_mask<T>(p0, p1, cm - 64 * (T) - 4 * hi);                      \
        float pmax = p0[0]; for (int r = 1; r < 16; ++r) pmax = fmaxf(pmax, p0[r]); for (int r = 0; r < 16; ++r) pmax = fmaxf(pmax, p1[r]);                                  \
        { auto rr = __builtin_amdgcn_permlane32_swap(__float_as_uint(pmax), __float_as_uint(pmax), false, false); pmax = fmaxf(__uint_as_float(rr[0]), __uint_as_float(rr[1])); } \
        const float mn = fmaxf(m_run, pmax), so = __builtin_amdgcn_exp2f((m_run - mn) * C2), mnL = -mn * C2; float ps = 0.f;                                                 \
        for (int r = 0; r < 16; ++r) ps += __builtin_amdgcn_exp2f(fmaf(p0[r], C2, mnL)) + __builtin_amdgcn_exp2f(fmaf(p1[r], C2, mnL));                                     \
        l_run = l_run * so + ps; m_run = mn; }
    CMP_PASS_A(0) CMP_PASS_A(1) CMP_PASS_A(2) CMP_PASS_A(3)
#undef CMP_PASS_A
    { auto rr = __builtin_amdgcn_permlane32_swap(__float_as_uint(l_run), __float_as_uint(l_run), false, false); l_run = __uint_as_float(rr[0]) + __uint_as_float(rr[1]); }
    const float inv_l = l_run > 0.f ? 1.0f / l_run : 0.f;
    const float mL = -m_run * C2;
    f32x16 o[4] = {}; float carry = 0.f; bf16x8 pa0, pa1, pa2, pa3;
#define CMP_IMP(P_, T, ph) do { float G_[4], x_[4];                                                                                            \
        for (int i = 0; i < 4; ++i) { G_[i] = (P_[4 * i] + P_[4 * i + 1]) + (P_[4 * i + 2] + P_[4 * i + 3]); x_[i] = __shfl_xor(P_[4 * i + 3], 32); }  \
        for (int i = 0; i < 4; ++i) { const float ex = hi ? x_[i] : (i ? x_[i > 0 ? i - 1 : 0] : carry); float v = (G_[i] + ex) * inv_l;     \
            v += __shfl_xor(v, 8); v += __shfl_xor(v, 16);                                                                                     \
            if (r32 < 8) imp[(8 * wid + r32) * 65 + 16 * (T) + 8 * (ph) + 2 * i + hi] = v; }                                                  \
        carry = x_[3]; } while (0)
#define CMP_PASS_B(T) if ((T) < NT) { SBAR(); qkt<T, MODE_WIN>(p0, p1, K_lds, nullptr, r32, hi, qr, 0.f); cmp_mask<T>(p0, p1, cm - 64 * (T) - 4 * hi);   \
        for (int r = 0; r < 16; ++r) { p0[r] = __builtin_amdgcn_exp2f(fmaf(p0[r], C2, mL)); p1[r] = __builtin_amdgcn_exp2f(fmaf(p1[r], C2, mL)); }        \
        CMP_IMP(p0, T, 0); CMP_IMP(p1, T, 1);                                                                                                           \
        ATT_PK4(p0, 0, pa0); ATT_PK4(p0, 8, pa1); ATT_PK4(p1, 0, pa2); ATT_PK4(p1, 8, pa3); SBAR();                                                     \
        pv_tile<T>(o, vb0, pa0, pa1, pa2, pa3); }
    CMP_PASS_B(0) CMP_PASS_B(1) CMP_PASS_B(2) CMP_PASS_B(3)
#undef CMP_PASS_B
#undef CMP_IMP
    if (hi == 0) li_l[r32] = gate * inv_l; asm volatile("s_waitcnt lgkmcnt(0)" ::: "memory");
    float rli[16];
#pragma unroll
    for (int r = 0; r < 16; ++r) rli[r] = li_l[crow(r, hi)];
#pragma unroll
    for (int r = 0; r < 16; ++r) { const int rho = crow(r, hi); bf16* orow = P.O + ((size_t)b * SEQ + t0 + 8 * wid + (rho & 7)) * DM + (4 * g + (rho >> 3)) * HD;
#pragma unroll
        for (int d0 = 0; d0 < 4; ++d0) { const float v = o[d0][r] * rli[r]; const float vn = __shfl_xor(v, 1);
            if ((r32 & 1) == 0) *(unsigned*)(orow + d0 * 32 + r32) = cvtpk(v, vn); } }
    __syncthreads();
    const int jq = tb;
    for (int k = 0; k < 8; ++k) {
        unsigned long long mask;
        if (jq + 1 <= 16) mask = (1ull << (jq + 1)) - 1ull;
        else {
            const int n = lane; float val = -1.0f;
            if (n <= jq) val = imp[(8 * wid + k) * 65 + n] + ((n == 0 || n == jq || n == jq - 1) ? 1000.0f : 0.0f);
            int rank = 0;
#pragma unroll 4
            for (int m = 0; m < 64; ++m) { const float vm = __uint_as_float(__builtin_amdgcn_readlane(__float_as_uint(val), m)); rank += (vm > val || (vm == val && m < n)) ? 1 : 0; }
            mask = __ballot(rank < 16 && n <= jq);
        }
        if (lane == 0) P.selm[((size_t)b * NG + g) * SEQ + t0 + 8 * wid + k] = mask;
    }
    __syncthreads();
}
__device__ __forceinline__ void cmp_phase(char* lds, const CmpPtrs& P, int G, int c) {
    for (int L = c; L < NB * NG * 64; L += G) { const int b = L & 7, s = L >> 3, g = s >> 6, x = s & 63, tb = x < 32 ? x : 95 - x; cmp_unit(lds, P, b, g, tb); }
}
}

constexpr size_t MiB = 1u << 20;
constexpr size_t WS_CTL = 0, CTL_ZERO_BYTES = 1 * MiB;
constexpr size_t WS_COS = 1 * MiB, WS_SIN = WS_COS + 256 * 1024;
constexpr size_t WS_PT = WS_SIN + 256 * 1024;
constexpr size_t WS_W2C = WS_PT + 64 * 1024;
constexpr size_t WS_RTE = 2 * MiB, WS_RTW = WS_RTE + 128 * 1024, WS_SLOT = WS_RTW + 256 * 1024;
constexpr size_t WS_WNSA = 4 * MiB, WS_WCMP1 = 25 * MiB, WS_WNO = 29 * MiB, WS_WFGU = 37 * MiB, WS_WFD = 81 * MiB, WS_WFOX = 103 * MiB, WS_WFO = 128 * MiB, WS_WMGU = 136 * MiB, WS_WMD = 584 * MiB;
constexpr size_t WS_HN = 808 * MiB;
constexpr size_t WS_Q = 936 * MiB, WS_KV = 1064 * MiB, WS_GATES = 1256 * MiB, WS_UV = 1262 * MiB, WS_CK = 1294 * MiB, WS_CV = 1296 * MiB, WS_SELM = 1298 * MiB;
constexpr size_t WS_O = 1432 * MiB, WS_MIX = 1560 * MiB;
constexpr size_t WS_ACT = 936 * MiB;
constexpr size_t WS_FQKV = 936 * MiB, WS_FL = 1320 * MiB, WS_CS = 1322 * MiB;
constexpr size_t WS_XG = 936 * MiB, WS_H = 1200 * MiB, WS_Y = 1424 * MiB, WS_END = 1688 * MiB;
constexpr int MOE_CHUNK_TILES = 64, MOE_MAX_TILES = 264, MOE_NCHUNK = 5;
constexpr int CW_BAR = 4096;
constexpr int CW_CNT = 64, CW_CUR = 128;

constexpr int LDS_BYTES = 155648;
constexpr int LDSCTL_OFF = LDS_BYTES - 256;
constexpr int NWAVES = 8;

__device__ __forceinline__ float wave_sum(float v) {
#pragma unroll
    for (int o = 1; o < 64; o <<= 1) v += __shfl_xor(v, o);
    return v;
}
__device__ __forceinline__ float bfu_lo(unsigned w) { return __uint_as_float(w << 16); }
__device__ __forceinline__ float bfu_hi(unsigned w) { return __uint_as_float(w & 0xffff0000u); }
__device__ __forceinline__ void tr_item(const float* W, size_t ldw, int K, bf16* WT, size_t dst_row0, int k0, int n0, LAS float* scr, int lane) {
    const int cq = lane & 15, rq = lane >> 4;
#pragma unroll 4
    for (int i = 0; i < 16; ++i) { const int kk = 4 * i + rq; const f32x4 v = *(const GAS f32x4*)(W + (size_t)(k0 + kk) * ldw + n0 + 4 * cq);
        LAS float* s = scr + kk * 65 + 4 * cq; s[0] = v.x; s[1] = v.y; s[2] = v.z; s[3] = v.w; }
    LDS_WAIT(); asm volatile("" ::: "memory");
    const int c = lane & 7;
#pragma unroll
    for (int j = 0; j < 8; ++j) { const int n = (lane >> 3) + 8 * j; const LAS float* s = scr + (8 * c) * 65 + n;
        v4u o; o.x = pk2(s[0], s[65]); o.y = pk2(s[130], s[195]); o.z = pk2(s[260], s[325]); o.w = pk2(s[390], s[455]);
        *(GAS v4u*)(WT + (dst_row0 + n) * (size_t)K + k0 + 8 * c) = o; }
    LDS_WAIT(); asm volatile("" ::: "memory");
}
struct TrJob { const float* W; size_t ldw; int K, N; bf16* WT; int grp, gstride, roff; };
__device__ __forceinline__ int tr_items(const TrJob& j) { return (j.K / 64) * (j.N / 64); }
__device__ __forceinline__ void tr_run(const TrJob& j, int it, LAS float* scr, int lane) {
    const int nb = j.N / 64, kb = it / nb, n0 = (it % nb) * 64;
    tr_item(j.W, j.ldw, j.K, j.WT, (size_t)(n0 / j.grp) * j.gstride + (n0 % j.grp) + j.roff, kb * 64, n0, scr, lane);
}
__device__ __forceinline__ float gelu_tanh(float x) {
    const float u = 0.7978845608028654f * (x + 0.044715f * x * x * x);
    const float e = __builtin_amdgcn_exp2f(-2.0f * 1.4426950408889634f * u);
    const float th = (1.0f - e) * __builtin_amdgcn_rcpf(1.0f + e);
    return 0.5f * x * (1.0f + th);
}

enum Phase { PH_PRO = 0, PH_NSA_IN, PH_CMP1, PH_CMP2, PH_ATT_CMP, PH_ATT_SLC, PH_ATT_WIN, PH_NSA_OUT, PH_NORM_A, PH_FFN_GU, PH_FFN_DN, PH_NORM_B, PH_FOX_IN, PH_FOX_SCAN, PH_FOX_ATT, PH_FOX_OUT,
             PH_NORM_C, PH_MOE_DISP, PH_MOE0, PH_FINAL = PH_MOE0 + 2 * MOE_NCHUNK, PH_COUNT };
struct Args { const float* in[20]; float* out; unsigned char* ws; int ph_lo, ph_hi; };

typedef unsigned u32x2 __attribute__((ext_vector_type(2)));
struct Row8 { f32x4 v[8]; };
__device__ __forceinline__ Row8 ld_row_f32(const float* p, int lane) { Row8 r; const GAS f32x4* q = (const GAS f32x4*)p + lane;
#pragma unroll
    for (int j = 0; j < 8; ++j) r.v[j] = q[64 * j]; return r; }
__device__ __forceinline__ Row8 ld_row_bf16(const bf16* p, int lane) { Row8 r; const GAS u32x2* q = (const GAS u32x2*)p + lane;
#pragma unroll
    for (int j = 0; j < 8; ++j) { const u32x2 w = q[64 * j]; r.v[j] = (f32x4){bfu_lo(w.x), bfu_hi(w.x), bfu_lo(w.y), bfu_hi(w.y)}; } return r; }
__device__ __forceinline__ void st_row_f32(float* p, int lane, const Row8& r) { GAS f32x4* q = (GAS f32x4*)p + lane;
#pragma unroll
    for (int j = 0; j < 8; ++j) q[64 * j] = r.v[j]; }
__device__ __forceinline__ void st_row_bf16(bf16* p, int lane, const Row8& r) { GAS u32x2* q = (GAS u32x2*)p + lane;
#pragma unroll
    for (int j = 0; j < 8; ++j) { u32x2 w; w.x = pk2(r.v[j].x, r.v[j].y); w.y = pk2(r.v[j].z, r.v[j].w); q[64 * j] = w; } }
__device__ __forceinline__ float row_rs(const Row8& r) { float s = 0.f;
#pragma unroll
    for (int j = 0; j < 8; ++j) s += (r.v[j].x * r.v[j].x + r.v[j].y * r.v[j].y) + (r.v[j].z * r.v[j].z + r.v[j].w * r.v[j].w);
    return 1.0f / sqrtf(wave_sum(s) * (1.0f / DM) + RMS_EPS); }

__global__ void __launch_bounds__(NWAVES * 64, 2) mk_fwd(Args args) {
    extern __shared__ __attribute__((aligned(16))) unsigned char lds[];
    LAS unsigned char* ldsl = (LAS unsigned char*)lds;
    volatile LAS unsigned* LCTL = (volatile LAS unsigned*)(ldsl + LDSCTL_OFF);
    const int tid = threadIdx.x, lane = tid & 63, wave = __builtin_amdgcn_readfirstlane(tid >> 6);
    const int G = gridDim.x, bx = blockIdx.x;
    const int gw = bx * NWAVES + wave, NGW = G * NWAVES;
    unsigned char* ws = args.ws;
    gu32* ctl = (gu32*)(ws + WS_CTL);
    if (tid < 64) LCTL[tid] = 0u;
    __syncthreads();
    XcdBarrier bar; bar.bar = (unsigned*)ctl + CW_BAR; bar.x = 0; bar.st = nullptr;
    if (MK_N_LAUNCHES == 1) bar = xcd_barrier_post((unsigned*)ctl + CW_BAR, LCTL);
    const int lo = args.ph_lo, hi = args.ph_hi;
#ifdef MK_ONLY
#define IN(k) ((k) == MK_ONLY && lo <= (k) && (k) < hi)
#else
#define IN(k) (lo <= (k) && (k) < hi)
#endif
#define SEAM(k) do { if (IN(k) && IN((k) + 1)) xcd_barrier(bar); } while (0)

    const float* x_in = args.in[0]; const float* ln_g = args.in[1];
    float* xres = args.out;
    bf16* HN = (bf16*)(ws + WS_HN); bf16* OB = (bf16*)(ws + WS_O); bf16* MIX = (bf16*)(ws + WS_MIX);
    float* cosT = (float*)(ws + WS_COS); float* sinT = (float*)(ws + WS_SIN); float* PT = (float*)(ws + WS_PT); bf16* W2C = (bf16*)(ws + WS_W2C);
    unsigned* RTE = (unsigned*)(ws + WS_RTE); float2* RTW = (float2*)(ws + WS_RTW); int2* SLOT = (int2*)(ws + WS_SLOT);

    if (IN(PH_PRO)) {
        LAS float* scr = (LAS float*)(ldsl + wave * 16640);
        int it0 = gw;
#define RUN_JOB(job) do { const TrJob j_ = (job); const int n_ = tr_items(j_); for (; it0 < n_; it0 += NGW) tr_run(j_, it0, scr, lane); it0 -= n_; } while (0)
        RUN_JOB((TrJob{args.in[2], NSA_NV, DM, 5120, (bf16*)(ws + WS_WNSA), 1 << 30, 0, 0}));
        RUN_JOB((TrJob{args.in[5], 256, DM, 256, (bf16*)(ws + WS_WCMP1), 1 << 30, 0, 0}));
        RUN_JOB((TrJob{args.in[5] + (size_t)2048 * 256, 256, DM, 256, (bf16*)(ws + WS_WCMP1), 1 << 30, 0, 256}));
        RUN_JOB((TrJob{args.in[7], 256, DM, 256, (bf16*)(ws + WS_WCMP1), 1 << 30, 0, 512}));
        RUN_JOB((TrJob{args.in[7] + (size_t)2048 * 256, 256, DM, 256, (bf16*)(ws + WS_WCMP1), 1 << 30, 0, 768}));
        RUN_JOB((TrJob{args.in[6], 128, 256, 128, W2C, 1 << 30, 0, 0}));
        RUN_JOB((TrJob{args.in[8], 128, 256, 128, W2C + 128 * 256, 1 << 30, 0, 0}));
        RUN_JOB((TrJob{args.in[9], DM, DM, DM, (bf16*)(ws + WS_WNO), 1 << 30, 0, 0}));
        RUN_JOB((TrJob{args.in[13], FFD, DM, FFD, (bf16*)(ws + WS_WFGU), 128, 256, 0}));
        RUN_JOB((TrJob{args.in[14], FFD, DM, FFD, (bf16*)(ws + WS_WFGU), 128, 256, 128}));
        RUN_JOB((TrJob{args.in[15], DM, FFD, DM, (bf16*)(ws + WS_WFD), 1 << 30, 0, 0}));
        RUN_JOB((TrJob{args.in[10], FOX_NV, DM, 6144, (bf16*)(ws + WS_WFOX), 1 << 30, 0, 0}));
        RUN_JOB((TrJob{args.in[12], DM, DM, DM, (bf16*)(ws + WS_WFO), 1 << 30, 0, 0}));
        for (int e = 0; e < NE; ++e) {
            RUN_JOB((TrJob{args.in[17] + (size_t)e * DM * FFE, FFE, DM, FFE, (bf16*)(ws + WS_WMGU) + (size_t)e * 2 * FFE * DM, 128, 256, 0}));
            RUN_JOB((TrJob{args.in[18] + (size_t)e * DM * FFE, FFE, DM, FFE, (bf16*)(ws + WS_WMGU) + (size_t)e * 2 * FFE * DM, 128, 256, 128}));
            RUN_JOB((TrJob{args.in[19] + (size_t)e * FFE * DM, DM, FFE, DM, (bf16*)(ws + WS_WMD) + (size_t)e * DM * FFE, 1 << 30, 0, 0}));
        }
#undef RUN_JOB
        const int gt = bx * (NWAVES * 64) + tid, NGT = G * NWAVES * 64;
        for (int i = gt; i < 48 * DM; i += NGT) { const int j = i / DM, k = i % DM; ((bf16*)(ws + WS_WNSA))[(size_t)(5120 + j) * DM + k] = (bf16)f2bf(args.in[2][(size_t)k * NSA_NV + 5120 + j]); }
        for (int i = gt; i < 16 * DM; i += NGT) { const int j = i / DM, k = i % DM; ((bf16*)(ws + WS_WFOX))[(size_t)(6144 + j) * DM + k] = (bf16)f2bf(args.in[10][(size_t)k * FOX_NV + 6144 + j]); }
        for (int i = gt; i < SEQ * 16; i += NGT) { const int pos = i >> 4, k = i & 15;
            const double inv = exp2(-(double)k * (18.931568569324174 / 16.0));
            double a = (double)pos * inv; a -= 6.283185307179586476925 * rint(a * 0.15915494309189533577);
            cosT[i] = cosf((float)a); sinT[i] = sinf((float)a); }
        for (int t = gw; t < 64; t += NGW) { const int kv = t >> 5, part = (t >> 2) & 7, hb = t & 3; const float* pos = args.in[kv ? 4 : 3]; const float* w1 = args.in[kv ? 7 : 5];
            float acc = 0.f; for (int k = part * 512; k < part * 512 + 512; ++k) acc = fmaf(pos[k], w1[(size_t)k * 256 + hb * 64 + lane], acc);
            PT[(kv * 8 + part) * 256 + hb * 64 + lane] = acc; }
        { const Row8 g0 = ld_row_f32(ln_g, lane);
          for (int m = gw; m < MTOK; m += NGW) { Row8 r = ld_row_f32(x_in + (size_t)m * DM, lane); const float rs = row_rs(r);
#pragma unroll
              for (int j = 0; j < 8; ++j) r.v[j] = r.v[j] * rs * g0.v[j];
              st_row_bf16(HN + (size_t)m * DM, lane, r); } }
    }
    SEAM(PH_PRO);

    if (IN(PH_NSA_IN)) {
        pg8::Gemm g{(const pg8::bf16_t*)HN, (const pg8::bf16_t*)(ws + WS_WNSA), MTOK, NSA_N, DM}; pg8::StaticOrder S; S.init(MTOK, NSA_N, G, bx);
        pg8::EpiNsaIn E{(pg8::bf16_t*)(ws + WS_Q), (pg8::bf16_t*)(ws + WS_KV), (float*)(ws + WS_GATES), cosT, sinT};
        pg8::gemm_phase<pg8::EpiNsaIn, pg8::StaticOrder, true, true>(ldsl, g, S, E);
    }
    SEAM(PH_NSA_IN);

    if (IN(PH_CMP1)) {
        pg8::Gemm g{(const pg8::bf16_t*)(ws + WS_KV), (const pg8::bf16_t*)(ws + WS_WCMP1), 16384, 1024, DM}; pg8::CmpOrder S{G, bx};
        pg8::EpiF32Cmp E{(float*)(ws + WS_UV), 512};
        pg8::gemm_phase<pg8::EpiF32Cmp, pg8::CmpOrder, false, true>(ldsl, g, S, E);
    }
    SEAM(PH_CMP1);

    if (IN(PH_CMP2)) {
        typedef float f32x4v __attribute__((ext_vector_type(4)));
        const float* UV = (const float*)(ws + WS_UV);
        for (int t = gw; t < 2 * NB * NG * 16; t += NGW) {
            const int kv = t >> 9, b = (t >> 6) & 7, g = (t >> 4) & 3, i0 = (t & 15) * 16;
            const int fr = lane & 15, fq = lane >> 4, i = i0 + fr;
            const bool valid = i < 255;
            const float* urow = UV + ((size_t)kv * 8192 + ((size_t)(b * 256 + i) * NG + g)) * 512;
            const float* vrow = UV + ((size_t)kv * 8192 + ((size_t)(b * 256 + (valid ? i + 1 : i)) * NG + g)) * 512 + 256;
            f32x4 acc[8];
#pragma unroll
            for (int n = 0; n < 8; ++n) acc[n] = (f32x4){0.f, 0.f, 0.f, 0.f};
            const bf16* w2 = W2C + (size_t)kv * 128 * 256;
#pragma unroll 2
            for (int ks = 0; ks < 8; ++ks) { const int h0 = 32 * ks + 8 * fq;
                float hv[8];
#pragma unroll
                for (int q = 0; q < 2; ++q) { const f32x4 a = *(const GAS f32x4*)(urow + h0 + 4 * q), c = *(const GAS f32x4*)(vrow + h0 + 4 * q);
                    f32x4 p = (f32x4){0.f, 0.f, 0.f, 0.f};
#pragma unroll
                    for (int pt = 0; pt < 8; ++pt) p += *(const GAS f32x4*)(PT + (kv * 8 + pt) * 256 + h0 + 4 * q);
#pragma unroll
                    for (int e = 0; e < 4; ++e) hv[4 * q + e] = gelu_tanh(a[e] + c[e] + p[e]); }
                v4u aw; aw.x = pk2(hv[0], hv[1]); aw.y = pk2(hv[2], hv[3]); aw.z = pk2(hv[4], hv[5]); aw.w = pk2(hv[6], hv[7]);
                const bf16x8 af = __builtin_bit_cast(bf16x8, aw);
#pragma unroll
                for (int n = 0; n < 8; ++n) { const bf16x8 bfr = *(const GAS bf16x8*)(w2 + (size_t)(16 * n + fr) * 256 + h0);
                    acc[n] = __builtin_amdgcn_mfma_f32_16x16x32_bf16(af, bfr, acc[n], 0, 0, 0); } }
            bf16* outp = (bf16*)(ws + (kv ? WS_CV : WS_CK));
#pragma unroll
            for (int n = 0; n < 8; ++n)
#pragma unroll
                for (int r = 0; r < 4; ++r) { const int ii = i0 + 4 * fq + r; outp[((size_t)(b * 256 + ii) * NG + g) * HD + 16 * n + fr] = (bf16)(ii < 255 ? f2bf(acc[n][r]) : 0u); }
        }
    }
    SEAM(PH_CMP2);

    if (IN(PH_ATT_CMP)) {
        att::CmpPtrs P{(const att::bf16*)(ws + WS_Q), (const att::bf16*)(ws + WS_CK), (const att::bf16*)(ws + WS_CV), (att::bf16*)OB, (const float*)(ws + WS_GATES), (unsigned long long*)(ws + WS_SELM)};
        att::cmp_phase((char*)lds, P, G, bx);
    }
    SEAM(PH_ATT_CMP);
    if (IN(PH_ATT_SLC)) {
        att::AttnPtrs P{(const att::bf16*)(ws + WS_Q), (const att::bf16*)(ws + WS_KV) + (size_t)2 * MTOK * 512, (const att::bf16*)(ws + WS_KV) + (size_t)3 * MTOK * 512, (att::bf16*)OB,
                        (const float*)(ws + WS_GATES), (const unsigned long long*)(ws + WS_SELM)};
        att::attn_phase<att::MODE_SLC, 512, true>((char*)lds, P, G, bx);
    }
    SEAM(PH_ATT_SLC);
    if (IN(PH_ATT_WIN)) {
        att::AttnPtrs P{(const att::bf16*)(ws + WS_Q), (const att::bf16*)(ws + WS_KV) + (size_t)4 * MTOK * 512, (const att::bf16*)(ws + WS_KV) + (size_t)5 * MTOK * 512, (att::bf16*)OB,
                        (const float*)(ws + WS_GATES), nullptr};
        att::attn_phase<att::MODE_WIN, 512, true>((char*)lds, P, G, bx);
    }
    SEAM(PH_ATT_WIN);

    if (IN(PH_NSA_OUT)) {
        pg8::Gemm g{(const pg8::bf16_t*)OB, (const pg8::bf16_t*)(ws + WS_WNO), MTOK, DM, DM}; pg8::StaticOrder S; S.init(MTOK, DM, G, bx);
        pg8::EpiBf16Plain E{(pg8::bf16_t*)MIX, DM};
        pg8::gemm_phase<pg8::EpiBf16Plain, pg8::StaticOrder, true, true>(ldsl, g, S, E);
    }
    SEAM(PH_NSA_OUT);

#define NORM_AB(src_x, gpost, gpre) do { const Row8 ga = ld_row_f32(gpost, lane), gb = ld_row_f32(gpre, lane);                     \
        for (int m = gw; m < MTOK; m += NGW) { Row8 y = ld_row_bf16(MIX + (size_t)m * DM, lane); Row8 xr = ld_row_f32((src_x) + (size_t)m * DM, lane);  \
            const float rs = row_rs(y);                                                                                           \
            _Pragma("unroll") for (int j = 0; j < 8; ++j) xr.v[j] = xr.v[j] + y.v[j] * rs * ga.v[j];                              \
            st_row_f32(xres + (size_t)m * DM, lane, xr); const float rs2 = row_rs(xr);                                            \
            _Pragma("unroll") for (int j = 0; j < 8; ++j) xr.v[j] = xr.v[j] * rs2 * gb.v[j];                                      \
            st_row_bf16(HN + (size_t)m * DM, lane, xr); } } while (0)
    if (IN(PH_NORM_A)) NORM_AB(x_in, ln_g + 1 * DM, ln_g + 2 * DM);
    SEAM(PH_NORM_A);

    if (IN(PH_FFN_GU)) {
        pg8::Gemm g{(const pg8::bf16_t*)HN, (const pg8::bf16_t*)(ws + WS_WFGU), MTOK, 2 * FFD, DM}; pg8::StaticOrder S; S.init(MTOK, 2 * FFD, G, bx);
        pg8::EpiSwiGLU E{(pg8::bf16_t*)(ws + WS_ACT), FFD};
        pg8::gemm_phase<pg8::EpiSwiGLU, pg8::StaticOrder, true, true>(ldsl, g, S, E);
    }
    SEAM(PH_FFN_GU);
    if (IN(PH_FFN_DN)) {
        pg8::Gemm g{(const pg8::bf16_t*)(ws + WS_ACT), (const pg8::bf16_t*)(ws + WS_WFD), MTOK, DM, FFD}; pg8::StaticOrder S; S.init(MTOK, DM, G, bx);
        pg8::EpiBf16Plain E{(pg8::bf16_t*)MIX, DM};
        pg8::gemm_phase<pg8::EpiBf16Plain, pg8::StaticOrder, true, true>(ldsl, g, S, E);
    }
    SEAM(PH_FFN_DN);
    if (IN(PH_NORM_B)) NORM_AB(xres, ln_g + 3 * DM, ln_g + 4 * DM);
    SEAM(PH_NORM_B);

    if (IN(PH_FOX_IN)) {
        pg8::Gemm g{(const pg8::bf16_t*)HN, (const pg8::bf16_t*)(ws + WS_WFOX), MTOK, FOX_N, DM}; pg8::StaticOrder S; S.init(MTOK, FOX_N, G, bx);
        pg8::EpiFoxIn E{(pg8::bf16_t*)(ws + WS_FQKV), (float*)(ws + WS_FL)};
        pg8::gemm_phase<pg8::EpiFoxIn, pg8::StaticOrder, true, true>(ldsl, g, S, E);
    }
    SEAM(PH_FOX_IN);
    if (IN(PH_FOX_SCAN)) {
        const float* FL = (const float*)(ws + WS_FL); float* CS = (float*)(ws + WS_CS); const float* fb = args.in[11];
        for (int t = gw; t < NB * NH; t += NGW) { const int b = t >> 4, h = t & 15; const float bias = fb[h];
            const float* src = FL + ((size_t)b * SEQ + 64 * lane) * 16 + h; float* dst = CS + ((size_t)b * NH + h) * SEQ + 64 * lane;
            float s = 0.f;
            for (int k = 0; k < 64; ++k) { const float z = src[k * 16] + bias; s += fminf(z, 0.f) - log1pf(expf(-fabsf(z))); }
            float incl = s;
#pragma unroll
            for (int o = 1; o < 64; o <<= 1) { const float n = __shfl_up(incl, o); if (lane >= o) incl += n; }
            float run = incl - s;
            for (int k = 0; k < 64; ++k) { const float z = src[k * 16] + bias; run += fminf(z, 0.f) - log1pf(expf(-fabsf(z))); dst[k] = run * 11.313708498984761f; }
        }
    }
    SEAM(PH_FOX_SCAN);
    if (IN(PH_FOX_ATT)) {
        att::AttnPtrs P{(const att::bf16*)(ws + WS_FQKV), (const att::bf16*)(ws + WS_FQKV) + (size_t)MTOK * DM, (const att::bf16*)(ws + WS_FQKV) + (size_t)2 * MTOK * DM, (att::bf16*)OB,
                        (const float*)(ws + WS_CS), nullptr};
        att::attn_phase<att::MODE_FOX, DM, false>((char*)lds, P, G, bx);
    }
    SEAM(PH_FOX_ATT);
    if (IN(PH_FOX_OUT)) {
        pg8::Gemm g{(const pg8::bf16_t*)OB, (const pg8::bf16_t*)(ws + WS_WFO), MTOK, DM, DM}; pg8::StaticOrder S; S.init(MTOK, DM, G, bx);
        pg8::EpiBf16Plain E{(pg8::bf16_t*)MIX, DM};
        pg8::gemm_phase<pg8::EpiBf16Plain, pg8::StaticOrder, true, true>(ldsl, g, S, E);
    }
    SEAM(PH_FOX_OUT);

    if (IN(PH_NORM_C)) {
        LAS float* wrt = (LAS float*)ldsl;
        const float* wr = args.in[16];
        for (int i = tid; i < DM * NE; i += NWAVES * 64) wrt[(i & 7) * DM + (i >> 3)] = wr[i];
        __syncthreads();
        const Row8 ga = ld_row_f32(ln_g + 5 * DM, lane), gb = ld_row_f32(ln_g + 6 * DM, lane);
        int cnt[NE];
#pragma unroll
        for (int e = 0; e < NE; ++e) cnt[e] = 0;
        for (int m = gw; m < MTOK; m += NGW) { Row8 y = ld_row_bf16(MIX + (size_t)m * DM, lane); Row8 xr = ld_row_f32(xres + (size_t)m * DM, lane);
            const float rs = row_rs(y);
#pragma unroll
            for (int j = 0; j < 8; ++j) xr.v[j] = xr.v[j] + y.v[j] * rs * ga.v[j];
            st_row_f32(xres + (size_t)m * DM, lane, xr); const float rs2 = row_rs(xr);
#pragma unroll
            for (int j = 0; j < 8; ++j) xr.v[j] = xr.v[j] * rs2 * gb.v[j];
            st_row_bf16(HN + (size_t)m * DM, lane, xr);
            float lg[NE];
#pragma unroll
            for (int e = 0; e < NE; ++e) { float s = 0.f;
#pragma unroll
                for (int j = 0; j < 8; ++j) { const f32x4 w = *(const LAS f32x4*)(wrt + e * DM + 256 * j + 4 * lane); s += (xr.v[j].x * w.x + xr.v[j].y * w.y) + (xr.v[j].z * w.z + xr.v[j].w * w.w); }
                asm volatile("" : "+v"(s) :: "memory");
                lg[e] = wave_sum(s); }
            int e1 = 0; float v1 = lg[0];
#pragma unroll
            for (int e = 1; e < NE; ++e) if (lg[e] > v1) { v1 = lg[e]; e1 = e; }
            int e2 = -1; float v2 = -__builtin_inff();
#pragma unroll
            for (int e = 0; e < NE; ++e) if (e != e1 && lg[e] > v2) { v2 = lg[e]; e2 = e; }
            const float ex = expf(v2 - v1), w1 = 1.0f / (1.0f + ex), w2 = ex * w1;
#pragma unroll
            for (int e = 0; e < NE; ++e) cnt[e] += (e1 == e) + (e2 == e);
            if (lane == 0) { RTE[m] = (unsigned)e1 | ((unsigned)e2 << 8); RTW[m] = make_float2(w1, w2); }
        }
        if (lane == 0) {
#pragma unroll
            for (int e = 0; e < NE; ++e) if (cnt[e]) __hip_atomic_fetch_add((LAS unsigned*)(ldsl + LDSCTL_OFF) + 8 + e, (unsigned)cnt[e], __ATOMIC_RELAXED, __HIP_MEMORY_SCOPE_WORKGROUP);
        }
        __syncthreads();
        if (tid < NE) { const unsigned c = LCTL[8 + tid]; if (c) __hip_atomic_fetch_add(ctl + CW_CNT + tid, c, RLX_AGENT); }
    }
    SEAM(PH_NORM_C);

    int tb[NE + 1];
#pragma unroll
    for (int e = 0; e <= NE; ++e) tb[e] = 0;
    if (hi > PH_NORM_C + 1) {
#pragma unroll
        for (int e = 0; e < NE; ++e) { const unsigned c = __builtin_amdgcn_readfirstlane(__hip_atomic_load(ctl + CW_CNT + e, RLX_AGENT)); tb[e + 1] = tb[e] + (int)((c + 255u) >> 8); }
    }
    const int ttot = tb[NE] < MOE_MAX_TILES ? tb[NE] : MOE_MAX_TILES;

    if (IN(PH_MOE_DISP)) {
        bf16* XG = (bf16*)(ws + WS_XG);
        for (int ch = gw; ch < MTOK / 64; ch += NGW) { const int tok = ch * 64 + lane; const unsigned re = RTE[tok]; const int e1 = re & 0xff, e2 = (re >> 8) & 0xff;
            const unsigned long long lt = (1ull << lane) - 1ull; int sa = 0, sb = 0;
#pragma unroll
            for (int e = 0; e < NE; ++e) { const unsigned long long m1 = __ballot(e1 == e), m2 = __ballot(e2 == e); const int n1 = __popcll(m1), n2 = __popcll(m2);
                unsigned base = 0; if (lane == 0 && n1 + n2 > 0) base = __hip_atomic_fetch_add(ctl + CW_CUR + e, (unsigned)(n1 + n2), RLX_AGENT);
                base = __builtin_amdgcn_readfirstlane(base);
                if (e1 == e) sa = tb[e] * 256 + (int)base + __popcll(m1 & lt);
                if (e2 == e) sb = tb[e] * 256 + (int)base + n1 + __popcll(m2 & lt); }
            SLOT[tok] = make_int2(sa, sb);
            for (int k = 0; k < 64; ++k) { const int ra = __builtin_amdgcn_readlane(sa, k), rb = __builtin_amdgcn_readlane(sb, k);
                const GAS v4u* src = (const GAS v4u*)(HN + (size_t)(ch * 64 + k) * DM) + lane; GAS v4u* da = (GAS v4u*)(XG + (size_t)ra * DM) + lane; GAS v4u* db = (GAS v4u*)(XG + (size_t)rb * DM) + lane;
#pragma unroll
                for (int j = 0; j < 4; ++j) { const v4u v = src[64 * j]; da[64 * j] = v; db[64 * j] = v; } }
        }
    }
    SEAM(PH_MOE_DISP);

    for (int cidx = 0; cidx < MOE_NCHUNK; ++cidx) {
        const int t0 = cidx * MOE_CHUNK_TILES; int nt = ttot - t0; nt = nt > MOE_CHUNK_TILES ? MOE_CHUNK_TILES : nt;
        if (IN(PH_MOE0 + 2 * cidx) && nt > 0) {
            pg8::Gemm g{(const pg8::bf16_t*)(ws + WS_XG), (const pg8::bf16_t*)(ws + WS_WMGU), 0, 2 * FFE, DM};
            pg8::MoeOrder<false> S{t0, nt, 2 * FFE / 256, G, bx, tb[1], tb[2], tb[3], tb[4], tb[5], tb[6], tb[7]};
            pg8::EpiSwiGLU E{(pg8::bf16_t*)(ws + WS_H), FFE};
            pg8::gemm_phase<pg8::EpiSwiGLU, pg8::MoeOrder<false>, true, true>(ldsl, g, S, E);
        }
        SEAM(PH_MOE0 + 2 * cidx);
        if (IN(PH_MOE0 + 2 * cidx + 1) && nt > 0) {
            pg8::Gemm g{(const pg8::bf16_t*)(ws + WS_H), (const pg8::bf16_t*)(ws + WS_WMD), 0, DM, FFE};
            pg8::MoeOrder<true> S{t0, nt, DM / 256, G, bx, tb[1], tb[2], tb[3], tb[4], tb[5], tb[6], tb[7]};
            pg8::EpiBf16Plain E{(pg8::bf16_t*)(ws + WS_Y), DM};
            pg8::gemm_phase<pg8::EpiBf16Plain, pg8::MoeOrder<true>, true, true>(ldsl, g, S, E);
        }
        SEAM(PH_MOE0 + 2 * cidx + 1);
    }

    if (IN(PH_FINAL)) {
        const bf16* Y = (const bf16*)(ws + WS_Y); const Row8 ga = ld_row_f32(ln_g + 7 * DM, lane);
        for (int m = gw; m < MTOK; m += NGW) { const int2 sl = SLOT[m]; const float2 w = RTW[m];
            const Row8 ya = ld_row_bf16(Y + (size_t)sl.x * DM, lane), yb = ld_row_bf16(Y + (size_t)sl.y * DM, lane); Row8 xr = ld_row_f32(xres + (size_t)m * DM, lane);
            Row8 f;
#pragma unroll
            for (int j = 0; j < 8; ++j) f.v[j] = ya.v[j] * w.x + yb.v[j] * w.y;
            const float rs = row_rs(f);
#pragma unroll
            for (int j = 0; j < 8; ++j) xr.v[j] = xr.v[j] + f.v[j] * rs * ga.v[j];
            st_row_f32(xres + (size_t)m * DM, lane, xr); }
    }
#undef IN
#undef SEAM
#undef NORM_AB
}

extern "C" void kernel_launch(void* const* d_in, const int* in_sizes, int n_in, void* d_out, int out_size, void* d_ws, size_t ws_size, hipStream_t stream) {
    static int grid = 0;
    if (grid == 0) {
        if (n_in != 20 || in_sizes[0] != MTOK * DM || out_size != MTOK * DM || ws_size < WS_END) { fprintf(stderr, "kernel_launch: unexpected shapes (n_in %d, ws %zu < %zu?)\n", n_in, ws_size, (size_t)WS_END); grid = -1; return; }
        int dev = 0, cus = 0, per_cu = 0;
        if (hipGetDevice(&dev) != hipSuccess || hipDeviceGetAttribute(&cus, hipDeviceAttributeMultiprocessorCount, dev) != hipSuccess) { grid = -1; return; }
        if (hipFuncSetAttribute((const void*)mk_fwd, hipFuncAttributeMaxDynamicSharedMemorySize, LDS_BYTES) != hipSuccess) { fprintf(stderr, "kernel_launch: hipFuncSetAttribute failed\n"); grid = -1; return; }
        if (hipOccupancyMaxActiveBlocksPerMultiprocessor(&per_cu, (const void*)mk_fwd, NWAVES * 64, LDS_BYTES) != hipSuccess || per_cu < 1) { fprintf(stderr, "kernel_launch: occupancy query says %d blocks per CU\n", per_cu); }
        (void)hipGetLastError();
        grid = cus;
    }
    if (grid < 0) return;
    (void)hipMemsetAsync((char*)d_ws + WS_CTL, 0, CTL_ZERO_BYTES, stream);
    Args a{};
    for (int i = 0; i < 20; ++i) a.in[i] = (const float*)d_in[i];
    a.out = (float*)d_out; a.ws = (unsigned char*)d_ws;
#if MK_N_LAUNCHES == 1
    a.ph_lo = 0; a.ph_hi = PH_COUNT;
    hipLaunchKernelGGL(mk_fwd, dim3(grid), dim3(NWAVES * 64), LDS_BYTES, stream, a);
#else
    for (int p = 0; p < PH_COUNT; ++p) { a.ph_lo = p; a.ph_hi = p + 1; hipLaunchKernelGGL(mk_fwd, dim3(grid), dim3(NWAVES * 64), LDS_BYTES, stream, a); }
#endif
}
```

```cpp
#include <hip/hip_runtime.h>
#include <cstdio>
#include <cstdint>

#ifndef MK_N_LAUNCHES
#define MK_N_LAUNCHES 1
#endif

constexpr int NB = 8, SEQ = 4096, DM = 2048, MTOK = NB * SEQ;
constexpr int NH = 16, HD = 128, NG = 4;
constexpr int NSA_NV = 5168, NSA_N = 5376;
constexpr int FOX_NV = 6160, FOX_N = 6400;
constexpr int FFD = 5632, NE = 8, FFE = 7168;
constexpr float RMS_EPS = 1e-6f;

#define GAS __attribute__((address_space(1)))
#define LAS __attribute__((address_space(3)))
typedef unsigned short bf16;
typedef unsigned v4u __attribute__((ext_vector_type(4)));
typedef float f32x4 __attribute__((ext_vector_type(4)));
typedef short bf16x8 __attribute__((ext_vector_type(8)));
typedef GAS unsigned gu32;
typedef GAS unsigned long long gu64;
#define RLX_AGENT __ATOMIC_RELAXED, __HIP_MEMORY_SCOPE_AGENT
#define LDS_WAIT() asm volatile("s_waitcnt lgkmcnt(0)" ::: "memory")
#define VM_WAIT() asm volatile("s_waitcnt vmcnt(0)" ::: "memory")
__device__ __forceinline__ unsigned long long rt() { return __builtin_amdgcn_s_memrealtime(); }
__device__ __forceinline__ unsigned f2bf(float f) { unsigned u = __builtin_bit_cast(unsigned, f); return (u + 0x7fffu + ((u >> 16) & 1u)) >> 16; }
__device__ __forceinline__ unsigned pk2(float lo, float hi) { return f2bf(lo) | (f2bf(hi) << 16); }

#define XB_TMO      128
#define XB_XCNT(j)  (256  + 64 * (j))
#define XB_XSUB(j)  (1280 + 64 * (j))
#define XB_XGEN(j)  (2304 + 64 * (j))
#define XB_TOP      3328
#define XB_TOPGEN   3392
#define XCD_BAR_WORDS 3456
#define XB_SPIN_CAP (1u << 20)

__device__ __forceinline__ unsigned xb_ld(unsigned* p)              { return __hip_atomic_load(p, __ATOMIC_RELAXED, __HIP_MEMORY_SCOPE_AGENT); }
__device__ __forceinline__ unsigned xb_add(unsigned* p, unsigned v) { return __hip_atomic_fetch_add(p, v, __ATOMIC_RELAXED, __HIP_MEMORY_SCOPE_AGENT); }
__device__ __forceinline__ unsigned xb_xcc_id() { return (unsigned)__builtin_amdgcn_s_getreg((3 << 11) | 20) & 0xFu; }
#define XB_SPIN(cond, bar) do { unsigned _sp = 0; while (cond) { __builtin_amdgcn_s_sleep(1); \
    if ((++_sp & 255u) == 0u) { if (xb_ld(&(bar)[XB_TMO])) break; if (_sp > XB_SPIN_CAP) { atomicAdd(&(bar)[XB_TMO], 1u); break; } } } } while (0)

struct XcdBarrier {
    unsigned* bar; unsigned x;
    volatile LAS unsigned* st;
};

__device__ __forceinline__ XcdBarrier xcd_barrier_post(unsigned* bar, volatile LAS unsigned* st) {
    XcdBarrier b; b.bar = bar; b.x = xb_xcc_id(); b.st = st;
    if (threadIdx.x == 0) (void)xb_add(&bar[XB_XCNT(b.x)], 1u);
    return b;
}
__device__ __forceinline__ void xcd_barrier_complete(unsigned* bar, unsigned x, unsigned& nloc, unsigned& nx) {
    const unsigned G = gridDim.x * gridDim.y * gridDim.z;
    unsigned sum, cnt, mine, sp = 0u;
    for (;;) {
        sum = 0u; cnt = 0u; mine = 0u;
#pragma unroll
        for (unsigned j = 0; j < 16; ++j) { const unsigned c = xb_ld(&bar[XB_XCNT(j)]); sum += c; cnt += (c > 0u) ? 1u : 0u; mine = (j == x) ? c : mine; }
        if (sum == G) break;
        __builtin_amdgcn_s_sleep(1);
        if ((++sp & 255u) == 0u) { if (xb_ld(&bar[XB_TMO])) break; if (sp > XB_SPIN_CAP) { atomicAdd(&bar[XB_TMO], 1u); break; } }
    }
    nloc = mine > 0u ? mine : 1u; nx = cnt > 0u ? cnt : 1u;
}

__device__ __forceinline__ void xcd_barrier(const XcdBarrier& b) {
    asm volatile("s_waitcnt vmcnt(0)" ::: "memory");
    __syncthreads();
    if (threadIdx.x == 0) {
        unsigned* bar = b.bar;
        __builtin_amdgcn_s_waitcnt(0);
        unsigned nloc = b.st[0], nx = b.st[1];
        if (nloc == 0u) { xcd_barrier_complete(bar, b.x, nloc, nx); b.st[0] = nloc; b.st[1] = nx; }
        const unsigned old = xb_add(&bar[XB_XSUB(b.x)], 1u);
        const unsigned gen = old / nloc;
        if (old + 1u == (gen + 1u) * nloc) {
            __builtin_amdgcn_fence(__ATOMIC_RELEASE, "agent");
            asm volatile("s_waitcnt vmcnt(0)" ::: "memory");
            const unsigned og = xb_add(&bar[XB_TOP], 1u);
            const unsigned tg = og / nx;
            if (og + 1u == (tg + 1u) * nx) xb_add(&bar[XB_TOPGEN], 1u);
            else XB_SPIN(xb_ld(&bar[XB_TOPGEN]) == tg, bar);
            __builtin_amdgcn_fence(__ATOMIC_ACQUIRE, "agent");
            xb_add(&bar[XB_XGEN(b.x)], 1u);
            asm volatile("s_waitcnt vmcnt(0)" ::: "memory");
        } else {
            XB_SPIN(xb_ld(&bar[XB_XGEN(b.x)]) == gen, bar);
            __builtin_amdgcn_fence(__ATOMIC_ACQUIRE, "agent");
            asm volatile("s_waitcnt vmcnt(0)" ::: "memory");
        }
    }
    __syncthreads();
}


namespace pg8 {
#define PG8_LAS __attribute__((address_space(3)))
typedef unsigned short bf16_t;
typedef short bf16x8 __attribute__((ext_vector_type(8)));
typedef float f32x4 __attribute__((ext_vector_type(4)));
typedef unsigned u32x4 __attribute__((ext_vector_type(4)));
constexpr int BM = 256, BK = 64, HALF = 128, HTB = HALF * BK * 2  , STAGE_BYTES = 8 * HTB, NXCD = 8, WGM = 8;

__host__ __device__ __forceinline__ int lds_byte(int r, int c) { const int st = (r >> 4) * 2 + (c >> 5), rr = r & 15, cc = c & 31, ob = rr * 64 + cc * 2; return st * 1024 + (ob ^ (((ob >> 9) & 1) << 5)); }
__host__ __device__ __forceinline__ void stage_rc(int b, int& R, int& C) { const int st = b / 1024, sb = b % 1024, swz = sb ^ (((sb >> 9) & 1) << 5); R = (st >> 1) * 16 + swz / 64; C = (st & 1) * 32 + (swz % 64) / 2; }
__host__ __device__ __forceinline__ int perm32(int rho) { const int n = rho >> 4, i = rho & 15; return 8 * (i >> 2) + 4 * n + (i & 3); }

struct Unit { int pm, pn, pa, pb; };
struct Gemm { const bf16_t* A; const bf16_t* Bt; int M, N, K; };

struct StaticOrder {
    int nM, nN, nwg, G, c;
    __host__ __device__ void init(int M, int N, int G_, int c_) { nM = M / BM; nN = N / BM; nwg = nM * nN; G = G_; c = c_; }
    __host__ __device__ bool next(int i, Unit& u) const {
        const long L = (long)i * G + c; if (L >= nwg) return false;
        int wgid = (int)L; { const int q = nwg / NXCD, r = nwg % NXCD, xcd = wgid % NXCD, off = wgid / NXCD; wgid = (xcd < r ? xcd * (q + 1) : r * (q + 1) + (xcd - r) * q) + off; }
        const int nig = WGM * nN, gid = wgid / nig, fm = gid * WGM, gsz = (nM - fm) < WGM ? (nM - fm) : WGM;
        u.pm = fm + ((wgid % nig) % gsz); u.pn = (wgid % nig) / gsz; u.pa = u.pm; u.pb = u.pn; return true;
    }
    __device__ __forceinline__ void a_ready(const Unit&) const {}
    __device__ __forceinline__ void done(const Unit&) const {}
};

__device__ __forceinline__ unsigned cvt_pk_bf16(float lo, float hi) { unsigned r; asm volatile("v_cvt_pk_bf16_f32 %0, %1, %2" : "=v"(r) : "v"(lo), "v"(hi)); return r; }
typedef float f32x2 __attribute__((ext_vector_type(2)));
__device__ __forceinline__ u32x4 pack8_bf16(const f32x4 a, const f32x4 b) { u32x4 w; w.x = cvt_pk_bf16(a[0], a[1]); w.y = cvt_pk_bf16(a[2], a[3]); w.z = cvt_pk_bf16(b[0], b[1]); w.w = cvt_pk_bf16(b[2], b[3]); return w; }

struct EpiBf16Plain {
    static constexpr bool PERM = true, AFTER_DRAIN = false, ROWSCALE = false;
    bf16_t* O; int ldc;
    __device__ __forceinline__ void operator()(const f32x4 (&acc)[2][2][4][2], const Unit& u, int wr, int wc, int fr, int fq) const {
        const int row0 = u.pm * BM + wr * 64 + fr, col0 = u.pn * BM + wc * 32 + 8 * fq;
#pragma unroll
        for (int ai = 0; ai < 2; ++ai)
#pragma unroll
            for (int m = 0; m < 4; ++m) { bf16_t* rowp = O + (size_t)(row0 + ai * HALF + m * 16) * ldc + col0;
#pragma unroll
                for (int bj = 0; bj < 2; ++bj) *(u32x4*)(rowp + bj * HALF) = pack8_bf16(acc[ai][bj][m][0], acc[ai][bj][m][1]); }
    }
};
struct EpiF32Cmp {
    static constexpr bool PERM = false, AFTER_DRAIN = false, ROWSCALE = false;
    float* O; int ldc;
    __device__ __forceinline__ void operator()(const f32x4 (&acc)[2][2][4][2], const Unit& u, int wr, int wc, int fr, int fq) const {
        const int row0 = u.pm * BM + wr * 64 + fr, col0 = (u.pn & 1) * BM + wc * 32 + 4 * fq;
#pragma unroll
        for (int ai = 0; ai < 2; ++ai)
#pragma unroll
            for (int m = 0; m < 4; ++m) { float* rowp = O + (size_t)(row0 + ai * HALF + m * 16) * ldc + col0;
#pragma unroll
                for (int bj = 0; bj < 2; ++bj)
#pragma unroll
                    for (int n = 0; n < 2; ++n) *(f32x4*)(rowp + bj * HALF + n * 16) = acc[ai][bj][m][n]; }
    }
};
struct EpiSwiGLU {
    static constexpr bool PERM = true, AFTER_DRAIN = false, ROWSCALE = true;
    bf16_t* O; int ldc; const float* rs;
    __device__ __forceinline__ void operator()(const f32x4 (&acc)[2][2][4][2], const Unit& u, int wr, int wc, int fr, int fq) const {
        const int row0 = u.pm * BM + wr * 64 + fr, col0 = u.pn * HALF + wc * 32 + 8 * fq;
#pragma unroll
        for (int ai = 0; ai < 2; ++ai)
#pragma unroll
            for (int m = 0; m < 4; ++m) { f32x4 h[2];
#pragma unroll
                for (int n = 0; n < 2; ++n) { const f32x4 g = acc[ai][0][m][n], up = acc[ai][1][m][n];
#pragma unroll
                    for (int j = 0; j < 4; j += 2) {
                        const f32x2 gg = {g[j], g[j + 1]}, uu = {up[j], up[j + 1]}; const f32x2 t = gg * -1.4426950408889634f;
                        f32x2 d = {__builtin_amdgcn_exp2f(t.x), __builtin_amdgcn_exp2f(t.y)}; d = d + 1.0f;
                        const f32x2 r = {__builtin_amdgcn_rcpf(d.x), __builtin_amdgcn_rcpf(d.y)}; const f32x2 hh = (gg * uu) * r;
                        h[n][j] = hh.x; h[n][j + 1] = hh.y; } }
                *(u32x4*)(O + (size_t)(row0 + ai * HALF + m * 16) * ldc + col0) = pack8_bf16(h[0], h[1]); }
    }
};
__device__ __forceinline__ unsigned pk4_fp8(float a, float b, float c, float d) {
    a = __builtin_amdgcn_fmed3f(a, -448.f, 448.f); b = __builtin_amdgcn_fmed3f(b, -448.f, 448.f); c = __builtin_amdgcn_fmed3f(c, -448.f, 448.f); d = __builtin_amdgcn_fmed3f(d, -448.f, 448.f);
    int w = 0; w = __builtin_amdgcn_cvt_pk_fp8_f32(a, b, w, false); w = __builtin_amdgcn_cvt_pk_fp8_f32(c, d, w, true); return (unsigned)w; }
struct EpiSwiGLU8 {
    static constexpr bool PERM = true, AFTER_DRAIN = false, ROWSCALE = false;
    unsigned char* O; int ldc; float oscale;
    __device__ __forceinline__ void operator()(const f32x4 (&acc)[2][2][4][2], const Unit& u, int wr, int wc, int fr, int fq) const {
        typedef unsigned u32x2 __attribute__((ext_vector_type(2)));
        const int row0 = u.pm * BM + wr * 64 + fr, col0 = u.pn * HALF + wc * 32 + 8 * fq; const float ic = 1.0f / oscale;
#pragma unroll
        for (int ai = 0; ai < 2; ++ai)
#pragma unroll
            for (int m = 0; m < 4; ++m) { f32x4 h[2];
#pragma unroll
                for (int n = 0; n < 2; ++n) { const f32x4 g = acc[ai][0][m][n], up = acc[ai][1][m][n];
#pragma unroll
                    for (int j = 0; j < 4; j += 2) {
                        const f32x2 gg = {g[j], g[j + 1]}, uu = {up[j], up[j + 1]}; const f32x2 t = gg * -1.4426950408889634f;
                        f32x2 d = {__builtin_amdgcn_exp2f(t.x), __builtin_amdgcn_exp2f(t.y)}; d = d * ic + ic;
                        const f32x2 r = {__builtin_amdgcn_rcpf(d.x), __builtin_amdgcn_rcpf(d.y)}; const f32x2 hh = (gg * uu) * r;
                        h[n][j] = hh.x; h[n][j + 1] = hh.y; } }
                u32x2 w; w.x = pk4_fp8(h[0][0], h[0][1], h[0][2], h[0][3]); w.y = pk4_fp8(h[1][0], h[1][1], h[1][2], h[1][3]);
                *(u32x2*)(O + (size_t)(row0 + ai * HALF + m * 16) * ldc + col0) = w; }
    }
};
struct EpiNsaIn {
    static constexpr bool PERM = true, AFTER_DRAIN = false, ROWSCALE = false;
    bf16_t* Q; bf16_t* KV; float* gates; const float* cosT; const float* sinT;
    __device__ __forceinline__ void operator()(const f32x4 (&acc)[2][2][4][2], const Unit& u, int wr, int wc, int fr, int fq) const {
        const int pn = u.pn, row0 = u.pm * BM + wr * 64 + fr;
        if (pn == 20) {
            if (wc == 0 || (wc == 1 && fq < 2)) {
#pragma unroll
                for (int ai = 0; ai < 2; ++ai)
#pragma unroll
                    for (int m = 0; m < 4; ++m) { float* gp = gates + (size_t)(row0 + ai * HALF + m * 16) * 48 + wc * 32 + 8 * fq;
#pragma unroll
                        for (int n = 0; n < 2; ++n) { const f32x4 a = acc[ai][0][m][n]; f32x4 s;
#pragma unroll
                            for (int j = 0; j < 4; ++j) s[j] = __builtin_amdgcn_rcpf(1.0f + __builtin_amdgcn_exp2f(-1.4426950408889634f * a[j]));
                            *(f32x4*)(gp + 4 * n) = s; } }
            }
            return;
        }
        bf16_t* base; int ldc, colt; bool rot, chunk;
        if (pn < 8) { base = Q; ldc = DM; colt = pn * BM; rot = true; chunk = false; }
        else { const int sec = (pn - 8) >> 1; base = KV + (size_t)sec * ((size_t)MTOK * 512); ldc = 512; colt = (pn & 1) * BM; rot = (sec & 1) == 0; chunk = sec < 2; }
        const bool dorot = rot && wc == 0;
#pragma unroll
        for (int ai = 0; ai < 2; ++ai)
#pragma unroll
            for (int m = 0; m < 4; ++m) { const int row = row0 + ai * HALF + m * 16, pos = row & (SEQ - 1);
                f32x4 c0, c1, s0, s1;
                if (dorot) { const float* cp = cosT + pos * 16 + 8 * (fq & 1); const float* sp = sinT + pos * 16 + 8 * (fq & 1);
                    c0 = *(const f32x4*)cp; c1 = *(const f32x4*)(cp + 4); s0 = *(const f32x4*)sp; s1 = *(const f32x4*)(sp + 4); }
#pragma unroll
                for (int bj = 0; bj < 2; ++bj) { f32x4 v0 = acc[ai][bj][m][0], v1 = acc[ai][bj][m][1];
                    if (dorot) { f32x4 o0, o1;
#pragma unroll
                        for (int j = 0; j < 4; ++j) { o0[j] = __shfl_xor(v0[j], 32); o1[j] = __shfl_xor(v1[j], 32); }
                        if (fq < 2) { v0 = v0 * c0 - o0 * s0; v1 = v1 * c1 - o1 * s1; }
                        else        { v0 = v0 * c0 + o0 * s0; v1 = v1 * c1 + o1 * s1; } }
                    const int col = colt + bj * HALF + wc * 32 + 8 * fq;
                    size_t off;
                    if (!chunk) off = (size_t)row * ldc + col;
                    else { const int b = row >> 12, t = row & (SEQ - 1), g = col >> 7, d = col & 127; off = ((size_t)((b * 256 + (t >> 4)) * 4 + g) * 16 + (t & 15)) * 128 + d; }
                    *(u32x4*)(base + off) = pack8_bf16(v0, v1); } }
    }
};
__device__ __forceinline__ float log_sigmoid_fast(float z) { const float e = __builtin_amdgcn_exp2f(-1.4426950408889634f * __builtin_fabsf(z)); return __builtin_fminf(z, 0.f) - 0.6931471805599453f * __builtin_amdgcn_logf(1.0f + e); }
struct EpiFoxIn {
    static constexpr bool PERM = true, AFTER_DRAIN = false, ROWSCALE = true;
    bf16_t* QKV; float* fl; float* tot; const float* fbias; const float* rs;
    __device__ __forceinline__ void operator()(const f32x4 (&acc)[2][2][4][2], const Unit& u, int wr, int wc, int fr, int fq) const {
        const int pn = u.pn, row0 = u.pm * BM + wr * 64 + fr;
        if (pn == 24) {
            if (wc == 0) {
                const int hb = 8 * (fq & 1); const f32x4 b0 = *(const f32x4*)(fbias + hb), b1 = *(const f32x4*)(fbias + hb + 4);
#pragma unroll
                for (int ai = 0; ai < 2; ++ai) { f32x4 s0 = (f32x4){0.f, 0.f, 0.f, 0.f}, s1 = s0;
#pragma unroll
                    for (int m = 0; m < 4; ++m) { f32x4 v0 = acc[ai][0][m][0] + b0, v1 = acc[ai][0][m][1] + b1;
#pragma unroll
                        for (int j = 0; j < 4; ++j) { v0[j] = log_sigmoid_fast(v0[j]); v1[j] = log_sigmoid_fast(v1[j]); }
                        s0 += v0; s1 += v1;
                        if (fq < 2) { float* gp = fl + (size_t)(row0 + ai * HALF + m * 16) * 16 + 8 * fq; *(f32x4*)gp = v0; *(f32x4*)(gp + 4) = v1; } }
#pragma unroll
                    for (int o = 1; o < 16; o <<= 1)
#pragma unroll
                        for (int j = 0; j < 4; ++j) { s0[j] += __shfl_xor(s0[j], o); s1[j] += __shfl_xor(s1[j], o); }
                    if (fq < 2 && fr == 0) { const int rowc = u.pm * BM + ai * HALF + wr * 64; float* tp = tot + ((size_t)((rowc >> 12) * 64 + ((rowc & (SEQ - 1)) >> 6))) * 16 + 8 * fq; *(f32x4*)tp = s0; *(f32x4*)(tp + 4) = s1; } }
            }
            return;
        }
        bf16_t* base = QKV + (size_t)(pn >> 3) * ((size_t)MTOK * DM); const int col0 = (pn & 7) * BM + wc * 32 + 8 * fq;
#pragma unroll
        for (int ai = 0; ai < 2; ++ai)
#pragma unroll
            for (int m = 0; m < 4; ++m) { bf16_t* rowp = base + (size_t)(row0 + ai * HALF + m * 16) * DM + col0;
#pragma unroll
                for (int bj = 0; bj < 2; ++bj) *(u32x4*)(rowp + bj * HALF) = pack8_bf16(acc[ai][bj][m][0], acc[ai][bj][m][1]); }
    }
};
struct EpiCmpGates {
    static constexpr bool PERM = false, AFTER_DRAIN = false, ROWSCALE = false;
    float* O; int ldc; float* gates;
    __device__ __forceinline__ void operator()(const f32x4 (&acc)[2][2][4][2], const Unit& u, int wr, int wc, int fr, int fq) const {
        const int row0 = u.pm * BM + wr * 64 + fr;
        if (u.pn >= 8) {
            if (wc < 2) {
#pragma unroll
                for (int ai = 0; ai < 2; ++ai)
#pragma unroll
                    for (int m = 0; m < 4; ++m) { float* gp = gates + (size_t)(row0 + ai * HALF + m * 16) * 48 + wc * 32 + 4 * fq;
#pragma unroll
                        for (int n = 0; n < 2; ++n) if (wc == 0 || n == 0) { const f32x4 a = acc[ai][0][m][n]; f32x4 s;
#pragma unroll
                            for (int j = 0; j < 4; ++j) s[j] = __builtin_amdgcn_rcpf(1.0f + __builtin_amdgcn_exp2f(-1.4426950408889634f * a[j]));
                            *(f32x4*)(gp + 16 * n) = s; } }
            }
            return;
        }
        const int col0 = (u.pn & 1) * BM + wc * 32 + 4 * fq;
#pragma unroll
        for (int ai = 0; ai < 2; ++ai)
#pragma unroll
            for (int m = 0; m < 4; ++m) { float* rowp = O + (size_t)(row0 + ai * HALF + m * 16) * ldc + col0;
#pragma unroll
                for (int bj = 0; bj < 2; ++bj)
#pragma unroll
                    for (int n = 0; n < 2; ++n) *(f32x4*)(rowp + bj * HALF + n * 16) = acc[ai][bj][m][n]; }
    }
};
struct CmpGateOrder {
    int G, c, aT0, bT0, hT0, gT;
    __device__ bool next(int i, Unit& u) const { const int L = i * G + c; if (L >= 256) return false;
        if (L < 128) { const int pa = L >> 1; u.pm = pa; u.pn = 2 * (pa >= 32) + (L & 1); u.pa = aT0 + pa; u.pb = bT0 + u.pn; }
        else { u.pm = L - 128; u.pn = 8; u.pa = hT0 + u.pm; u.pb = gT; }
        return true; }
    __device__ __forceinline__ void a_ready(const Unit&) const {}
    __device__ __forceinline__ void done(const Unit&) const {}
};
struct CmpOrder {
    int G, c;
    __device__ bool next(int i, Unit& u) const { const int L = i * G + c; if (L >= 128) return false; u.pa = L >> 1; u.pm = u.pa; u.pb = 2 * (u.pa >= 32) + (L & 1); u.pn = u.pb; return true; }
    __device__ __forceinline__ void a_ready(const Unit&) const {}
    __device__ __forceinline__ void done(const Unit&) const {}
};
template <bool DOWN> struct MoeOrder {
    int t0, nt, nN, G, c; int tb1, tb2, tb3, tb4, tb5, tb6, tb7;
    __device__ bool next(int i, Unit& u) const {
        const int nwg = nt * nN; const long L = (long)i * G + c; if (L >= nwg) return false;
        int wgid = (int)L; { const int q = nwg / NXCD, r = nwg % NXCD, xcd = wgid % NXCD, off = wgid / NXCD; wgid = (xcd < r ? xcd * (q + 1) : r * (q + 1) + (xcd - r) * q) + off; }
        const int nig = WGM * nN, gid = wgid / nig, fm = gid * WGM, gsz = (nt - fm) < WGM ? (nt - fm) : WGM;
        const int pl = fm + ((wgid % nig) % gsz), pn = (wgid % nig) / gsz, pg = t0 + pl;
        const int e = (pg >= tb1) + (pg >= tb2) + (pg >= tb3) + (pg >= tb4) + (pg >= tb5) + (pg >= tb6) + (pg >= tb7);
        u.pn = pn; u.pb = e * nN + pn;
        u.pa = pg; u.pm = pg;
        return true;
    }
    __device__ __forceinline__ void a_ready(const Unit&) const {}
    __device__ __forceinline__ void done(const Unit&) const {}
};

typedef int i32x8 __attribute__((ext_vector_type(8)));
typedef int i32x4_ __attribute__((ext_vector_type(4)));
template <class Epi, class Sched, bool ALIGN_EPI = false, bool SP2 = false, bool F8 = false, int SCB = 0, int SCA = 0>
__device__ __forceinline__ void gemm_phase(PG8_LAS unsigned char* lds, const Gemm g, const Sched& S, const Epi& E) {
    const int tid = threadIdx.x, wid = __builtin_amdgcn_readfirstlane(tid >> 6), lane = tid & 63, wr = wid >> 2, wc = wid & 3, fr = lane & 15, fq = lane >> 4;
    const int KB = F8 ? g.K : 2 * g.K, nt = KB / (2 * BK);
    unsigned voffA[2], voffB[2];
#pragma unroll
    for (int i = 0; i < 2; ++i) { int R, C; stage_rc(tid * 16 + i * 8192, R, C); const int Rb = Epi::PERM ? ((R & ~31) + perm32(R & 31)) : R;
        voffA[i] = (unsigned)(R * KB + C * 2); voffB[i] = (unsigned)(Rb * KB + C * 2); }
    const size_t kstep = (size_t)(BK * 2);
    const size_t hstep = (size_t)HALF * KB;
    const size_t tstep = 2 * hstep;
    const unsigned ldsw = (unsigned)wid * 1024u;
    const int aoff = lds_byte(wr * 64 + fr, fq * 8), boff = lds_byte(wc * 32 + fr, fq * 8);
#define PG8_SA(b, h) (((b) * 2 + (h)) * HTB)
#define PG8_SB(b, h) ((4 + (b) * 2 + (h)) * HTB)
#define PG8_STAGE(bufoff, gbase, voff) do { _Pragma("unroll") for (int _i = 0; _i < 2; ++_i) \
        __builtin_amdgcn_global_load_lds((const unsigned*)((const char*)(gbase) + (voff)[_i]), (PG8_LAS unsigned*)(lds + (bufoff) + ldsw + _i * 8192), 16, 0, 0); } while (0)
#define PG8_LDA(dst, b, h) do { _Pragma("unroll") for (int m = 0; m < 4; ++m) { dst[m].lo = *(const PG8_LAS i32x4_*)(lds + PG8_SA(b, h) + aoff + m * 2048); dst[m].hi = *(const PG8_LAS i32x4_*)(lds + PG8_SA(b, h) + aoff + m * 2048 + 1024); } } while (0)
#define PG8_LDB(dst, b, h) do { _Pragma("unroll") for (int n = 0; n < 2; ++n) { dst[n].lo = *(const PG8_LAS i32x4_*)(lds + PG8_SB(b, h) + boff + n * 2048); dst[n].hi = *(const PG8_LAS i32x4_*)(lds + PG8_SB(b, h) + boff + n * 2048 + 1024); } } while (0)
#define PG8_LO(v) __builtin_bit_cast(bf16x8, __builtin_shufflevector(v, v, 0, 1, 2, 3))
#define PG8_HI(v) __builtin_bit_cast(bf16x8, __builtin_shufflevector(v, v, 4, 5, 6, 7))
#define PG8_MMA(ai, bj, At, Bt) do { __builtin_amdgcn_s_setprio(1); _Pragma("unroll") for (int m = 0; m < 4; ++m) _Pragma("unroll") for (int n = 0; n < 2; ++n) { \
        if constexpr (F8) asm volatile("v_mfma_scale_f32_16x16x128_f8f6f4 %0, %1, %2, %0, %3, %4 op_sel_hi:[0,0,0]" : "+v"(acc[ai][bj][m][n]) : "v"(Bt[n]), "v"(At[m]), "v"(scb_), "v"(sca_)); \
        else { acc[ai][bj][m][n] = __builtin_amdgcn_mfma_f32_16x16x32_bf16(PG8_LO(Bt[n]), PG8_LO(At[m]), acc[ai][bj][m][n], 0, 0, 0); \
               acc[ai][bj][m][n] = __builtin_amdgcn_mfma_f32_16x16x32_bf16(PG8_HI(Bt[n]), PG8_HI(At[m]), acc[ai][bj][m][n], 0, 0, 0); } } __builtin_amdgcn_s_setprio(0); } while (0)
#define PG8_WAIT_V(n) asm volatile("s_waitcnt vmcnt(" #n ")" ::: "memory")
#define PG8_WAIT_L(n) asm volatile("s_waitcnt lgkmcnt(" #n ")" ::: "memory")
#define PG8_BAR __builtin_amdgcn_s_barrier()
#define PG8_SCHED __builtin_amdgcn_sched_barrier(0)
    Unit cur, nxt; int ui = 0;
    if (!S.next(0, cur)) return;
    f32x4 acc[2][2][4][2];
#pragma unroll
    for (int a = 0; a < 2; ++a)
#pragma unroll
        for (int b = 0; b < 2; ++b)
#pragma unroll
            for (int m = 0; m < 4; ++m)
#pragma unroll
                for (int n = 0; n < 2; ++n) acc[a][b][m][n] = (f32x4){0.f, 0.f, 0.f, 0.f};
    const int scb_ = SCB, sca_ = SCA; (void)scb_; (void)sca_;
    i32x8 At[4], B0[2], B1[2];
    const char* cA = (const char*)g.A + (size_t)cur.pa * tstep; const char* cB = (const char*)g.Bt + (size_t)cur.pb * tstep;
    S.a_ready(cur);
    if constexpr (SP2) {
        PG8_STAGE(PG8_SB(0, 0), cB, voffB); PG8_STAGE(PG8_SB(0, 1), cB + hstep, voffB); PG8_STAGE(PG8_SA(0, 0), cA, voffA); PG8_STAGE(PG8_SA(0, 1), cA + hstep, voffA);
        if (wr == 1) PG8_BAR;
        PG8_WAIT_V(2); PG8_BAR;
        PG8_STAGE(PG8_SB(1, 0), cB + kstep, voffB); PG8_STAGE(PG8_SA(1, 0), cA + kstep, voffA); PG8_STAGE(PG8_SB(1, 1), cB + hstep + kstep, voffB);
        PG8_WAIT_V(6); PG8_BAR;
    } else {
        PG8_STAGE(PG8_SB(0, 0), cB, voffB); PG8_STAGE(PG8_SA(0, 0), cA, voffA); PG8_STAGE(PG8_SB(0, 1), cB + hstep, voffB); PG8_STAGE(PG8_SA(0, 1), cA + hstep, voffA);
        if (wr == 1) PG8_BAR;
        PG8_WAIT_V(4); PG8_BAR;
        PG8_STAGE(PG8_SB(1, 0), cB + kstep, voffB); PG8_STAGE(PG8_SA(1, 0), cA + kstep, voffA); PG8_STAGE(PG8_SB(1, 1), cB + hstep + kstep, voffB);
        PG8_WAIT_V(6); PG8_BAR;
    }
    for (;;) {
        const bool has_next = S.next(ui + 1, nxt);
        const char* nA = has_next ? (const char*)g.A + (size_t)nxt.pa * tstep : cA; const char* nB = has_next ? (const char*)g.Bt + (size_t)nxt.pb * tstep : cB;
        for (int t = 0; t < nt; t += 2) {
            const bool last = (t == nt - 2);
            const char* a1 = cA + (size_t)(t + 1) * kstep;
            const char* a2 = last ? nA : cA + (size_t)(t + 2) * kstep; const char* b2 = last ? nB : cB + (size_t)(t + 2) * kstep;
            const char* a3 = a2 + kstep; const char* b3 = b2 + kstep;
            if (last && has_next) S.a_ready(nxt);
            if constexpr (SP2) {
            PG8_LDB(B0, 0, 0); PG8_LDB(B1, 0, 1); PG8_SCHED; PG8_LDA(At, 0, 0); PG8_STAGE(PG8_SA(1, 1), a1 + hstep, voffA);
            PG8_WAIT_V(8); PG8_WAIT_L(0); PG8_BAR; PG8_MMA(0, 0, At, B0); PG8_MMA(0, 1, At, B1); PG8_BAR; PG8_SCHED;
            PG8_LDA(At, 0, 1); PG8_STAGE(PG8_SB(0, 0), b2, voffB); PG8_STAGE(PG8_SB(0, 1), b2 + hstep, voffB); PG8_STAGE(PG8_SA(0, 0), a2, voffA);
            PG8_WAIT_V(8); PG8_WAIT_L(0); PG8_BAR; PG8_MMA(1, 0, At, B0); PG8_MMA(1, 1, At, B1); PG8_BAR; PG8_SCHED;
            PG8_LDB(B0, 1, 0); PG8_LDB(B1, 1, 1); PG8_SCHED; PG8_LDA(At, 1, 0); PG8_STAGE(PG8_SA(0, 1), a2 + hstep, voffA);
            PG8_WAIT_V(8); PG8_WAIT_L(0); PG8_BAR; PG8_MMA(0, 0, At, B0); PG8_MMA(0, 1, At, B1); PG8_BAR; PG8_SCHED;
            PG8_LDA(At, 1, 1); PG8_STAGE(PG8_SB(1, 0), b3, voffB); PG8_STAGE(PG8_SB(1, 1), b3 + hstep, voffB); PG8_STAGE(PG8_SA(1, 0), a3, voffA);
            PG8_WAIT_V(8); PG8_WAIT_L(0); PG8_BAR; PG8_MMA(1, 0, At, B0); PG8_MMA(1, 1, At, B1); PG8_BAR; PG8_SCHED;
            } else {
            PG8_LDB(B0, 0, 0); PG8_SCHED; PG8_LDA(At, 0, 0); PG8_STAGE(PG8_SA(1, 1), a1 + hstep, voffA);
            PG8_WAIT_L(8); PG8_BAR; PG8_WAIT_L(0); PG8_MMA(0, 0, At, B0); PG8_BAR; PG8_SCHED;
            PG8_LDB(B1, 0, 1); PG8_STAGE(PG8_SB(0, 0), b2, voffB);
            PG8_BAR; PG8_WAIT_L(0); PG8_MMA(0, 1, At, B1); PG8_BAR;
            PG8_LDA(At, 0, 1); PG8_STAGE(PG8_SA(0, 0), a2, voffA);
            PG8_BAR; PG8_WAIT_L(0); PG8_MMA(1, 0, At, B0); PG8_BAR; PG8_SCHED;
            PG8_STAGE(PG8_SB(0, 1), b2 + hstep, voffB);
            PG8_WAIT_V(6); PG8_BAR; PG8_MMA(1, 1, At, B1); PG8_BAR;
            PG8_LDB(B0, 1, 0); PG8_SCHED; PG8_LDA(At, 1, 0); PG8_STAGE(PG8_SA(0, 1), a2 + hstep, voffA);
            PG8_WAIT_L(8); PG8_BAR; PG8_WAIT_L(0); PG8_MMA(0, 0, At, B0); PG8_BAR; PG8_SCHED;
            PG8_LDB(B1, 1, 1); PG8_STAGE(PG8_SB(1, 0), b3, voffB);
            PG8_BAR; PG8_WAIT_L(0); PG8_MMA(0, 1, At, B1); PG8_BAR;
            PG8_LDA(At, 1, 1); PG8_STAGE(PG8_SA(1, 0), a3, voffA);
            PG8_BAR; PG8_WAIT_L(0); PG8_MMA(1, 0, At, B0); PG8_BAR; PG8_SCHED;
            PG8_STAGE(PG8_SB(1, 1), b3 + hstep, voffB);
            PG8_WAIT_V(6); PG8_BAR; PG8_MMA(1, 1, At, B1); PG8_BAR;
            }
        }
        if constexpr (ALIGN_EPI) { if (wr == 0) PG8_BAR; }
        if constexpr (F8) asm volatile("s_nop 15\n\ts_nop 15" ::: "memory");
        if constexpr (Epi::ROWSCALE) {
            const float* rp = E.rs + cur.pm * BM + wr * 64 + fr;
#pragma unroll
            for (int a = 0; a < 2; ++a)
#pragma unroll
                for (int m = 0; m < 4; ++m) { const float s_ = rp[a * HALF + m * 16];
#pragma unroll
                    for (int b = 0; b < 2; ++b)
#pragma unroll
                        for (int n = 0; n < 2; ++n) acc[a][b][m][n] *= s_; } }
        if constexpr (!Epi::AFTER_DRAIN) { E(acc, cur, wr, wc, fr, fq); S.done(cur); }
        if (!has_next) break;
#pragma unroll
        for (int a = 0; a < 2; ++a)
#pragma unroll
            for (int b = 0; b < 2; ++b)
#pragma unroll
                for (int m = 0; m < 4; ++m)
#pragma unroll
                    for (int n = 0; n < 2; ++n) acc[a][b][m][n] = (f32x4){0.f, 0.f, 0.f, 0.f};
        cur = nxt; cA = nA; cB = nB; ++ui;
        if constexpr (ALIGN_EPI) { if (wr == 1) PG8_BAR; }
    }
    PG8_WAIT_V(0);
    if constexpr (!ALIGN_EPI) { if (wr == 0) PG8_BAR; }
    PG8_BAR;
    if constexpr (Epi::AFTER_DRAIN) { E.fused(acc, cur, wr, wc, fr, fq, lds, wid, lane); S.done(cur); }
#undef PG8_SA
#undef PG8_SB
#undef PG8_STAGE
#undef PG8_LDA
#undef PG8_LDB
#undef PG8_MMA
#undef PG8_WAIT_V
#undef PG8_WAIT_L
#undef PG8_BAR
#undef PG8_SCHED
}
}

namespace att {
typedef unsigned short bf16;
typedef short bf16x8 __attribute__((ext_vector_type(8)));
typedef short s16x4 __attribute__((ext_vector_type(4)));
typedef float f32x16 __attribute__((ext_vector_type(16)));
typedef float f32x4 __attribute__((ext_vector_type(4)));
typedef unsigned u32x4 __attribute__((ext_vector_type(4)));
constexpr int D = 128, NW = 8, QBLK = 32, KVBLK = 64, QB = NW * QBLK;
constexpr int SHM_V = KVBLK * D * 2, SHM_K = KVBLK * D * 2;
constexpr float SCALE = 0.08838834764831845f, THR = 8.f;
constexpr int WS_OFF = 2 * SHM_V + 2 * SHM_K, CB_OFF = WS_OFF + NW * 128 * 4, OT_OFF = CB_OFF + 512, OT_PITCH = 272, OT_WAVE = 32 * OT_PITCH, ATT_LDS = OT_OFF + NW * OT_WAVE;
enum { MODE_WIN = 0, MODE_SLC = 1, MODE_FOX = 2 };

#define KSWZ(row, colB) ((row) * 256 + ((colB) ^ (((row) & 15) << 4)))
#define SBAR() __builtin_amdgcn_sched_barrier(0)
__device__ __forceinline__ int v_st(int k, int c) { const int kk = (k & ~0xC) | ((k & 4) << 1) | ((k & 8) >> 1); return ((kk >> 3) * 4 + (c >> 5)) * 512 + ((kk & 7) * 32 + (c & 31)) * 2; }
__device__ __forceinline__ int v_rd_base(int lane) { return ((lane & 3) << 3) | (((lane >> 2) & 3) << 6) | (((lane >> 4) & 1) << 5) | (((lane >> 5) & 1) << 8); }
constexpr int v_rd_off(int d0, int ks, int half) { return d0 * 512 + ks * 4096 + half * 2048; }
__device__ __forceinline__ int crow(int r, int hi) { return (r & 3) + 8 * (r >> 2) + 4 * hi; }
__device__ __forceinline__ unsigned cvtpk(float lo, float hi) { unsigned r; asm volatile("v_cvt_pk_bf16_f32 %0, %1, %2" : "=v"(r) : "v"(lo), "v"(hi)); return r; }
__device__ __forceinline__ bf16x8 load8(const bf16* p) { return *reinterpret_cast<const bf16x8*>(p); }
__device__ __forceinline__ float bf_lo(unsigned w) { return __uint_as_float(w << 16); }
__device__ __forceinline__ float bf_hi(unsigned w) { return __uint_as_float(w & 0xffff0000u); }
__device__ __forceinline__ void mask_tile(f32x16& p0, f32x16& p1, int dq, unsigned W) {
    const float NEG = -__builtin_inff();
#pragma unroll
    for (int r = 0; r < 16; ++r) {
        const int c = (r & 3) + 8 * (r >> 2);
        if ((unsigned)(dq - c) >= W) p0[r] = NEG;
        if ((unsigned)(dq - c - 32) >= W) p1[r] = NEG;
    }
}
template <bool RS>
__device__ __forceinline__ void partialSM(f32x16& p0, f32x16& p1, float& m_reg, float& mn, float& alpha, bool sel) {
    float pmax = p0[0]; for (int r = 1; r < 16; ++r) pmax = fmaxf(pmax, p0[r]); for (int r = 0; r < 16; ++r) pmax = fmaxf(pmax, p1[r]);
    { auto rr = __builtin_amdgcn_permlane32_swap(__float_as_uint(pmax), __float_as_uint(pmax), false, false);
      pmax = fmaxf(__uint_as_float(rr[0]), __uint_as_float(rr[1])); }
    if (RS) pmax = sel ? pmax : -__builtin_inff();
    constexpr float C2 = 1.4426950408889634f * SCALE;
    if (__builtin_expect(__all((pmax - m_reg) * SCALE <= THR), 1)) { mn = m_reg; alpha = 1.f; }
    else { mn = fmaxf(m_reg, pmax); alpha = __builtin_amdgcn_exp2f((m_reg - mn) * C2); m_reg = mn; }
    float mnL = -mn * C2;
    if (RS) mnL = sel ? mnL : -__builtin_inff();
    for (int r = 0; r < 16; ++r) p0[r] = fmaf(p0[r], C2, mnL); for (int r = 0; r < 16; ++r) p1[r] = fmaf(p1[r], C2, mnL);
    for (int r = 0; r < 16; ++r) p0[r] = __builtin_amdgcn_exp2f(p0[r]);
}
#define ATT_PK4(P, B_, OUT) do { unsigned a0 = cvtpk(P[B_+0], P[B_+1]), a1 = cvtpk(P[B_+2], P[B_+3]);                          \
        unsigned b0 = cvtpk(P[B_+4], P[B_+5]), b1 = cvtpk(P[B_+6], P[B_+7]);                                             \
        auto r0 = __builtin_amdgcn_permlane32_swap(a0, b0, false, false); auto r1 = __builtin_amdgcn_permlane32_swap(a1, b1, false, false); \
        u32x4 w = {r0[0], r1[0], r0[1], r1[1]}; OUT = *reinterpret_cast<bf16x8*>(&w); } while (0)
__device__ __forceinline__ void finishSM(f32x16& p0, f32x16& p1, float alpha, float& l_reg, bf16x8& pa0, bf16x8& pa1, bf16x8& pa2, bf16x8& pa3) {
    for (int r = 0; r < 16; ++r) p1[r] = __builtin_amdgcn_exp2f(p1[r]);
    float ps = 0; for (int r = 0; r < 16; ++r) ps += p0[r]; for (int r = 0; r < 16; ++r) ps += p1[r];
    { auto rr = __builtin_amdgcn_permlane32_swap(__float_as_uint(ps), __float_as_uint(ps), false, false);
      ps = __uint_as_float(rr[0]) + __uint_as_float(rr[1]); }
    l_reg = l_reg * alpha + ps;
    ATT_PK4(p0, 0, pa0); ATT_PK4(p0, 8, pa1); ATT_PK4(p1, 0, pa2); ATT_PK4(p1, 8, pa3);
}
template <int KB, int MODE>
__device__ __forceinline__ void qkt(f32x16& p0, f32x16& p1, const char* K_lds, const char* C_lds, int r32, int hi, const bf16x8* qr, float cq, int tk = 0) {
    if (MODE == MODE_FOX) {
        const char* cb = C_lds + KB * 256 + hi * 16;
#pragma unroll
        for (int i = 0; i < 4; ++i) { const f32x4 a = *reinterpret_cast<const f32x4*>(cb + i * 32); const f32x4 b = *reinterpret_cast<const f32x4*>(cb + 128 + i * 32);
#pragma unroll
            for (int j = 0; j < 4; ++j) { p0[4 * i + j] = a[j]; p1[4 * i + j] = b[j]; } }
    } else { p0 = f32x16{}; p1 = f32x16{}; }
    typedef const __attribute__((address_space(3))) bf16x8* lds_b8p;
    unsigned ka = 0; int ko[4] = {0, 0, 0, 0}, flip = 128;
    if (MODE == MODE_WIN) {
#pragma unroll
        for (int dd = 0; dd < 4; ++dd) ko[dd] = KSWZ(r32, (dd * 16 + hi * 8) * 2);
        asm volatile("" : "+v"(flip));
    } else {
        ka = (unsigned)(uintptr_t)(const __attribute__((address_space(3))) char*)K_lds + KSWZ(r32, hi * 16);
        asm("" : "+v"(ka) : "s"(tk));
    }
#pragma unroll
    for (int d0 = 0; d0 < 8; ++d0) {
        bf16x8 b0, b1;
        if (MODE == MODE_WIN) { const char* a = K_lds + KB * SHM_K + (d0 < 4 ? ko[d0] : (ko[d0 & 3] ^ flip));
            b0 = *reinterpret_cast<const bf16x8*>(a); b1 = *reinterpret_cast<const bf16x8*>(a + 32 * 256);
        } else { const unsigned a = (ka ^ (unsigned)(d0 * 32)) + KB * SHM_K;
            b0 = *(lds_b8p)(uintptr_t)a; b1 = *(lds_b8p)(uintptr_t)(a + 32 * 256); }
        p0 = __builtin_amdgcn_mfma_f32_32x32x16_bf16(b0, qr[d0], p0, 0, 0, 0);
        p1 = __builtin_amdgcn_mfma_f32_32x32x16_bf16(b1, qr[d0], p1, 0, 0, 0); }
}
template <int VB>
__device__ __forceinline__ void pv_tile(f32x16* o, int vb0, bf16x8 pa0, bf16x8 pa1, bf16x8 pa2, bf16x8 pa3) {
#define TRRD(dst, off) asm volatile("ds_read_b64_tr_b16 %0, %1 offset:%2" : "=&v"(dst) : "v"(vb0), "i"(off) : "memory")
#define PV_D0(d0) do { s16x4 l0, l1, l2, l3, h0, h1, h2, h3; constexpr int b_ = VB * SHM_V + v_rd_off(d0, 0, 0);   \
        TRRD(l0, b_); TRRD(h0, b_ + 2048); TRRD(l1, b_ + 4096); TRRD(h1, b_ + 6144); TRRD(l2, b_ + 8192); TRRD(h2, b_ + 10240); TRRD(l3, b_ + 12288); TRRD(h3, b_ + 14336); \
        asm volatile("s_waitcnt lgkmcnt(0)" ::: "memory"); SBAR();   \
        o[d0] = __builtin_amdgcn_mfma_f32_32x32x16_bf16(pa0, (bf16x8){l0[0], l0[1], l0[2], l0[3], h0[0], h0[1], h0[2], h0[3]}, o[d0], 0, 0, 0);   \
        o[d0] = __builtin_amdgcn_mfma_f32_32x32x16_bf16(pa1, (bf16x8){l1[0], l1[1], l1[2], l1[3], h1[0], h1[1], h1[2], h1[3]}, o[d0], 0, 0, 0);   \
        o[d0] = __builtin_amdgcn_mfma_f32_32x32x16_bf16(pa2, (bf16x8){l2[0], l2[1], l2[2], l2[3], h2[0], h2[1], h2[2], h2[3]}, o[d0], 0, 0, 0);   \
        o[d0] = __builtin_amdgcn_mfma_f32_32x32x16_bf16(pa3, (bf16x8){l3[0], l3[1], l3[2], l3[3], h3[0], h3[1], h3[2], h3[3]}, o[d0], 0, 0, 0); } while (0)
    PV_D0(0); PV_D0(1); PV_D0(2); PV_D0(3);
#undef PV_D0
#undef TRRD
}

template <int VB, bool RS>
__device__ __forceinline__ void pv_sm_tile(f32x16* o, int vb0, bf16x8 pa0, bf16x8 pa1, bf16x8 pa2, bf16x8 pa3, f32x16& p0, f32x16& p1, float& m_reg, float& mn, float& alpha, bool sel) {
#define TRRD(dst, off) asm volatile("ds_read_b64_tr_b16 %0, %1 offset:%2" : "=&v"(dst) : "v"(vb0), "i"(off) : "memory")
#define PV_RD(g) s16x4 l0##g, l1##g, l2##g, l3##g, h0##g, h1##g, h2##g, h3##g; { constexpr int b_ = VB * SHM_V + v_rd_off(g, 0, 0);   \
        TRRD(l0##g, b_); TRRD(h0##g, b_ + 2048); TRRD(l1##g, b_ + 4096); TRRD(h1##g, b_ + 6144); TRRD(l2##g, b_ + 8192); TRRD(h2##g, b_ + 10240); TRRD(l3##g, b_ + 12288); TRRD(h3##g, b_ + 14336); }
#define PV_WT() do { asm volatile("s_waitcnt lgkmcnt(0)" ::: "memory"); SBAR(); } while (0)
#define PV_MM(g) do {   \
        o[g] = __builtin_amdgcn_mfma_f32_32x32x16_bf16(pa0, (bf16x8){l0##g[0], l0##g[1], l0##g[2], l0##g[3], h0##g[0], h0##g[1], h0##g[2], h0##g[3]}, o[g], 0, 0, 0);   \
        o[g] = __builtin_amdgcn_mfma_f32_32x32x16_bf16(pa1, (bf16x8){l1##g[0], l1##g[1], l1##g[2], l1##g[3], h1##g[0], h1##g[1], h1##g[2], h1##g[3]}, o[g], 0, 0, 0);   \
        o[g] = __builtin_amdgcn_mfma_f32_32x32x16_bf16(pa2, (bf16x8){l2##g[0], l2##g[1], l2##g[2], l2##g[3], h2##g[0], h2##g[1], h2##g[2], h2##g[3]}, o[g], 0, 0, 0);   \
        o[g] = __builtin_amdgcn_mfma_f32_32x32x16_bf16(pa3, (bf16x8){l3##g[0], l3##g[1], l3##g[2], l3##g[3], h3##g[0], h3##g[1], h3##g[2], h3##g[3]}, o[g], 0, 0, 0); } while (0)
    constexpr float C2 = 1.4426950408889634f * SCALE;
    PV_RD(0); PV_WT();
    PV_MM(0); PV_RD(1);
    float pmax = p0[0];
#pragma unroll
    for (int r = 1; r < 16; ++r) pmax = fmaxf(pmax, p0[r]);
#pragma unroll
    for (int r = 0; r < 16; ++r) pmax = fmaxf(pmax, p1[r]);
    { auto rr = __builtin_amdgcn_permlane32_swap(__float_as_uint(pmax), __float_as_uint(pmax), false, false);
      pmax = fmaxf(__uint_as_float(rr[0]), __uint_as_float(rr[1])); }
    if (RS) pmax = sel ? pmax : -__builtin_inff();
    PV_WT();
    PV_MM(1); PV_RD(2);
    { const bool keep = __all((pmax - m_reg) * SCALE <= THR);
      mn = keep ? m_reg : fmaxf(m_reg, pmax); alpha = __builtin_amdgcn_exp2f((m_reg - mn) * C2); m_reg = mn; }
    float mnL = -mn * C2;
    if (RS) mnL = sel ? mnL : -__builtin_inff();
#pragma unroll
    for (int r = 0; r < 16; ++r) p0[r] = fmaf(p0[r], C2, mnL);
#pragma unroll
    for (int r = 0; r < 16; ++r) p1[r] = fmaf(p1[r], C2, mnL);
    asm volatile("" : "+v"(p0), "+v"(p1));
    PV_WT();
    PV_MM(2); PV_RD(3);
#pragma unroll
    for (int r = 0; r < 8; ++r) p0[r] = __builtin_amdgcn_exp2f(p0[r]);
    asm volatile("" : "+v"(p0));
    PV_WT();
    PV_MM(3);
#pragma unroll
    for (int r = 8; r < 16; ++r) p0[r] = __builtin_amdgcn_exp2f(p0[r]);
    asm volatile("" : "+v"(p0));
#undef PV_MM
#undef PV_WT
#undef PV_RD
#undef TRRD
}

struct BlockRef { const bf16* Q; const bf16* K; const bf16* V; bf16* O; int P0; const float* aux; const unsigned long long* selm; };
struct Seam { bf16x8 qr[8]; bf16x8 st_v0, st_v1, st_k0, st_k1; float st_c; };
__device__ __forceinline__ int swa_jlo(int P0, int W) { const int lowk = P0 - W + 1; return lowk > 0 ? lowk / KVBLK : 0; }
template <int MODE, bool GQA>
__device__ __forceinline__ int first_kb(int P0, int W, int skv) {
    if (MODE == MODE_WIN) return swa_jlo(P0, W) * KVBLK;
    int jh = (P0 + (GQA ? 2 * QBLK : QB) - 1) / KVBLK + 1; if (jh > skv / KVBLK) jh = skv / KVBLK; return (jh - 1) * KVBLK; }
#define ROW(p, k0, hf) ((p) + (size_t)(((k0) + 32 * (hf)) * KS) + lane_off)
#define VMW() asm volatile("s_waitcnt vmcnt(0)" ::: "memory")
#define VMWN(n) asm volatile("s_waitcnt vmcnt(%0)" :: "i"(n) : "memory")
#define SLOAD_K(Kp, Cp, k0) do { S.st_k0 = load8(ROW(Kp, k0, 0)); S.st_k1 = load8(ROW(Kp, k0, 1));                  \
                         if (MODE == MODE_FOX) { if (tid < 64) S.st_c = (Cp)[(k0) + tid]; } } while (0)
#define SLOAD_V(Vp, k0) do { S.st_v0 = load8(ROW(Vp, k0, 0)); S.st_v1 = load8(ROW(Vp, k0, 1)); } while (0)
#define SLOAD_H(Kp, Vp, Cp, k0) do { SLOAD_K(Kp, Cp, k0); SLOAD_V(Vp, k0); } while (0)
#define SWRITE_HK(bf) do { *(bf16x8*)(K_lds + (bf) * SHM_K + kws) = S.st_k0; *(bf16x8*)(K_lds + (bf) * SHM_K + kws + 32 * 256) = S.st_k1;   \
                         if (MODE == MODE_FOX) { if (tid < 64) *reinterpret_cast<float*>(C_lds + (bf) * 256 + tid * 4) = -S.st_c; } } while (0)
#define SWRITE_HV(bf) do { *(bf16x8*)(V_lds + (bf) * SHM_V + vst0) = S.st_v0; *(bf16x8*)(V_lds + (bf) * SHM_V + vst1) = S.st_v1; } while (0)
#define SWRITE_H(bf) do { SWRITE_HV(bf); SWRITE_HK(bf); } while (0)
template <int MODE, int QS, int KS, bool GQA>
__device__ __forceinline__ void att_prime(const BlockRef& cur, int skv, int W, char* lds, Seam& S) {
    const int tid = threadIdx.x, wid = __builtin_amdgcn_readfirstlane(tid >> 6), lane = tid & 63, r32 = lane & 31, hi = lane >> 5;
    const int sr = tid >> 4, sc = (tid & 15) * 8, kws = KSWZ(sr, sc * 2); char* K_lds = lds + 2 * SHM_V; char* C_lds = lds + CB_OFF; const unsigned lane_off = (unsigned)(sr * KS + sc);
    const int kb0 = first_kb<MODE, GQA>(cur.P0, W, skv);
#pragma unroll
    for (int d0 = 0; d0 < 8; ++d0) S.qr[d0] = load8(cur.Q + (unsigned)((GQA ? ((wid & 1) * QBLK + r32) * QS + (wid >> 1) * D : (wid * QBLK + r32) * QS) + d0 * 16 + hi * 8));
    SLOAD_H(cur.K, cur.V, cur.aux, kb0); VMW(); SWRITE_HK(0);
    __syncthreads();
}
template <int MODE, int QS, int KS, int OS, bool ACCUM, bool GQA>
__device__ __forceinline__ void att_block(const BlockRef& cur, const BlockRef& nxt, int skv, int W, char* lds, Seam& S) {
    constexpr bool RS = MODE == MODE_SLC, AHEAD = MODE == MODE_FOX;
    const int tid = threadIdx.x, wid = __builtin_amdgcn_readfirstlane(tid >> 6), lane = tid & 63, r32 = lane & 31, hi = lane >> 5;
    const int j_lo = swa_jlo(cur.P0, W);
    constexpr int TOKB = GQA ? 2 * QBLK : QB;
    int j_hi = (cur.P0 + TOKB - 1) / KVBLK + 1; if (j_hi > skv / KVBLK) j_hi = skv / KVBLK;
    const int rowt = GQA ? (wid & 1) * QBLK : wid * QBLK;
    const int NT = j_hi - j_lo;
    const int kbn = first_kb<MODE, GQA>(nxt.P0, W, skv);
    const int qlo = cur.P0 + rowt, qm = qlo + r32 - 4 * hi;
    char* V_lds = lds; char* K_lds = lds + 2 * SHM_V; char* C_lds = lds + CB_OFF;
    float* ws = (float*)(lds + WS_OFF) + wid * 128; float* li_l = ws, * al_l = ws + 32; unsigned long long* rm_l = (unsigned long long*)(ws + 64);
    float m_reg = -1e30f, l_reg = 0; f32x16 o[4] = {};
    const int sr = tid >> 4, sc = (tid & 15) * 8, vst0 = v_st(sr, sc), vst1 = vst0 + 8192  , kws = KSWZ(sr, sc * 2); const unsigned lane_off = (unsigned)(sr * KS + sc);
    const int vb0 = (int)(uintptr_t)V_lds + v_rd_base(lane);
    const bf16* Kh = cur.K; const bf16* Vh = cur.V; const float* Ch = cur.aux;
    float cq = 0.f, gate = 1.f; unsigned long long rmask;
    if (MODE != MODE_FOX) { gate = cur.aux[(unsigned)((rowt + r32) * 48 + (GQA ? (wid >> 1) : 0))]; if (hi == 0) li_l[r32] = gate; }
    if (MODE == MODE_SLC) { rmask = cur.selm[rowt + r32]; if (hi == 0) rm_l[r32] = rmask; }
#define RESC(a) do { if (__any((a) < 1.f)) { if (hi == 0) al_l[r32] = (a); asm volatile("s_waitcnt lgkmcnt(0)" ::: "memory");              \
                     for (int d_ = 0; d_ < 4; ++d_) for (int r = 0; r < 16; ++r) o[d_][r] *= al_l[crow(r, hi)]; } } while (0)
#define TILE(t) (MODE != MODE_WIN ? j_hi - 1 - (t) : j_lo + (t))
#define KBASE(t) (TILE(t) * KVBLK)
#define SEL(t) (MODE == MODE_SLC ? (((rm_l[r32] >> TILE(t)) & 1ull) != 0ull) : true)
#define MASKT(P0_, P1_, t) do { const int kb_ = KBASE(t); if (kb_ + KVBLK - 1 > qlo || kb_ <= qlo + QBLK - 1 - W) mask_tile(P0_, P1_, qm - kb_, (unsigned)W); } while (0)
#define SEAM_K0() do { if constexpr (ACCUM) VMWN(16); else VMWN(8); SWRITE_HK(0); SBAR(); } while (0)
    f32x16 pA0, pA1, pB0, pB1; float mnA, mnB, alA, alB; bf16x8 pa0, pa1, pa2, pa3;
    SWRITE_HV(0); SBAR();
    if (NT > 1) SLOAD_H(Kh, Vh, Ch, KBASE(1));
    SBAR(); qkt<0, MODE>(pA0, pA1, K_lds, C_lds, r32, hi, S.qr, cq);
    MASKT(pA0, pA1, 0); partialSM<RS>(pA0, pA1, m_reg, mnA, alA, SEL(0));
    if (NT > 1) { if constexpr (AHEAD) { SWRITE_HK(1); if (NT > 2) SLOAD_K(Kh, Ch, KBASE(2)); } else { VMW(); SWRITE_H(1); } }
    __syncthreads();
#define HALF_STEP(PX0, PX1, mnX, alX, PY0, PY1, alY, t, KB, VB, SB) do {                                                      \
        SBAR(); qkt<KB, MODE>(PX0, PX1, K_lds, C_lds, r32, hi, S.qr, cq, (t));                                                     \
        finishSM(PY0, PY1, alY, l_reg, pa0, pa1, pa2, pa3); SBAR();                                                           \
        if constexpr (AHEAD) { SWRITE_HV(KB); if ((t) + 1 < NT) { SLOAD_V(Vh, KBASE((t) + 1)); } SBAR(); }                    \
        else if ((t) + 1 < NT) { SLOAD_H(Kh, Vh, Ch, KBASE((t) + 1)); SBAR(); }                                               \
        MASKT(PX0, PX1, (t)); SBAR(); pv_sm_tile<VB, RS>(o, vb0, pa0, pa1, pa2, pa3, PX0, PX1, m_reg, mnX, alX, SEL(t));          \
        if constexpr (AHEAD) { if ((t) + 1 < NT) SWRITE_HK(SB); if ((t) + 2 < NT) SLOAD_K(Kh, Ch, KBASE((t) + 2)); }          \
        else if ((t) + 1 < NT) { VMWN(2); SWRITE_HK(SB); }     \
        __syncthreads();                                               \
        if constexpr (!AHEAD) { if ((t) + 1 < NT) { VMW(); SWRITE_HV(SB); } }     \
        RESC(alX); } while (0)
    for (int t = 1; t + 1 < NT; t += 2) {
        HALF_STEP(pB0, pB1, mnB, alB, pA0, pA1, alA, t, 1, 0, 0);
        HALF_STEP(pA0, pA1, mnA, alA, pB0, pB1, alB, t + 1, 0, 1, 1);
    }
    const bool even = (NT & 1) == 0;
    if (even) { SBAR(); qkt<1, MODE>(pB0, pB1, K_lds, C_lds, r32, hi, S.qr, cq, NT); if constexpr (AHEAD) SWRITE_HV(1); SBAR(); }
    SLOAD_H(nxt.K, nxt.V, nxt.aux, kbn); SBAR();
#pragma unroll
    for (int d0 = 0; d0 < 8; ++d0) S.qr[d0] = load8(nxt.Q + (unsigned)((GQA ? (rowt + r32) * QS + (wid >> 1) * D : (rowt + r32) * QS) + d0 * 16 + hi * 8));
    bf16* Ow = cur.O + (GQA ? (unsigned)(rowt * OS + (wid >> 1) * D) : (unsigned)(rowt * OS));
    u32x4 oldv[8];
    if constexpr (ACCUM) {
#pragma unroll
        for (int j = 0; j < 8; ++j) oldv[j] = *(const u32x4*)(Ow + (size_t)(j * 4 * OS) + (unsigned)((lane >> 4) * OS + (lane & 15) * 8)); }
    SBAR();
    finishSM(pA0, pA1, alA, l_reg, pa0, pa1, pa2, pa3); SBAR();
    pv_tile<0>(o, vb0, pa0, pa1, pa2, pa3);
    if (even) { MASKT(pB0, pB1, NT - 1); partialSM<RS>(pB0, pB1, m_reg, mnB, alB, SEL(NT - 1)); __syncthreads(); RESC(alB);
        finishSM(pB0, pB1, alB, l_reg, pa0, pa1, pa2, pa3); SBAR(); pv_tile<1>(o, vb0, pa0, pa1, pa2, pa3); }
    SBAR(); SEAM_K0();
    if (hi == 0) li_l[r32] = (MODE == MODE_FOX ? 1.f : li_l[r32]) / l_reg; asm volatile("s_waitcnt lgkmcnt(0)" ::: "memory");
    float rli[16];
#pragma unroll
    for (int r = 0; r < 16; ++r) rli[r] = li_l[crow(r, hi)];
    if constexpr (ACCUM) {
    int lane_e = lane; asm volatile("" : "+v"(lane_e));
    const int r32e = lane_e & 31, hie = lane_e >> 5;
    char* ot = lds + OT_OFF + wid * OT_WAVE;
    char* otw = ot + hie * (4 * OT_PITCH) + r32e * 2;
#pragma unroll
    for (int r = 0; r < 16; ++r) { const int cr = (r & 3) + 8 * (r >> 2);
#pragma unroll
        for (int d0 = 0; d0 < 4; ++d0) { const float v = o[d0][r] * rli[r]; const float vn = __shfl_xor(v, 1);
            if ((r32e & 1) == 0) *(unsigned*)(otw + cr * OT_PITCH + d0 * 64) = cvtpk(v, vn); } }
    asm volatile("s_waitcnt lgkmcnt(0)" ::: "memory");
    const char* otr = ot + (lane_e >> 4) * OT_PITCH + (lane_e & 15) * 16;
    const unsigned goff = (unsigned)((lane_e >> 4) * OS + (lane_e & 15) * 8);
#pragma unroll
    for (int j = 0; j < 8; ++j) {
        u32x4 w = *(const u32x4*)(otr + j * 4 * OT_PITCH); u32x4* gp = (u32x4*)(Ow + (size_t)(j * 4 * OS) + goff);
        if (ACCUM) { const u32x4 old = oldv[j];
#pragma unroll
            for (int e = 0; e < 4; ++e) w[e] = cvtpk(bf_lo(w[e]) + bf_lo(old[e]), bf_hi(w[e]) + bf_hi(old[e])); }
        *gp = w; }
    } else {
#pragma unroll
        for (int r = 0; r < 16; ++r) { const int orow = crow(r, hi);
#pragma unroll
            for (int d0 = 0; d0 < 4; ++d0) { const float v = o[d0][r] * rli[r]; const float vn = __shfl_xor(v, 1);
                if ((r32 & 1) == 0) *(unsigned*)(Ow + (unsigned)(orow * OS + d0 * 32 + r32)) = cvtpk(v, vn); } }
    }
    __syncthreads();
#undef RESC
#undef KBASE
#undef TILE
#undef SEL
#undef MASKT
#undef SEAM_K0
#undef HALF_STEP
}
#undef ROW
#undef VMWN
#undef SLOAD_H
#undef SWRITE_HK
#undef SWRITE_HV
#undef SWRITE_H

struct AttnPtrs { const bf16* Q; const bf16* K; const bf16* V; bf16* O; const float* aux; const unsigned long long* selm; };
template <int MODE, int KS, bool GQA>
__device__ __forceinline__ BlockRef att_ref(const AttnPtrs& P, int b, int h, int qb) {
    constexpr int TOKB = GQA ? 2 * QBLK : QB;
    BlockRef r; const size_t row0 = (size_t)b * SEQ + (size_t)qb * TOKB;
    r.Q = P.Q + row0 * DM + h * HD; r.O = P.O + row0 * DM + h * HD; r.P0 = qb * TOKB;
    if (MODE == MODE_FOX) { r.K = P.K + (size_t)b * SEQ * KS + h * HD; r.V = P.V + (size_t)b * SEQ * KS + h * HD; r.aux = P.aux + ((size_t)b * NH + h) * SEQ; r.selm = nullptr; }
    else { const int g = h >> 2; r.K = P.K + (size_t)b * SEQ * KS + g * HD; r.V = P.V + (size_t)b * SEQ * KS + g * HD;
           r.aux = P.aux + row0 * 48 + (MODE == MODE_SLC ? 16 : 32) + h; r.selm = MODE == MODE_SLC ? P.selm + ((size_t)b * NG + g) * SEQ + (size_t)qb * TOKB : nullptr; }
    return r;
}
template <int MODE, int KS, bool ACCUM>
__device__ __forceinline__ void attn_phase(char* lds, const AttnPtrs& P, int G, int c) {
    constexpr bool GQA = MODE != MODE_FOX;
    constexpr bool PAIRED = MODE != MODE_WIN; constexpr int W = MODE == MODE_WIN ? 512 : (1 << 20);
    constexpr int NBLK = GQA ? SEQ / 64 : SEQ / QB, NHEADU = GQA ? NG : NH;
    constexpr int PER = PAIRED ? NBLK / 2 : NBLK, total = NB * NHEADU * PER;
    int L = c; if (L >= total) return;
    int pass = 0;
#define DEC(L_, pass_, out) do { const int b_ = (L_) & 7, s_ = (L_) >> 3, hu_ = s_ / PER, x_ = s_ % PER; const int qb_ = PAIRED ? ((pass_) ? NBLK - 1 - x_ : x_) : x_; \
        out = att_ref<MODE, KS, GQA>(P, b_, GQA ? 4 * hu_ : hu_, qb_); } while (0)
    BlockRef cur; DEC(L, 0, cur);
    Seam S;
    att_prime<MODE, DM, KS, GQA>(cur, SEQ, W, lds, S);
    for (;;) {
        const bool more_pass = PAIRED && pass == 0, more_item = L + G < total, last = !more_pass && !more_item;
        int passn = pass + 1, Ln = L;
        if (!more_pass) { passn = 0; Ln = more_item ? L + G : L; }
        BlockRef nxt; if (last) nxt = cur; else DEC(Ln, passn, nxt);
        att_block<MODE, DM, KS, DM, ACCUM, GQA>(cur, nxt, SEQ, W, lds, S);
        if (last) break;
        cur = nxt; pass = passn; L = Ln;
    }
#undef DEC
}
#undef VMW
constexpr int CMP_K_OFF = 4 * SHM_V, CMP_IMP_OFF = 8 * SHM_V, CMP_WS_OFF = CMP_IMP_OFF + 16896, CMP_LDS = CMP_WS_OFF + NW * 256;
template <int T> __device__ __forceinline__ void cmp_mask(f32x16& p0, f32x16& p1, int dq) {
    const float NEG = -__builtin_inff();
#pragma unroll
    for (int r = 0; r < 16; ++r) { const int cc = (r & 3) + 8 * (r >> 2); if (cc > dq) p0[r] = NEG; if (cc + 32 > dq) p1[r] = NEG; }
}
struct CmpPtrs { const bf16* Q; const bf16* CK; const bf16* CV; bf16* O; const float* gates; unsigned long long* selm; };
__device__ __forceinline__ void cmp_stage(char* lds, const CmpPtrs& P, int b, int g, int NT) {
    const int tid = threadIdx.x; char* V_lds = lds; char* K_lds = lds + CMP_K_OFF;
    const int sr = tid >> 4, sc = (tid & 15) * 8, vst0 = v_st(sr, sc), vst1 = v_st(32 + sr, sc), kws = KSWZ(sr, sc * 2);
    const bf16* kp = P.CK + ((size_t)(b * 256) * NG + g) * HD + sc; const bf16* vp = P.CV + ((size_t)(b * 256) * NG + g) * HD + sc;
    bf16x8 k0[4], k1[4], v0[4], v1[4];
#pragma unroll
    for (int T = 0; T < 4; ++T) if (T < NT) { const unsigned o0 = (unsigned)((T * 64 + sr) * NG * HD), o1 = (unsigned)((T * 64 + 32 + sr) * NG * HD);
        k0[T] = load8(kp + o0); k1[T] = load8(kp + o1); v0[T] = load8(vp + o0); v1[T] = load8(vp + o1); }
#pragma unroll
    for (int T = 0; T < 4; ++T) if (T < NT) {
        *(bf16x8*)(K_lds + T * SHM_K + kws) = k0[T]; *(bf16x8*)(K_lds + T * SHM_K + kws + 32 * 256) = k1[T];
        *(bf16x8*)(V_lds + T * SHM_V + vst0) = v0[T]; *(bf16x8*)(V_lds + T * SHM_V + vst1) = v1[T]; }
}
__device__ __forceinline__ void cmp_load_q(const CmpPtrs& P, int b, int g, int tb, int wid, int r32, int hi, bf16x8* qr, float& gate) {
    const int pos = tb * 64 + 8 * wid + (r32 & 7), h = 4 * g + (r32 >> 3);
    const bf16* qp = P.Q + ((size_t)b * SEQ + pos) * DM + h * HD + hi * 8;
#pragma unroll
    for (int d0 = 0; d0 < 8; ++d0) qr[d0] = load8(qp + d0 * 16);
    gate = P.gates[((size_t)b * SEQ + pos) * 48 + h];
}
__device__ __forceinline__ void cmp_unit(char* lds, const CmpPtrs& P, int b, int g, int tb, const bf16x8* qr, float gate) {
    const int tid = threadIdx.x, wid = __builtin_amdgcn_readfirstlane(tid >> 6), lane = tid & 63, r32 = lane & 31, hi = lane >> 5;
    char* V_lds = lds; char* K_lds = lds + CMP_K_OFF; float* imp = (float*)(lds + CMP_IMP_OFF); float* li_l = (float*)(lds + CMP_WS_OFF) + wid * 64;
    const int t0 = tb * 64, tok = 8 * wid + (r32 & 7), pos = t0 + tok;
    const int nkeys = 4 * tb + 3 > 255 ? 255 : 4 * tb + 3, NT = (nkeys + 63) >> 6;
    const bool need_imp = tb >= 16;
    constexpr float C2 = 1.4426950408889634f * SCALE;
    const int cm = (pos - 31) >> 4;
    const int vb0 = (int)(uintptr_t)V_lds + v_rd_base(lane);
    float m_run = -1e30f, l_run = 0.f;
    f32x16 p0, p1;
#define CMP_PASS_A(T) if ((T) < NT) { SBAR(); qkt<T, MODE_WIN>(p0, p1, K_lds, nullptr, r32, hi, qr, 0.f); cmp_mask<T>(p0, p1, cm - 64 * (T) - 4 * hi);                      \
        float pmax = p0[0]; for (int r = 1; r < 16; ++r) pmax = fmaxf(pmax, p0[r]); for (int r = 0; r < 16; ++r) pmax = fmaxf(pmax, p1[r]);                                  \
        { auto rr = __builtin_amdgcn_permlane32_swap(__float_as_uint(pmax), __float_as_uint(pmax), false, false); pmax = fmaxf(__uint_as_float(rr[0]), __uint_as_float(rr[1])); } \
        const float mn = fmaxf(m_run, pmax), so = __builtin_amdgcn_exp2f((m_run - mn) * C2), mnL = -mn * C2; float ps = 0.f;                                                 \
        for (int r = 0; r < 16; ++r) ps += __builtin_amdgcn_exp2f(fmaf(p0[r], C2, mnL)) + __builtin_amdgcn_exp2f(fmaf(p1[r], C2, mnL));                                     \
        l_run = l_run * so + ps; m_run = mn; }
    CMP_PASS_A(0) CMP_PASS_A(1) CMP_PASS_A(2) CMP_PASS_A(3)
#undef CMP_PASS_A
    { auto rr = __builtin_amdgcn_permlane32_swap(__float_as_uint(l_run), __float_as_uint(l_run), false, false); l_run = __uint_as_float(rr[0]) + __uint_as_float(rr[1]); }
    const float inv_l = l_run > 0.f ? 1.0f / l_run : 0.f;
    const float mL = -m_run * C2;
    f32x16 o[4] = {}; float carry = 0.f; bf16x8 pa0, pa1, pa2, pa3;
#define CMP_IMP(P_, T, ph) do { float G_[4], x_[4];                                                                                            \
        for (int i = 0; i < 4; ++i) { G_[i] = (P_[4 * i] + P_[4 * i + 1]) + (P_[4 * i + 2] + P_[4 * i + 3]); x_[i] = __shfl_xor(P_[4 * i + 3], 32); }  \
        for (int i = 0; i < 4; ++i) { const float ex = hi ? x_[i] : (i ? x_[i > 0 ? i - 1 : 0] : carry); float v = (G_[i] + ex) * inv_l;     \
            v += __shfl_xor(v, 8); v += __shfl_xor(v, 16);                                                                                     \
            if (r32 < 8) imp[(8 * wid + r32) * 65 + 16 * (T) + 8 * (ph) + 2 * i + hi] = v; }                                                  \
        carry = x_[3]; } while (0)
#define CMP_PASS_B(T) if ((T) < NT) { SBAR(); qkt<T, MODE_WIN>(p0, p1, K_lds, nullptr, r32, hi, qr, 0.f); cmp_mask<T>(p0, p1, cm - 64 * (T) - 4 * hi);   \
        for (int r = 0; r < 16; ++r) { p0[r] = __builtin_amdgcn_exp2f(fmaf(p0[r], C2, mL)); p1[r] = __builtin_amdgcn_exp2f(fmaf(p1[r], C2, mL)); }        \
        if (need_imp) { CMP_IMP(p0, T, 0); CMP_IMP(p1, T, 1); }                                                                                         \
        ATT_PK4(p0, 0, pa0); ATT_PK4(p0, 8, pa1); ATT_PK4(p1, 0, pa2); ATT_PK4(p1, 8, pa3); SBAR();                                                     \
        pv_tile<T>(o, vb0, pa0, pa1, pa2, pa3); }
    CMP_PASS_B(0) CMP_PASS_B(1) CMP_PASS_B(2) CMP_PASS_B(3)
#undef CMP_PASS_B
#undef CMP_IMP
    if (hi == 0) li_l[r32] = gate * inv_l; asm volatile("s_waitcnt lgkmcnt(0)" ::: "memory");
    float rli[16];
#pragma unroll
    for (int r = 0; r < 16; ++r) rli[r] = li_l[crow(r, hi)];
#pragma unroll
    for (int r = 0; r < 16; ++r) { const int rho = crow(r, hi); bf16* orow = P.O + ((size_t)b * SEQ + t0 + 8 * wid + (rho & 7)) * DM + (4 * g + (rho >> 3)) * HD;
#pragma unroll
        for (int d0 = 0; d0 < 4; ++d0) { const float v = o[d0][r] * rli[r]; const float vn = __shfl_xor(v, 1);
            if ((r32 & 1) == 0) *(unsigned*)(orow + d0 * 32 + r32) = cvtpk(v, vn); } }
    asm volatile("s_waitcnt lgkmcnt(0)" ::: "memory");
    const int jq = tb;
#pragma unroll 1
    for (int k = 0; k < 8; k += 4) {
        unsigned long long mask[4];
        if (!need_imp) {
#pragma unroll
            for (int u = 0; u < 4; ++u) mask[u] = (1ull << (jq + 1)) - 1ull; }
        else {
            const int n = lane; unsigned key[4] = {0u, 0u, 0u, 0u}, T[4] = {0u, 0u, 0u, 0u};
            if (n <= jq) { const float bonus = (n == 0 || n == jq || n == jq - 1) ? 1000.0f : 0.0f;
#pragma unroll
                for (int u = 0; u < 4; ++u) key[u] = __float_as_uint(imp[(8 * wid + k + u) * 65 + n] + bonus) + 1u; }
#pragma unroll 1
            for (int bit = 31; bit >= 0; --bit) { unsigned long long bl[4]; unsigned c[4];
#pragma unroll
                for (int u = 0; u < 4; ++u) { c[u] = T[u] | (1u << bit); bl[u] = __ballot(key[u] >= c[u]); }
#pragma unroll
                for (int u = 0; u < 4; ++u) if (__popcll(bl[u]) >= 16) T[u] = c[u]; }
            const unsigned long long lt = (1ull << lane) - 1ull;
#pragma unroll
            for (int u = 0; u < 4; ++u) { const unsigned long long gt = __ballot(key[u] > T[u]), eq = __ballot(key[u] == T[u]); const int need = 16 - __popcll(gt);
                mask[u] = __ballot(key[u] > T[u] || (key[u] == T[u] && __popcll(eq & lt) < need)); }
        }
        if (lane == 0) { unsigned long long* sp = P.selm + ((size_t)b * NG + g) * SEQ + t0 + 8 * wid + k;
#pragma unroll
            for (int u = 0; u < 4; ++u) sp[u] = mask[u]; }
    }
}
__device__ __forceinline__ void cmp_phase(char* lds, const CmpPtrs& P, int G, int c) {
    const int tid = threadIdx.x, wid = __builtin_amdgcn_readfirstlane(tid >> 6), lane = tid & 63, r32 = lane & 31, hi = lane >> 5;
#pragma unroll 1
    for (int L = c; L < NB * NG * 8; L += G) {
        const int b = L & 7, k = L >> 3, g = k & 3, j = (k >> 2) & 7;
        cmp_stage(lds, P, b, g, 4);
        bf16x8 qa[8], qb[8]; float ga, gb;
        cmp_load_q(P, b, g, j, wid, r32, hi, qa, ga);
        __syncthreads();
#define CMP_TB(u) (16 * ((u) >> 1) + (((u) & 1) ? 15 - j : j))
#pragma unroll 1
        for (int u = 0; u < 8; ++u) {
            if (u + 1 < 8) cmp_load_q(P, b, g, CMP_TB(u + 1), wid, r32, hi, qb, gb);
            cmp_unit(lds, P, b, g, CMP_TB(u), qa, ga);
#pragma unroll
            for (int d0 = 0; d0 < 8; ++d0) qa[d0] = qb[d0];
            ga = gb;
        }
#undef CMP_TB
        __syncthreads();
    }
}
}

constexpr size_t MiB = 1u << 20;
constexpr size_t WS_CTL = 0, CTL_ZERO_BYTES = 1 * MiB;
constexpr size_t WS_COS = 1 * MiB, WS_SIN = WS_COS + 256 * 1024;
constexpr size_t WS_PT = WS_SIN + 256 * 1024;
constexpr size_t WS_W2C = WS_PT + 64 * 1024;
constexpr size_t WS_RS = 3 * MiB;
constexpr size_t WS_RTE = 2 * MiB, WS_RTW = WS_RTE + 128 * 1024, WS_SLOT = WS_RTW + 256 * 1024;
constexpr size_t WS_WNSA = 4 * MiB, WS_WCMP1 = 25 * MiB, WS_WNO = 29 * MiB, WS_WFGU = 37 * MiB, WS_WFD = 81 * MiB, WS_WFOX = 103 * MiB, WS_WFO = 128 * MiB, WS_WMGU = 136 * MiB, WS_WMD = 360 * MiB;
constexpr size_t WS_HN = 472 * MiB, WS_HN8 = 472 * MiB;
constexpr size_t WS_Q = 600 * MiB, WS_KV = 728 * MiB, WS_GATES = 920 * MiB, WS_UV = 926 * MiB, WS_CK = 958 * MiB, WS_CV = 960 * MiB, WS_SELM = 962 * MiB;
constexpr size_t WS_O = 1096 * MiB, WS_MIX = 1224 * MiB;
constexpr size_t WS_ACT = 600 * MiB;
constexpr size_t WS_FQKV = 600 * MiB, WS_FL = 984 * MiB, WS_CS = 986 * MiB, WS_TOT = 988 * MiB;
constexpr size_t WS_XG = 600 * MiB, WS_H = 732 * MiB, WS_Y = 1194 * MiB, WS_XR = 1458 * MiB, WS_END = 1586 * MiB;
constexpr int MOE_MAX_TILES = 264, MOE_NCHUNK = 1;
constexpr float XG_SCALE = 16.f, H_SCALE = 8.f, W8_SCALE = 256.f;
constexpr int CW_BAR = 4096;
constexpr int CW_CNT = 64, CW_CWG = 1024;

constexpr int LDS_BYTES = 155648;
constexpr int LDSCTL_OFF = LDS_BYTES - 256;
constexpr int NWAVES = 8;

__device__ __forceinline__ float wave_sum(float v) {
#pragma unroll
    for (int o = 1; o < 64; o <<= 1) v += __shfl_xor(v, o);
    return v;
}
__device__ __forceinline__ float bfu_lo(unsigned w) { return __uint_as_float(w << 16); }
__device__ __forceinline__ float bfu_hi(unsigned w) { return __uint_as_float(w & 0xffff0000u); }
__device__ __forceinline__ void tr_item(const float* W, size_t ldw, int K, bf16* WT, size_t dst_row0, int k0, int n0, LAS float* scr, int lane, const float* gain = nullptr) {
    const int cq = lane & 15, rq = lane >> 4;
    f32x4 tv[16];
#pragma unroll
    for (int i = 0; i < 16; ++i) tv[i] = __builtin_nontemporal_load((const GAS f32x4*)(W + (size_t)(k0 + 4 * i + rq) * ldw + n0 + 4 * cq));
#pragma unroll
    for (int i = 0; i < 16; ++i) { const int kk = 4 * i + rq; f32x4 v = tv[i]; if (gain) v *= gain[k0 + kk];
        LAS float* s = scr + kk * 65 + 4 * cq; s[0] = v.x; s[1] = v.y; s[2] = v.z; s[3] = v.w; }
    LDS_WAIT(); asm volatile("" ::: "memory");
    const int c = lane & 7;
#pragma unroll
    for (int j = 0; j < 8; ++j) { const int n = (lane >> 3) + 8 * j; const LAS float* s = scr + (8 * c) * 65 + n;
        v4u o; o.x = pk2(s[0], s[65]); o.y = pk2(s[130], s[195]); o.z = pk2(s[260], s[325]); o.w = pk2(s[390], s[455]);
        *(GAS v4u*)(WT + (dst_row0 + n) * (size_t)K + k0 + 8 * c) = o; }
    LDS_WAIT(); asm volatile("" ::: "memory");
}
__device__ __forceinline__ void tr_item_f8(const float* W, size_t ldw, int K, unsigned char* WT, size_t dst_row0, int k0, int n0, LAS float* scr, int lane) {
    const int cq = lane & 7, rq = lane >> 3;
    f32x4 tv[16];
#pragma unroll
    for (int i = 0; i < 16; ++i) tv[i] = __builtin_nontemporal_load((const GAS f32x4*)(W + (size_t)(k0 + 8 * i + rq) * ldw + n0 + 4 * cq));
#pragma unroll
    for (int i = 0; i < 16; ++i) { const int kk = 8 * i + rq; const f32x4 v = tv[i];
        LAS float* s = scr + kk * 33 + 4 * cq; s[0] = v.x * W8_SCALE; s[1] = v.y * W8_SCALE; s[2] = v.z * W8_SCALE; s[3] = v.w * W8_SCALE; }
    LDS_WAIT(); asm volatile("" ::: "memory");
    const int c = lane & 7;
#pragma unroll
    for (int j = 0; j < 4; ++j) { const int n = (lane >> 3) + 8 * j; const LAS float* s = scr + (16 * c) * 33 + n;
        v4u o; o.x = pg8::pk4_fp8(s[0], s[33], s[66], s[99]); o.y = pg8::pk4_fp8(s[132], s[165], s[198], s[231]); o.z = pg8::pk4_fp8(s[264], s[297], s[330], s[363]); o.w = pg8::pk4_fp8(s[396], s[429], s[462], s[495]);
        *(GAS v4u*)(WT + (dst_row0 + n) * (size_t)K + k0 + 16 * c) = o; }
    LDS_WAIT(); asm volatile("" ::: "memory");
}
struct TrJob { const float* W; size_t ldw; int K, N; bf16* WT; int grp, gstride, roff; int f8; const float* gain; };
__device__ __forceinline__ int tr_items(const TrJob& j) { return (j.K / 64) * (j.N / 64); }
__device__ __forceinline__ void tr_run(const TrJob& j, int it, LAS float* scr, int lane) {
    if (j.f8) { const int nb = j.N / 32, kb = it / nb, n0 = (it % nb) * 32; const size_t r0 = (size_t)(n0 / j.grp) * j.gstride + (n0 % j.grp) + j.roff;
        tr_item_f8(j.W, j.ldw, j.K, (unsigned char*)j.WT, r0, kb * 128, n0, scr, lane); return; }
    const int nb = j.N / 64, kb = it / nb, n0 = (it % nb) * 64;
    const size_t r0 = (size_t)(n0 / j.grp) * j.gstride + (n0 % j.grp) + j.roff;
    tr_item(j.W, j.ldw, j.K, j.WT, r0, kb * 64, n0, scr, lane, j.gain);
}
__device__ __forceinline__ float gelu_tanh(float x) {
    const float u = 0.7978845608028654f * (x + 0.044715f * x * x * x);
    const float e = __builtin_amdgcn_exp2f(-2.0f * 1.4426950408889634f * u);
    const float th = (1.0f - e) * __builtin_amdgcn_rcpf(1.0f + e);
    return 0.5f * x * (1.0f + th);
}

enum Phase { PH_PRO = 0, PH_NSA_IN, PH_CMP1, PH_CMP2, PH_ATT_CMP, PH_ATT_SLC, PH_ATT_WIN, PH_NSA_OUT, PH_NORM_A, PH_FFN_GU, PH_FFN_DN, PH_NORM_B, PH_FOX_IN, PH_FOX_SCAN, PH_FOX_ATT, PH_FOX_OUT,
             PH_NORM_C, PH_MOE_DISP, PH_MOE0, PH_FINAL = PH_MOE0 + 2 * MOE_NCHUNK, PH_COUNT };
struct Args { const float* in[20]; float* out; unsigned char* ws; int ph_lo, ph_hi; };

typedef unsigned u32x2 __attribute__((ext_vector_type(2)));
struct Row8 { f32x4 v[8]; };
__device__ __forceinline__ Row8 ld_row_f32(const float* p, int lane) { Row8 r; const GAS f32x4* q = (const GAS f32x4*)p + lane;
#pragma unroll
    for (int j = 0; j < 8; ++j) r.v[j] = q[64 * j]; return r; }
__device__ __forceinline__ Row8 ld_row_bf16(const bf16* p, int lane) { Row8 r; const GAS u32x2* q = (const GAS u32x2*)p + lane;
#pragma unroll
    for (int j = 0; j < 8; ++j) { const u32x2 w = q[64 * j]; r.v[j] = (f32x4){bfu_lo(w.x), bfu_hi(w.x), bfu_lo(w.y), bfu_hi(w.y)}; } return r; }
__device__ __forceinline__ void st_row_f32(float* p, int lane, const Row8& r) { GAS f32x4* q = (GAS f32x4*)p + lane;
#pragma unroll
    for (int j = 0; j < 8; ++j) q[64 * j] = r.v[j]; }
__device__ __forceinline__ void st_row_bf16(bf16* p, int lane, const Row8& r) { GAS u32x2* q = (GAS u32x2*)p + lane;
#pragma unroll
    for (int j = 0; j < 8; ++j) { u32x2 w; w.x = pk2(r.v[j].x, r.v[j].y); w.y = pk2(r.v[j].z, r.v[j].w); q[64 * j] = w; } }
__device__ __forceinline__ Row8 ld_row_f32_nt(const float* p, int lane) { Row8 r; const GAS f32x4* q = (const GAS f32x4*)p + lane;
#pragma unroll
    for (int j = 0; j < 8; ++j) r.v[j] = __builtin_nontemporal_load(q + 64 * j); return r; }
__device__ __forceinline__ Row8 ld_row_bf16_nt(const bf16* p, int lane) { Row8 r; const GAS u32x2* q = (const GAS u32x2*)p + lane;
#pragma unroll
    for (int j = 0; j < 8; ++j) { const u32x2 w = __builtin_nontemporal_load(q + 64 * j); r.v[j] = (f32x4){bfu_lo(w.x), bfu_hi(w.x), bfu_lo(w.y), bfu_hi(w.y)}; } return r; }
__device__ __forceinline__ void st_row_f32_nt(float* p, int lane, const Row8& r) { GAS f32x4* q = (GAS f32x4*)p + lane;
#pragma unroll
    for (int j = 0; j < 8; ++j) __builtin_nontemporal_store(r.v[j], q + 64 * j); }
__device__ __forceinline__ void st_row_bf16_nt(bf16* p, int lane, const Row8& r) { GAS u32x2* q = (GAS u32x2*)p + lane;
#pragma unroll
    for (int j = 0; j < 8; ++j) { u32x2 w; w.x = pk2(r.v[j].x, r.v[j].y); w.y = pk2(r.v[j].z, r.v[j].w); __builtin_nontemporal_store(w, q + 64 * j); } }
__device__ __forceinline__ float row_rs(const Row8& r) { float s = 0.f;
#pragma unroll
    for (int j = 0; j < 8; ++j) s += (r.v[j].x * r.v[j].x + r.v[j].y * r.v[j].y) + (r.v[j].z * r.v[j].z + r.v[j].w * r.v[j].w);
    return 1.0f / sqrtf(wave_sum(s) * (1.0f / DM) + RMS_EPS); }

__global__ void __launch_bounds__(NWAVES * 64, 2) mk_fwd(Args args) {
    extern __shared__ __attribute__((aligned(1024))) unsigned char lds[];
    LAS unsigned char* ldsl = (LAS unsigned char*)lds;
    volatile LAS unsigned* LCTL = (volatile LAS unsigned*)(ldsl + LDSCTL_OFF);
    const int tid = threadIdx.x, lane = tid & 63, wave = __builtin_amdgcn_readfirstlane(tid >> 6);
    const int G = gridDim.x, bx = blockIdx.x;
    const int gw = bx * NWAVES + wave, NGW = G * NWAVES;
    unsigned char* ws = args.ws;
    gu32* ctl = (gu32*)(ws + WS_CTL);
    if (tid < 64) LCTL[tid] = 0u;
    __syncthreads();
    XcdBarrier bar; bar.bar = (unsigned*)ctl + CW_BAR; bar.x = 0; bar.st = nullptr;
    if (MK_N_LAUNCHES == 1) bar = xcd_barrier_post((unsigned*)ctl + CW_BAR, LCTL);
    const int lo = args.ph_lo, hi = args.ph_hi;
#ifdef MK_ONLY
#define IN(k) ((k) == MK_ONLY && lo <= (k) && (k) < hi)
#elif defined(MK_SKIP)
#define IN(k) ((k) != MK_SKIP && lo <= (k) && (k) < hi)
#else
#define IN(k) (lo <= (k) && (k) < hi)
#endif
#ifdef MK_PROBE_MASK
    unsigned long long pr_last = rt(), pr_acc = 0ull;
#define SEAM(k) do { if (IN(k) && IN((k) + 1)) xcd_barrier(bar); { const unsigned long long t_ = rt(); if ((MK_PROBE_MASK >> (k)) & 1ull) pr_acc += t_ - pr_last; pr_last = t_; } } while (0)
#else
#define SEAM(k) do { if (IN(k) && IN((k) + 1)) xcd_barrier(bar); } while (0)
#endif

    const float* x_in = args.in[0]; const float* ln_g = args.in[1];
    float* xout = args.out; bf16* XR = (bf16*)(ws + WS_XR);
    bf16* HN = (bf16*)(ws + WS_HN); bf16* OB = (bf16*)(ws + WS_O); bf16* MIX = (bf16*)(ws + WS_MIX);
    float* cosT = (float*)(ws + WS_COS); float* sinT = (float*)(ws + WS_SIN); float* PT = (float*)(ws + WS_PT); bf16* W2C = (bf16*)(ws + WS_W2C);
    unsigned* RTE = (unsigned*)(ws + WS_RTE); float2* RTW = (float2*)(ws + WS_RTW); int2* SLOT = (int2*)(ws + WS_SLOT);

    if (IN(PH_PRO)) {
        LAS float* scr = (LAS float*)(ldsl + wave * 16896);
        int it0 = gw;
#define RUN_JOB(job) do { const TrJob j_ = (job); const int n_ = tr_items(j_); for (; it0 < n_; it0 += NGW) tr_run(j_, it0, scr, lane); it0 -= n_; } while (0)
        RUN_JOB((TrJob{args.in[2], NSA_NV, DM, 5120, (bf16*)(ws + WS_WNSA), 1 << 30, 0, 0, 0}));
        RUN_JOB((TrJob{args.in[5], 256, DM, 256, (bf16*)(ws + WS_WCMP1), 1 << 30, 0, 0, 0}));
        RUN_JOB((TrJob{args.in[5] + (size_t)2048 * 256, 256, DM, 256, (bf16*)(ws + WS_WCMP1), 1 << 30, 0, 256, 0}));
        RUN_JOB((TrJob{args.in[7], 256, DM, 256, (bf16*)(ws + WS_WCMP1), 1 << 30, 0, 512, 0}));
        RUN_JOB((TrJob{args.in[7] + (size_t)2048 * 256, 256, DM, 256, (bf16*)(ws + WS_WCMP1), 1 << 30, 0, 768, 0}));
        RUN_JOB((TrJob{args.in[6], 128, 256, 128, W2C, 1 << 30, 0, 0, 0}));
        RUN_JOB((TrJob{args.in[8], 128, 256, 128, W2C + 128 * 256, 1 << 30, 0, 0, 0}));
        RUN_JOB((TrJob{args.in[9], DM, DM, DM, (bf16*)(ws + WS_WNO), 1 << 30, 0, 0, 0}));
        RUN_JOB((TrJob{args.in[13], FFD, DM, FFD, (bf16*)(ws + WS_WFGU), 128, 256, 0, 0, ln_g + 2 * DM}));
        RUN_JOB((TrJob{args.in[14], FFD, DM, FFD, (bf16*)(ws + WS_WFGU), 128, 256, 128, 0, ln_g + 2 * DM}));
        RUN_JOB((TrJob{args.in[15], DM, FFD, DM, (bf16*)(ws + WS_WFD), 1 << 30, 0, 0, 0}));
        RUN_JOB((TrJob{args.in[10], FOX_NV, DM, 6144, (bf16*)(ws + WS_WFOX), 1 << 30, 0, 0, 0, ln_g + 4 * DM}));
        RUN_JOB((TrJob{args.in[12], DM, DM, DM, (bf16*)(ws + WS_WFO), 1 << 30, 0, 0, 0}));
        for (int e = 0; e < NE; ++e) {
            RUN_JOB((TrJob{args.in[17] + (size_t)e * DM * FFE, FFE, DM, FFE, (bf16*)(ws + WS_WMGU + (size_t)e * 2 * FFE * DM), 128, 256, 0, 1}));
            RUN_JOB((TrJob{args.in[18] + (size_t)e * DM * FFE, FFE, DM, FFE, (bf16*)(ws + WS_WMGU + (size_t)e * 2 * FFE * DM), 128, 256, 128, 1}));
            RUN_JOB((TrJob{args.in[19] + (size_t)e * FFE * DM, DM, FFE, DM, (bf16*)(ws + WS_WMD + (size_t)e * DM * FFE), 1 << 30, 0, 0, 1}));
        }
#undef RUN_JOB
        const int gt = bx * (NWAVES * 64) + tid, NGT = G * NWAVES * 64;
        for (int i = gt; i < 48 * DM; i += NGT) { const int j = i / DM, k = i % DM; ((bf16*)(ws + WS_WNSA))[(size_t)(5120 + j) * DM + k] = (bf16)f2bf(args.in[2][(size_t)k * NSA_NV + 5120 + j]); }
        for (int i = gt; i < 16 * DM; i += NGT) { const int j = i / DM, k = i % DM; ((bf16*)(ws + WS_WFOX))[(size_t)(6144 + j) * DM + k] = (bf16)f2bf(args.in[10][(size_t)k * FOX_NV + 6144 + j] * ln_g[4 * DM + k]); }
        for (int i = gt; i < SEQ * 16; i += NGT) { const int pos = i >> 4, k = i & 15;
            const double inv = exp2(-(double)k * (18.931568569324174 / 16.0));
            double a = (double)pos * inv; a -= 6.283185307179586476925 * rint(a * 0.15915494309189533577);
            cosT[i] = cosf((float)a); sinT[i] = sinf((float)a); }
        for (int t = gw; t < 64; t += NGW) { const int kv = t >> 5, part = (t >> 2) & 7, hb = t & 3; const float* pos = args.in[kv ? 4 : 3]; const float* w1 = args.in[kv ? 7 : 5];
            float acc = 0.f; for (int k = part * 512; k < part * 512 + 512; ++k) acc = fmaf(pos[k], w1[(size_t)k * 256 + hb * 64 + lane], acc);
            PT[(kv * 8 + part) * 256 + hb * 64 + lane] = acc; }
        { const Row8 g0 = ld_row_f32(ln_g, lane);
          int m = gw; Row8 r; if (m < MTOK) r = ld_row_f32_nt(x_in + (size_t)m * DM, lane);
          for (; m < MTOK; m += NGW) { const int m2 = m + NGW; Row8 rn = r; if (m2 < MTOK) rn = ld_row_f32_nt(x_in + (size_t)m2 * DM, lane);
              const float rs = row_rs(r);
#pragma unroll
              for (int j = 0; j < 8; ++j) r.v[j] = r.v[j] * rs * g0.v[j];
              st_row_bf16(HN + (size_t)m * DM, lane, r); r = rn; } }
    }
    SEAM(PH_PRO);

    if (IN(PH_NSA_IN)) {
        pg8::Gemm g{(const pg8::bf16_t*)HN, (const pg8::bf16_t*)(ws + WS_WNSA), MTOK, 5120, DM}; pg8::StaticOrder S; S.init(MTOK, 5120, G, bx);
        pg8::EpiNsaIn E{(pg8::bf16_t*)(ws + WS_Q), (pg8::bf16_t*)(ws + WS_KV), (float*)(ws + WS_GATES), cosT, sinT};
        pg8::gemm_phase<pg8::EpiNsaIn, pg8::StaticOrder, true, true>(ldsl, g, S, E);
    }
    SEAM(PH_NSA_IN);

    if (IN(PH_CMP1)) {
        static_assert(WS_KV % MiB == 0 && WS_WCMP1 % MiB == 0 && WS_HN % MiB == 0 && WS_WNSA % MiB == 0, "absolute 1 MiB tile indices");
        pg8::Gemm g{(const pg8::bf16_t*)ws, (const pg8::bf16_t*)ws, 0, 0, DM};
        pg8::CmpGateOrder S{G, bx, (int)(WS_KV / MiB), (int)(WS_WCMP1 / MiB), (int)(WS_HN / MiB), (int)(WS_WNSA / MiB) + 20};
        pg8::EpiCmpGates E{(float*)(ws + WS_UV), 512, (float*)(ws + WS_GATES)};
        pg8::gemm_phase<pg8::EpiCmpGates, pg8::CmpGateOrder, false, true>(ldsl, g, S, E);
    }
    SEAM(PH_CMP1);

    if (IN(PH_CMP2)) {
        typedef float f32x4v __attribute__((ext_vector_type(4)));
        const float* UV = (const float*)(ws + WS_UV);
        for (int t = gw; t < 2 * NB * NG * 16; t += NGW) {
            const int kv = t >> 9, b = (t >> 6) & 7, g = (t >> 4) & 3, i0 = (t & 15) * 16;
            const int fr = lane & 15, fq = lane >> 4, i = i0 + fr;
            const bool valid = i < 255;
            const float* urow = UV + ((size_t)kv * 8192 + ((size_t)(b * 256 + i) * NG + g)) * 512;
            const float* vrow = UV + ((size_t)kv * 8192 + ((size_t)(b * 256 + (valid ? i + 1 : i)) * NG + g)) * 512 + 256;
            f32x4 acc[8];
#pragma unroll
            for (int n = 0; n < 8; ++n) acc[n] = (f32x4){0.f, 0.f, 0.f, 0.f};
            const bf16* w2 = W2C + (size_t)kv * 128 * 256;
#pragma unroll 2
            for (int ks = 0; ks < 8; ++ks) { const int h0 = 32 * ks + 8 * fq;
                float hv[8];
#pragma unroll
                for (int q = 0; q < 2; ++q) { const f32x4 a = *(const GAS f32x4*)(urow + h0 + 4 * q), c = *(const GAS f32x4*)(vrow + h0 + 4 * q);
                    f32x4 p = (f32x4){0.f, 0.f, 0.f, 0.f};
#pragma unroll
                    for (int pt = 0; pt < 8; ++pt) p += *(const GAS f32x4*)(PT + (kv * 8 + pt) * 256 + h0 + 4 * q);
#pragma unroll
                    for (int e = 0; e < 4; ++e) hv[4 * q + e] = gelu_tanh(a[e] + c[e] + p[e]); }
                v4u aw; aw.x = pk2(hv[0], hv[1]); aw.y = pk2(hv[2], hv[3]); aw.z = pk2(hv[4], hv[5]); aw.w = pk2(hv[6], hv[7]);
                const bf16x8 af = __builtin_bit_cast(bf16x8, aw);
#pragma unroll
                for (int n = 0; n < 8; ++n) { const bf16x8 bfr = *(const GAS bf16x8*)(w2 + (size_t)(16 * n + fr) * 256 + h0);
                    acc[n] = __builtin_amdgcn_mfma_f32_16x16x32_bf16(af, bfr, acc[n], 0, 0, 0); } }
            bf16* outp = (bf16*)(ws + (kv ? WS_CV : WS_CK));
#pragma unroll
            for (int n = 0; n < 8; ++n)
#pragma unroll
                for (int r = 0; r < 4; ++r) { const int ii = i0 + 4 * fq + r; outp[((size_t)(b * 256 + ii) * NG + g) * HD + 16 * n + fr] = (bf16)(ii < 255 ? f2bf(acc[n][r]) : 0u); }
        }
    }
    SEAM(PH_CMP2);

    if (IN(PH_ATT_CMP)) {
        att::CmpPtrs P{(const att::bf16*)(ws + WS_Q), (const att::bf16*)(ws + WS_CK), (const att::bf16*)(ws + WS_CV), (att::bf16*)OB, (const float*)(ws + WS_GATES), (unsigned long long*)(ws + WS_SELM)};
        att::cmp_phase((char*)lds, P, G, bx);
    }
    SEAM(PH_ATT_CMP);
    if (IN(PH_ATT_SLC)) {
        att::AttnPtrs P{(const att::bf16*)(ws + WS_Q), (const att::bf16*)(ws + WS_KV) + (size_t)2 * MTOK * 512, (const att::bf16*)(ws + WS_KV) + (size_t)3 * MTOK * 512, (att::bf16*)OB,
                        (const float*)(ws + WS_GATES), (const unsigned long long*)(ws + WS_SELM)};
        att::attn_phase<att::MODE_SLC, 512, true>((char*)lds, P, G, bx);
    }
    SEAM(PH_ATT_SLC);
    if (IN(PH_ATT_WIN)) {
        att::AttnPtrs P{(const att::bf16*)(ws + WS_Q), (const att::bf16*)(ws + WS_KV) + (size_t)4 * MTOK * 512, (const att::bf16*)(ws + WS_KV) + (size_t)5 * MTOK * 512, (att::bf16*)OB,
                        (const float*)(ws + WS_GATES), nullptr};
        att::attn_phase<att::MODE_WIN, 512, true>((char*)lds, P, G, bx);
    }
    SEAM(PH_ATT_WIN);

    if (IN(PH_NSA_OUT)) {
        pg8::Gemm g{(const pg8::bf16_t*)OB, (const pg8::bf16_t*)(ws + WS_WNO), MTOK, DM, DM}; pg8::StaticOrder S; S.init(MTOK, DM, G, bx);
        pg8::EpiBf16Plain E{(pg8::bf16_t*)MIX, DM};
        pg8::gemm_phase<pg8::EpiBf16Plain, pg8::StaticOrder, true, true>(ldsl, g, S, E);
    }
    SEAM(PH_NSA_OUT);

#define NORM_AB(LDX, gpost) do { const Row8 ga = ld_row_f32(gpost, lane); float* RS = (float*)(ws + WS_RS);                        \
        int m = gw; Row8 y, xr; if (m < MTOK) { y = ld_row_bf16_nt(MIX + (size_t)m * DM, lane); xr = LDX(m); }                    \
        for (; m < MTOK; m += NGW) { const int m2 = m + NGW; Row8 yn = y, xn = xr;                                               \
            if (m2 < MTOK) { yn = ld_row_bf16_nt(MIX + (size_t)m2 * DM, lane); xn = LDX(m2); }                                   \
            const float rs = row_rs(y);                                                                                           \
            _Pragma("unroll") for (int j = 0; j < 8; ++j) xr.v[j] = xr.v[j] + y.v[j] * rs * ga.v[j];                              \
            st_row_bf16(XR + (size_t)m * DM, lane, xr); const float rs2 = row_rs(xr);                                             \
            if (lane == 0) RS[m] = rs2; y = yn; xr = xn; } } while (0)
#define LDX_A(mm) ld_row_f32_nt(x_in + (size_t)(mm) * DM, lane)
#define LDX_B(mm) ld_row_bf16_nt(XR + (size_t)(mm) * DM, lane)
    if (IN(PH_NORM_A)) NORM_AB(LDX_A, ln_g + 1 * DM);
    SEAM(PH_NORM_A);

    if (IN(PH_FFN_GU)) {
        pg8::Gemm g{(const pg8::bf16_t*)XR, (const pg8::bf16_t*)(ws + WS_WFGU), MTOK, 2 * FFD, DM}; pg8::StaticOrder S; S.init(MTOK, 2 * FFD, G, bx);
        pg8::EpiSwiGLU E{(pg8::bf16_t*)(ws + WS_ACT), FFD, (const float*)(ws + WS_RS)};
        pg8::gemm_phase<pg8::EpiSwiGLU, pg8::StaticOrder, true, true>(ldsl, g, S, E);
    }
    SEAM(PH_FFN_GU);
    if (IN(PH_FFN_DN)) {
        pg8::Gemm g{(const pg8::bf16_t*)(ws + WS_ACT), (const pg8::bf16_t*)(ws + WS_WFD), MTOK, DM, FFD}; pg8::StaticOrder S; S.init(MTOK, DM, G, bx);
        pg8::EpiBf16Plain E{(pg8::bf16_t*)MIX, DM};
        pg8::gemm_phase<pg8::EpiBf16Plain, pg8::StaticOrder, true, true>(ldsl, g, S, E);
    }
    SEAM(PH_FFN_DN);
    if (IN(PH_NORM_B)) NORM_AB(LDX_B, ln_g + 3 * DM);
    SEAM(PH_NORM_B);

    if (IN(PH_FOX_IN)) {
        pg8::Gemm g{(const pg8::bf16_t*)XR, (const pg8::bf16_t*)(ws + WS_WFOX), MTOK, FOX_N, DM}; pg8::StaticOrder S; S.init(MTOK, FOX_N, G, bx);
        pg8::EpiFoxIn E{(pg8::bf16_t*)(ws + WS_FQKV), (float*)(ws + WS_FL), (float*)(ws + WS_TOT), args.in[11], (const float*)(ws + WS_RS)};
        pg8::gemm_phase<pg8::EpiFoxIn, pg8::StaticOrder, true, true>(ldsl, g, S, E);
    }
    SEAM(PH_FOX_IN);
    if (IN(PH_FOX_SCAN)) {
        const float* FL = (const float*)(ws + WS_FL); const float* TOT = (const float*)(ws + WS_TOT); float* CS = (float*)(ws + WS_CS);
        for (int t = gw; t < NB * 64; t += NGW) { const int b = t >> 6, c = t & 63;
            const GAS f32x4* src = (const GAS f32x4*)(FL + ((size_t)b * SEQ + c * 64 + lane) * 16); const GAS f32x4* tp = (const GAS f32x4*)(TOT + ((size_t)b * 64 + lane) * 16);
            f32x4 ls[4], tt[4];
#pragma unroll
            for (int q = 0; q < 4; ++q) { ls[q] = src[q]; tt[q] = tp[q]; }
#pragma unroll
            for (int q = 0; q < 4; ++q)
#pragma unroll
                for (int j = 0; j < 4; ++j) { const int h = 4 * q + j; const float pre = wave_sum(lane < c ? tt[q][j] : 0.f); float v = ls[q][j];
#pragma unroll
                    for (int o = 1; o < 64; o <<= 1) { const float n = __shfl_up(v, o); if (lane >= o) v += n; }
                    CS[((size_t)b * NH + h) * SEQ + c * 64 + lane] = (v + pre) * 11.313708498984761f; }
        }
    }
    SEAM(PH_FOX_SCAN);
    if (IN(PH_FOX_ATT)) {
        att::AttnPtrs P{(const att::bf16*)(ws + WS_FQKV), (const att::bf16*)(ws + WS_FQKV) + (size_t)MTOK * DM, (const att::bf16*)(ws + WS_FQKV) + (size_t)2 * MTOK * DM, (att::bf16*)OB,
                        (const float*)(ws + WS_CS), nullptr};
        att::attn_phase<att::MODE_FOX, DM, false>((char*)lds, P, G, bx);
    }
    SEAM(PH_FOX_ATT);
    if (IN(PH_FOX_OUT)) {
        pg8::Gemm g{(const pg8::bf16_t*)OB, (const pg8::bf16_t*)(ws + WS_WFO), MTOK, DM, DM}; pg8::StaticOrder S; S.init(MTOK, DM, G, bx);
        pg8::EpiBf16Plain E{(pg8::bf16_t*)MIX, DM};
        pg8::gemm_phase<pg8::EpiBf16Plain, pg8::StaticOrder, true, true>(ldsl, g, S, E);
    }
    SEAM(PH_FOX_OUT);

    if (IN(PH_NORM_C)) {
        LAS float* wrt = (LAS float*)ldsl;
        const float* wr = args.in[16];
        for (int i = tid; i < DM * NE; i += NWAVES * 64) wrt[(i & 7) * DM + (i >> 3)] = wr[i];
        __syncthreads();
        const Row8 ga = ld_row_f32(ln_g + 5 * DM, lane), gb = ld_row_f32(ln_g + 6 * DM, lane);
        int m = gw; Row8 y, xr; if (m < MTOK) { y = ld_row_bf16_nt(MIX + (size_t)m * DM, lane); xr = ld_row_bf16_nt(XR + (size_t)m * DM, lane); }
        for (; m < MTOK; m += NGW) { const int m2 = m + NGW; Row8 yn = y, xn = xr;
            if (m2 < MTOK) { yn = ld_row_bf16_nt(MIX + (size_t)m2 * DM, lane); xn = ld_row_bf16_nt(XR + (size_t)m2 * DM, lane); }
            const float rs = row_rs(y);
#pragma unroll
            for (int j = 0; j < 8; ++j) xr.v[j] = xr.v[j] + y.v[j] * rs * ga.v[j];
            st_row_bf16_nt(XR + (size_t)m * DM, lane, xr); const float rs2 = row_rs(xr);
#pragma unroll
            for (int j = 0; j < 8; ++j) xr.v[j] = xr.v[j] * rs2 * gb.v[j];
            { unsigned char* h8 = (unsigned char*)(ws + WS_HN8) + (size_t)m * DM + 4 * lane;
#pragma unroll
              for (int j = 0; j < 8; ++j) *(GAS unsigned*)(h8 + 256 * j) = pg8::pk4_fp8(xr.v[j].x * XG_SCALE, xr.v[j].y * XG_SCALE, xr.v[j].z * XG_SCALE, xr.v[j].w * XG_SCALE); }
            float lg[NE];
#pragma unroll
            for (int e = 0; e < NE; ++e) { float s = 0.f;
#pragma unroll
                for (int j = 0; j < 8; ++j) { const f32x4 w = *(const LAS f32x4*)(wrt + e * DM + 256 * j + 4 * lane); s += (xr.v[j].x * w.x + xr.v[j].y * w.y) + (xr.v[j].z * w.z + xr.v[j].w * w.w); }
                asm volatile("" : "+v"(s) :: "memory");
                lg[e] = wave_sum(s); }
            int e1 = 0; float v1 = lg[0];
#pragma unroll
            for (int e = 1; e < NE; ++e) if (lg[e] > v1) { v1 = lg[e]; e1 = e; }
            int e2 = -1; float v2 = -__builtin_inff();
#pragma unroll
            for (int e = 0; e < NE; ++e) if (e != e1 && lg[e] > v2) { v2 = lg[e]; e2 = e; }
            const float ex = expf(v2 - v1), w1 = 1.0f / (1.0f + ex), w2 = ex * w1;
            if (lane == 0) {
                const unsigned i1 = __hip_atomic_fetch_add((LAS unsigned*)(ldsl + LDSCTL_OFF) + 8 + e1, 1u, __ATOMIC_RELAXED, __HIP_MEMORY_SCOPE_WORKGROUP);
                const unsigned i2 = __hip_atomic_fetch_add((LAS unsigned*)(ldsl + LDSCTL_OFF) + 8 + e2, 1u, __ATOMIC_RELAXED, __HIP_MEMORY_SCOPE_WORKGROUP);
                RTE[m] = (unsigned)e1 | ((unsigned)e2 << 8) | (i1 << 16) | (i2 << 24); RTW[m] = make_float2(w1, w2); }
            y = yn; xr = xn;
        }
        __syncthreads();
        if (tid < NE) { const unsigned c = LCTL[8 + tid]; ctl[CW_CWG + bx * NE + tid] = c; if (c) __hip_atomic_fetch_add(ctl + CW_CNT + tid, c, RLX_AGENT); }
    }
    SEAM(PH_NORM_C);

    int tb[NE + 1];
#pragma unroll
    for (int e = 0; e <= NE; ++e) tb[e] = 0;
    if (hi > PH_NORM_C + 1) {
#pragma unroll
        for (int e = 0; e < NE; ++e) { const unsigned c = __builtin_amdgcn_readfirstlane(__hip_atomic_load(ctl + CW_CNT + e, RLX_AGENT)); tb[e + 1] = tb[e] + (int)((c + 255u) >> 8); }
    }
    const int ttot = tb[NE] < MOE_MAX_TILES ? tb[NE] : MOE_MAX_TILES;

    if (IN(PH_MOE_DISP)) {
        unsigned char* XG = ws + WS_XG; const unsigned char* HN8 = ws + WS_HN8;
        LAS unsigned* part = (LAS unsigned*)ldsl; LAS int* sbase = (LAS int*)(ldsl + 4096);
        { const int e = tid & 7, k = tid >> 3; unsigned s = 0; for (int j = k; j < bx; j += 64) s += ctl[CW_CWG + j * NE + e]; part[k * 8 + e] = s; }
        __syncthreads();
        if (tid < NE) { unsigned s = 0; for (int k = 0; k < 64; ++k) s += part[k * 8 + tid]; sbase[tid] = tb[tid] * 256 + (int)s; }
        __syncthreads();
        for (int i0 = 0; gw + NGW * i0 < MTOK; i0 += 8) {
            const int ml = gw + NGW * (i0 + (lane & 7)); int sa = 0, sb = 0;
            if (lane < 8 && ml < MTOK) { const unsigned re = RTE[ml]; sa = sbase[re & 0xff] + (int)((re >> 16) & 0xff); sb = sbase[(re >> 8) & 0xff] + (int)(re >> 24); SLOT[ml] = make_int2(sa, sb); }
            v4u v[8][2];
#pragma unroll
            for (int u = 0; u < 8; ++u) { const int m = gw + NGW * (i0 + u); if (m < MTOK) { const GAS v4u* src = (const GAS v4u*)(HN8 + (size_t)m * DM) + lane; v[u][0] = src[0]; v[u][1] = src[64]; } }
#pragma unroll
            for (int u = 0; u < 8; ++u) { const int m = gw + NGW * (i0 + u); const int ra = __builtin_amdgcn_readlane(sa, u), rb = __builtin_amdgcn_readlane(sb, u);
                if (m < MTOK) { GAS v4u* da = (GAS v4u*)(XG + (size_t)ra * DM) + lane; GAS v4u* db = (GAS v4u*)(XG + (size_t)rb * DM) + lane;
                    da[0] = v[u][0]; da[64] = v[u][1]; db[0] = v[u][0]; db[64] = v[u][1]; } }
        }
    }
    SEAM(PH_MOE_DISP);

    if (IN(PH_MOE0) && ttot > 0) {
        pg8::Gemm g{(const pg8::bf16_t*)(ws + WS_XG), (const pg8::bf16_t*)(ws + WS_WMGU), 0, 2 * FFE, DM};
        pg8::MoeOrder<false> S{0, ttot, 2 * FFE / 256, G, bx, tb[1], tb[2], tb[3], tb[4], tb[5], tb[6], tb[7]};
        pg8::EpiSwiGLU8 E{ws + WS_H, FFE, H_SCALE};
        pg8::gemm_phase<pg8::EpiSwiGLU8, pg8::MoeOrder<false>, true, true, true, 0x77777777, 0x7B7B7B7B>(ldsl, g, S, E);
    }
    SEAM(PH_MOE0);
    if (IN(PH_MOE0 + 1) && ttot > 0) {
        pg8::Gemm g{(const pg8::bf16_t*)(ws + WS_H), (const pg8::bf16_t*)(ws + WS_WMD), 0, DM, FFE};
        pg8::MoeOrder<true> S{0, ttot, DM / 256, G, bx, tb[1], tb[2], tb[3], tb[4], tb[5], tb[6], tb[7]};
        pg8::EpiBf16Plain E{(pg8::bf16_t*)(ws + WS_Y), DM};
        pg8::gemm_phase<pg8::EpiBf16Plain, pg8::MoeOrder<true>, true, true, true, 0x77777777, 0x7C7C7C7C>(ldsl, g, S, E);
    }
    SEAM(PH_MOE0 + 1);

    if (IN(PH_FINAL)) {
        const bf16* Y = (const bf16*)(ws + WS_Y); const Row8 ga = ld_row_f32(ln_g + 7 * DM, lane);
        int m = gw; int2 sl = make_int2(0, 0), sl2 = sl; float2 w = make_float2(0.f, 0.f), w2 = w; Row8 ya, yb, xr;
        if (m < MTOK) { sl = SLOT[m]; w = RTW[m]; ya = ld_row_bf16_nt(Y + (size_t)sl.x * DM, lane); yb = ld_row_bf16_nt(Y + (size_t)sl.y * DM, lane); xr = ld_row_bf16_nt(XR + (size_t)m * DM, lane); }
        if (m + NGW < MTOK) { sl2 = SLOT[m + NGW]; w2 = RTW[m + NGW]; }
        for (; m < MTOK; m += NGW) { const int m2 = m + NGW, m3 = m + 2 * NGW; Row8 yan = ya, ybn = yb, xn = xr; int2 sl3 = sl2; float2 w3 = w2;
            if (m2 < MTOK) { yan = ld_row_bf16_nt(Y + (size_t)sl2.x * DM, lane); ybn = ld_row_bf16_nt(Y + (size_t)sl2.y * DM, lane); xn = ld_row_bf16_nt(XR + (size_t)m2 * DM, lane); }
            if (m3 < MTOK) { sl3 = SLOT[m3]; w3 = RTW[m3]; }
            Row8 f;
#pragma unroll
            for (int j = 0; j < 8; ++j) f.v[j] = ya.v[j] * w.x + yb.v[j] * w.y;
            const float rs = row_rs(f);
#pragma unroll
            for (int j = 0; j < 8; ++j) xr.v[j] = xr.v[j] + f.v[j] * rs * ga.v[j];
            st_row_f32_nt(xout + (size_t)m * DM, lane, xr);
            ya = yan; yb = ybn; xr = xn; w = w2; sl2 = sl3; w2 = w3; }
    }
#ifdef MK_PROBE_MASK
    { const unsigned long long t_ = rt(); if ((MK_PROBE_MASK >> PH_FINAL) & 1ull) pr_acc += t_ - pr_last;
      if (bx == 0 && tid == 0) { const unsigned long long t0_ = rt(); while (rt() - t0_ < pr_acc) __builtin_amdgcn_s_sleep(8); } }
#endif
#undef IN
#undef SEAM
#undef NORM_AB
#undef LDX_A
#undef LDX_B
}

extern "C" void kernel_launch(void* const* d_in, const int* in_sizes, int n_in, void* d_out, int out_size, void* d_ws, size_t ws_size, hipStream_t stream) {
    static int grid = 0;
    if (grid == 0) {
        if (n_in != 20 || in_sizes[0] != MTOK * DM || out_size != MTOK * DM || ws_size < WS_END) { fprintf(stderr, "kernel_launch: unexpected shapes (n_in %d, ws %zu < %zu?)\n", n_in, ws_size, (size_t)WS_END); grid = -1; return; }
        int dev = 0, cus = 0, per_cu = 0;
        if (hipGetDevice(&dev) != hipSuccess || hipDeviceGetAttribute(&cus, hipDeviceAttributeMultiprocessorCount, dev) != hipSuccess) { grid = -1; return; }
        if (hipFuncSetAttribute((const void*)mk_fwd, hipFuncAttributeMaxDynamicSharedMemorySize, LDS_BYTES) != hipSuccess) { fprintf(stderr, "kernel_launch: hipFuncSetAttribute failed\n"); grid = -1; return; }
        if (hipOccupancyMaxActiveBlocksPerMultiprocessor(&per_cu, (const void*)mk_fwd, NWAVES * 64, LDS_BYTES) != hipSuccess || per_cu < 1) { fprintf(stderr, "kernel_launch: occupancy query says %d blocks per CU\n", per_cu); }
        (void)hipGetLastError();
        grid = cus;
    }
    if (grid < 0) return;
    (void)hipMemsetAsync((char*)d_ws + WS_CTL, 0, CTL_ZERO_BYTES, stream);
    Args a{};
    for (int i = 0; i < 20; ++i) a.in[i] = (const float*)d_in[i];
    a.out = (float*)d_out; a.ws = (unsigned char*)d_ws;
#if MK_N_LAUNCHES == 1
    a.ph_lo = 0; a.ph_hi = PH_COUNT;
    hipLaunchKernelGGL(mk_fwd, dim3(grid), dim3(NWAVES * 64), LDS_BYTES, stream, a);
#else
    for (int p = 0; p < PH_COUNT; ++p) { a.ph_lo = p; a.ph_hi = p + 1; hipLaunchKernelGGL(mk_fwd, dim3(grid), dim3(NWAVES * 64), LDS_BYTES, stream, a); }
#endif
}
```

```cpp
#include <hip/hip_runtime.h>
#include <cstdio>
#include <cstdint>

#ifndef MK_N_LAUNCHES
#define MK_N_LAUNCHES 1
#endif

constexpr int NB = 8, SEQ = 4096, DM = 2048, MTOK = NB * SEQ;
constexpr int NH = 16, HD = 128, NG = 4;
constexpr int NSA_NV = 5168, NSA_N = 5376;
constexpr int FOX_NV = 6160, FOX_N = 6400;
constexpr int FFD = 5632, NE = 8, FFE = 7168;
constexpr float RMS_EPS = 1e-6f;

#define GAS __attribute__((address_space(1)))
#define LAS __attribute__((address_space(3)))
typedef unsigned short bf16;
typedef unsigned v4u __attribute__((ext_vector_type(4)));
typedef float f32x4 __attribute__((ext_vector_type(4)));
typedef short bf16x8 __attribute__((ext_vector_type(8)));
typedef GAS unsigned gu32;
typedef GAS unsigned long long gu64;
#define RLX_AGENT __ATOMIC_RELAXED, __HIP_MEMORY_SCOPE_AGENT
#define LDS_WAIT() asm volatile("s_waitcnt lgkmcnt(0)" ::: "memory")
#define VM_WAIT() asm volatile("s_waitcnt vmcnt(0)" ::: "memory")
__device__ __forceinline__ unsigned long long rt() { return __builtin_amdgcn_s_memrealtime(); }
__device__ __forceinline__ unsigned f2bf(float f) { unsigned u = __builtin_bit_cast(unsigned, f); return (u + 0x7fffu + ((u >> 16) & 1u)) >> 16; }
__device__ __forceinline__ unsigned pk2(float lo, float hi) { return f2bf(lo) | (f2bf(hi) << 16); }

#define XB_TMO      128
#define XB_XCNT(j)  (256  + 64 * (j))
#define XB_XSUB(j)  (1280 + 64 * (j))
#define XB_XGEN(j)  (2304 + 64 * (j))
#define XB_TOP      3328
#define XB_TOPGEN   3392
#define XCD_BAR_WORDS 3456
#define XB_SPIN_CAP (1u << 20)

__device__ __forceinline__ unsigned xb_ld(unsigned* p)              { return __hip_atomic_load(p, __ATOMIC_RELAXED, __HIP_MEMORY_SCOPE_AGENT); }
__device__ __forceinline__ unsigned xb_add(unsigned* p, unsigned v) { return __hip_atomic_fetch_add(p, v, __ATOMIC_RELAXED, __HIP_MEMORY_SCOPE_AGENT); }
__device__ __forceinline__ unsigned xb_xcc_id() { return (unsigned)__builtin_amdgcn_s_getreg((3 << 11) | 20) & 0xFu; }
#define XB_SPIN(cond, bar) do { unsigned _sp = 0; while (cond) { __builtin_amdgcn_s_sleep(1); \
    if ((++_sp & 255u) == 0u) { if (xb_ld(&(bar)[XB_TMO])) break; if (_sp > XB_SPIN_CAP) { atomicAdd(&(bar)[XB_TMO], 1u); break; } } } } while (0)

struct XcdBarrier {
    unsigned* bar; unsigned x;
    volatile LAS unsigned* st;
};

__device__ __forceinline__ XcdBarrier xcd_barrier_post(unsigned* bar, volatile LAS unsigned* st) {
    XcdBarrier b; b.bar = bar; b.x = xb_xcc_id(); b.st = st;
    if (threadIdx.x == 0) (void)xb_add(&bar[XB_XCNT(b.x)], 1u);
    return b;
}
__device__ __forceinline__ void xcd_barrier_complete(unsigned* bar, unsigned x, unsigned& nloc, unsigned& nx) {
    const unsigned G = gridDim.x * gridDim.y * gridDim.z;
    unsigned sum, cnt, mine, sp = 0u;
    for (;;) {
        sum = 0u; cnt = 0u; mine = 0u;
#pragma unroll
        for (unsigned j = 0; j < 16; ++j) { const unsigned c = xb_ld(&bar[XB_XCNT(j)]); sum += c; cnt += (c > 0u) ? 1u : 0u; mine = (j == x) ? c : mine; }
        if (sum == G) break;
        __builtin_amdgcn_s_sleep(1);
        if ((++sp & 255u) == 0u) { if (xb_ld(&bar[XB_TMO])) break; if (sp > XB_SPIN_CAP) { atomicAdd(&bar[XB_TMO], 1u); break; } }
    }
    nloc = mine > 0u ? mine : 1u; nx = cnt > 0u ? cnt : 1u;
}

__device__ __forceinline__ void xcd_barrier(const XcdBarrier& b) {
    asm volatile("s_waitcnt vmcnt(0)" ::: "memory");
    __syncthreads();
    if (threadIdx.x == 0) {
        unsigned* bar = b.bar;
        __builtin_amdgcn_s_waitcnt(0);
        unsigned nloc = b.st[0], nx = b.st[1];
        if (nloc == 0u) { xcd_barrier_complete(bar, b.x, nloc, nx); b.st[0] = nloc; b.st[1] = nx; }
        const unsigned old = xb_add(&bar[XB_XSUB(b.x)], 1u);
        const unsigned gen = old / nloc;
        if (old + 1u == (gen + 1u) * nloc) {
            __builtin_amdgcn_fence(__ATOMIC_RELEASE, "agent");
            asm volatile("s_waitcnt vmcnt(0)" ::: "memory");
            const unsigned og = xb_add(&bar[XB_TOP], 1u);
            const unsigned tg = og / nx;
            if (og + 1u == (tg + 1u) * nx) xb_add(&bar[XB_TOPGEN], 1u);
            else XB_SPIN(xb_ld(&bar[XB_TOPGEN]) == tg, bar);
            __builtin_amdgcn_fence(__ATOMIC_ACQUIRE, "agent");
            xb_add(&bar[XB_XGEN(b.x)], 1u);
            asm volatile("s_waitcnt vmcnt(0)" ::: "memory");
        } else {
            XB_SPIN(xb_ld(&bar[XB_XGEN(b.x)]) == gen, bar);
            __builtin_amdgcn_fence(__ATOMIC_ACQUIRE, "agent");
            asm volatile("s_waitcnt vmcnt(0)" ::: "memory");
        }
    }
    __syncthreads();
}


namespace pg8 {
#define PG8_LAS __attribute__((address_space(3)))
typedef unsigned short bf16_t;
typedef short bf16x8 __attribute__((ext_vector_type(8)));
typedef float f32x4 __attribute__((ext_vector_type(4)));
typedef unsigned u32x4 __attribute__((ext_vector_type(4)));
constexpr int BM = 256, BK = 64, HALF = 128, HTB = HALF * BK * 2  , STAGE_BYTES = 8 * HTB, NXCD = 8, WGM = 8;

__host__ __device__ __forceinline__ int lds_byte(int r, int c) { const int st = (r >> 4) * 2 + (c >> 5), rr = r & 15, cc = c & 31, ob = rr * 64 + cc * 2; return st * 1024 + (ob ^ (((ob >> 9) & 1) << 5)); }
__host__ __device__ __forceinline__ void stage_rc(int b, int& R, int& C) { const int st = b / 1024, sb = b % 1024, swz = sb ^ (((sb >> 9) & 1) << 5); R = (st >> 1) * 16 + swz / 64; C = (st & 1) * 32 + (swz % 64) / 2; }
__host__ __device__ __forceinline__ int perm32(int rho) { const int n = rho >> 4, i = rho & 15; return 8 * (i >> 2) + 4 * n + (i & 3); }

struct Unit { int pm, pn, pa, pb; };
struct Gemm { const bf16_t* A; const bf16_t* Bt; int M, N, K; };

struct StaticOrder {
    int nM, nN, nwg, G, c;
    __host__ __device__ void init(int M, int N, int G_, int c_) { nM = M / BM; nN = N / BM; nwg = nM * nN; G = G_; c = c_; }
    __host__ __device__ bool next(int i, Unit& u) const {
        const long L = (long)i * G + c; if (L >= nwg) return false;
        int wgid = (int)L; { const int q = nwg / NXCD, r = nwg % NXCD, xcd = wgid % NXCD, off = wgid / NXCD; wgid = (xcd < r ? xcd * (q + 1) : r * (q + 1) + (xcd - r) * q) + off; }
        const int nig = WGM * nN, gid = wgid / nig, fm = gid * WGM, gsz = (nM - fm) < WGM ? (nM - fm) : WGM;
        u.pm = fm + ((wgid % nig) % gsz); u.pn = (wgid % nig) / gsz; u.pa = u.pm; u.pb = u.pn; return true;
    }
    __device__ __forceinline__ void a_ready(const Unit&) const {}
    __device__ __forceinline__ void done(const Unit&) const {}
};

__device__ __forceinline__ unsigned cvt_pk_bf16(float lo, float hi) { unsigned r; asm volatile("v_cvt_pk_bf16_f32 %0, %1, %2" : "=v"(r) : "v"(lo), "v"(hi)); return r; }
typedef float f32x2 __attribute__((ext_vector_type(2)));
__device__ __forceinline__ u32x4 pack8_bf16(const f32x4 a, const f32x4 b) { u32x4 w; w.x = cvt_pk_bf16(a[0], a[1]); w.y = cvt_pk_bf16(a[2], a[3]); w.z = cvt_pk_bf16(b[0], b[1]); w.w = cvt_pk_bf16(b[2], b[3]); return w; }

struct EpiBf16Plain {
    static constexpr bool PERM = true, AFTER_DRAIN = false, ROWSCALE = false;
    bf16_t* O; int ldc;
    __device__ __forceinline__ void operator()(const f32x4 (&acc)[2][2][4][2], const Unit& u, int wr, int wc, int fr, int fq) const {
        const int row0 = u.pm * BM + wr * 64 + fr, col0 = u.pn * BM + wc * 32 + 8 * fq;
#pragma unroll
        for (int ai = 0; ai < 2; ++ai)
#pragma unroll
            for (int m = 0; m < 4; ++m) { bf16_t* rowp = O + (size_t)(row0 + ai * HALF + m * 16) * ldc + col0;
#pragma unroll
                for (int bj = 0; bj < 2; ++bj) *(u32x4*)(rowp + bj * HALF) = pack8_bf16(acc[ai][bj][m][0], acc[ai][bj][m][1]); }
    }
};
struct EpiF32Cmp {
    static constexpr bool PERM = false, AFTER_DRAIN = false, ROWSCALE = false;
    float* O; int ldc;
    __device__ __forceinline__ void operator()(const f32x4 (&acc)[2][2][4][2], const Unit& u, int wr, int wc, int fr, int fq) const {
        const int row0 = u.pm * BM + wr * 64 + fr, col0 = (u.pn & 1) * BM + wc * 32 + 4 * fq;
#pragma unroll
        for (int ai = 0; ai < 2; ++ai)
#pragma unroll
            for (int m = 0; m < 4; ++m) { float* rowp = O + (size_t)(row0 + ai * HALF + m * 16) * ldc + col0;
#pragma unroll
                for (int bj = 0; bj < 2; ++bj)
#pragma unroll
                    for (int n = 0; n < 2; ++n) *(f32x4*)(rowp + bj * HALF + n * 16) = acc[ai][bj][m][n]; }
    }
};
struct EpiSwiGLU {
    static constexpr bool PERM = true, AFTER_DRAIN = false, ROWSCALE = true;
    bf16_t* O; int ldc; const float* rs;
    __device__ __forceinline__ void operator()(const f32x4 (&acc)[2][2][4][2], const Unit& u, int wr, int wc, int fr, int fq) const {
        const int row0 = u.pm * BM + wr * 64 + fr, col0 = u.pn * HALF + wc * 32 + 8 * fq;
#pragma unroll
        for (int ai = 0; ai < 2; ++ai)
#pragma unroll
            for (int m = 0; m < 4; ++m) { f32x4 h[2];
#pragma unroll
                for (int n = 0; n < 2; ++n) { const f32x4 g = acc[ai][0][m][n], up = acc[ai][1][m][n];
#pragma unroll
                    for (int j = 0; j < 4; j += 2) {
                        const f32x2 gg = {g[j], g[j + 1]}, uu = {up[j], up[j + 1]}; const f32x2 t = gg * -1.4426950408889634f;
                        f32x2 d = {__builtin_amdgcn_exp2f(t.x), __builtin_amdgcn_exp2f(t.y)}; d = d + 1.0f;
                        const f32x2 r = {__builtin_amdgcn_rcpf(d.x), __builtin_amdgcn_rcpf(d.y)}; const f32x2 hh = (gg * uu) * r;
                        h[n][j] = hh.x; h[n][j + 1] = hh.y; } }
                *(u32x4*)(O + (size_t)(row0 + ai * HALF + m * 16) * ldc + col0) = pack8_bf16(h[0], h[1]); }
    }
};
__device__ __forceinline__ unsigned pk4_fp8(float a, float b, float c, float d) {
    a = __builtin_amdgcn_fmed3f(a, -448.f, 448.f); b = __builtin_amdgcn_fmed3f(b, -448.f, 448.f); c = __builtin_amdgcn_fmed3f(c, -448.f, 448.f); d = __builtin_amdgcn_fmed3f(d, -448.f, 448.f);
    int w = 0; w = __builtin_amdgcn_cvt_pk_fp8_f32(a, b, w, false); w = __builtin_amdgcn_cvt_pk_fp8_f32(c, d, w, true); return (unsigned)w; }
struct EpiSwiGLU8 {
    static constexpr bool PERM = true, AFTER_DRAIN = false, ROWSCALE = false;
    unsigned char* O; int ldc; float oscale;
    __device__ __forceinline__ void operator()(const f32x4 (&acc)[2][2][4][2], const Unit& u, int wr, int wc, int fr, int fq) const {
        typedef unsigned u32x2 __attribute__((ext_vector_type(2)));
        const int row0 = u.pm * BM + wr * 64 + fr, col0 = u.pn * HALF + wc * 32 + 8 * fq; const float ic = 1.0f / oscale;
#pragma unroll
        for (int ai = 0; ai < 2; ++ai)
#pragma unroll
            for (int m = 0; m < 4; ++m) { f32x4 h[2];
#pragma unroll
                for (int n = 0; n < 2; ++n) { const f32x4 g = acc[ai][0][m][n], up = acc[ai][1][m][n];
#pragma unroll
                    for (int j = 0; j < 4; j += 2) {
                        const f32x2 gg = {g[j], g[j + 1]}, uu = {up[j], up[j + 1]}; const f32x2 t = gg * -1.4426950408889634f;
                        f32x2 d = {__builtin_amdgcn_exp2f(t.x), __builtin_amdgcn_exp2f(t.y)}; d = d * ic + ic;
                        const f32x2 r = {__builtin_amdgcn_rcpf(d.x), __builtin_amdgcn_rcpf(d.y)}; const f32x2 hh = (gg * uu) * r;
                        h[n][j] = hh.x; h[n][j + 1] = hh.y; } }
                u32x2 w; w.x = pk4_fp8(h[0][0], h[0][1], h[0][2], h[0][3]); w.y = pk4_fp8(h[1][0], h[1][1], h[1][2], h[1][3]);
                *(u32x2*)(O + (size_t)(row0 + ai * HALF + m * 16) * ldc + col0) = w; }
    }
};
struct EpiNsaIn {
    static constexpr bool PERM = true, AFTER_DRAIN = false, ROWSCALE = false;
    bf16_t* Q; bf16_t* KV; float* gates; const float* cosT; const float* sinT;
    __device__ __forceinline__ void operator()(const f32x4 (&acc)[2][2][4][2], const Unit& u, int wr, int wc, int fr, int fq) const {
        const int pn = u.pn, row0 = u.pm * BM + wr * 64 + fr;
        if (pn == 20) {
            if (wc == 0 || (wc == 1 && fq < 2)) {
#pragma unroll
                for (int ai = 0; ai < 2; ++ai)
#pragma unroll
                    for (int m = 0; m < 4; ++m) { float* gp = gates + (size_t)(row0 + ai * HALF + m * 16) * 48 + wc * 32 + 8 * fq;
#pragma unroll
                        for (int n = 0; n < 2; ++n) { const f32x4 a = acc[ai][0][m][n]; f32x4 s;
#pragma unroll
                            for (int j = 0; j < 4; ++j) s[j] = __builtin_amdgcn_rcpf(1.0f + __builtin_amdgcn_exp2f(-1.4426950408889634f * a[j]));
                            *(f32x4*)(gp + 4 * n) = s; } }
            }
            return;
        }
        bf16_t* base; int ldc, colt; bool rot, chunk;
        if (pn < 8) { base = Q; ldc = DM; colt = pn * BM; rot = true; chunk = false; }
        else { const int sec = (pn - 8) >> 1; base = KV + (size_t)sec * ((size_t)MTOK * 512); ldc = 512; colt = (pn & 1) * BM; rot = (sec & 1) == 0; chunk = sec < 2; }
        const bool dorot = rot && wc == 0;
#pragma unroll
        for (int ai = 0; ai < 2; ++ai)
#pragma unroll
            for (int m = 0; m < 4; ++m) { const int row = row0 + ai * HALF + m * 16, pos = row & (SEQ - 1);
                f32x4 c0, c1, s0, s1;
                if (dorot) { const float* cp = cosT + pos * 16 + 8 * (fq & 1); const float* sp = sinT + pos * 16 + 8 * (fq & 1);
                    c0 = *(const f32x4*)cp; c1 = *(const f32x4*)(cp + 4); s0 = *(const f32x4*)sp; s1 = *(const f32x4*)(sp + 4); }
#pragma unroll
                for (int bj = 0; bj < 2; ++bj) { f32x4 v0 = acc[ai][bj][m][0], v1 = acc[ai][bj][m][1];
                    if (dorot) { f32x4 o0, o1;
#pragma unroll
                        for (int j = 0; j < 4; ++j) { o0[j] = __shfl_xor(v0[j], 32); o1[j] = __shfl_xor(v1[j], 32); }
                        if (fq < 2) { v0 = v0 * c0 - o0 * s0; v1 = v1 * c1 - o1 * s1; }
                        else        { v0 = v0 * c0 + o0 * s0; v1 = v1 * c1 + o1 * s1; } }
                    const int col = colt + bj * HALF + wc * 32 + 8 * fq;
                    size_t off;
                    if (!chunk) off = (size_t)row * ldc + col;
                    else { const int b = row >> 12, t = row & (SEQ - 1), g = col >> 7, d = col & 127; off = ((size_t)((b * 256 + (t >> 4)) * 4 + g) * 16 + (t & 15)) * 128 + d; }
                    *(u32x4*)(base + off) = pack8_bf16(v0, v1); } }
    }
};
__device__ __forceinline__ float log_sigmoid_fast(float z) { const float e = __builtin_amdgcn_exp2f(-1.4426950408889634f * __builtin_fabsf(z)); return __builtin_fminf(z, 0.f) - 0.6931471805599453f * __builtin_amdgcn_logf(1.0f + e); }
struct EpiFoxIn {
    static constexpr bool PERM = true, AFTER_DRAIN = false, ROWSCALE = true;
    bf16_t* QKV; float* fl; float* tot; const float* fbias; const float* rs;
    __device__ __forceinline__ void operator()(const f32x4 (&acc)[2][2][4][2], const Unit& u, int wr, int wc, int fr, int fq) const {
        const int pn = u.pn, row0 = u.pm * BM + wr * 64 + fr;
        if (pn == 24) {
            if (wc == 0) {
                const int hb = 8 * (fq & 1); const f32x4 b0 = *(const f32x4*)(fbias + hb), b1 = *(const f32x4*)(fbias + hb + 4);
#pragma unroll
                for (int ai = 0; ai < 2; ++ai) { f32x4 s0 = (f32x4){0.f, 0.f, 0.f, 0.f}, s1 = s0;
#pragma unroll
                    for (int m = 0; m < 4; ++m) { f32x4 v0 = acc[ai][0][m][0] + b0, v1 = acc[ai][0][m][1] + b1;
#pragma unroll
                        for (int j = 0; j < 4; ++j) { v0[j] = log_sigmoid_fast(v0[j]); v1[j] = log_sigmoid_fast(v1[j]); }
                        s0 += v0; s1 += v1;
                        if (fq < 2) { float* gp = fl + (size_t)(row0 + ai * HALF + m * 16) * 16 + 8 * fq; *(f32x4*)gp = v0; *(f32x4*)(gp + 4) = v1; } }
#pragma unroll
                    for (int o = 1; o < 16; o <<= 1)
#pragma unroll
                        for (int j = 0; j < 4; ++j) { s0[j] += __shfl_xor(s0[j], o); s1[j] += __shfl_xor(s1[j], o); }
                    if (fq < 2 && fr == 0) { const int rowc = u.pm * BM + ai * HALF + wr * 64; float* tp = tot + ((size_t)((rowc >> 12) * 64 + ((rowc & (SEQ - 1)) >> 6))) * 16 + 8 * fq; *(f32x4*)tp = s0; *(f32x4*)(tp + 4) = s1; } }
            }
            return;
        }
        bf16_t* base = QKV + (size_t)(pn >> 3) * ((size_t)MTOK * DM); const int col0 = (pn & 7) * BM + wc * 32 + 8 * fq;
#pragma unroll
        for (int ai = 0; ai < 2; ++ai)
#pragma unroll
            for (int m = 0; m < 4; ++m) { bf16_t* rowp = base + (size_t)(row0 + ai * HALF + m * 16) * DM + col0;
#pragma unroll
                for (int bj = 0; bj < 2; ++bj) *(u32x4*)(rowp + bj * HALF) = pack8_bf16(acc[ai][bj][m][0], acc[ai][bj][m][1]); }
    }
};
struct EpiCmpGates {
    static constexpr bool PERM = false, AFTER_DRAIN = false, ROWSCALE = false;
    float* O; int ldc; float* gates;
    __device__ __forceinline__ void operator()(const f32x4 (&acc)[2][2][4][2], const Unit& u, int wr, int wc, int fr, int fq) const {
        const int row0 = u.pm * BM + wr * 64 + fr;
        if (u.pn >= 8) {
            if (wc < 2) {
#pragma unroll
                for (int ai = 0; ai < 2; ++ai)
#pragma unroll
                    for (int m = 0; m < 4; ++m) { float* gp = gates + (size_t)(row0 + ai * HALF + m * 16) * 48 + wc * 32 + 4 * fq;
#pragma unroll
                        for (int n = 0; n < 2; ++n) if (wc == 0 || n == 0) { const f32x4 a = acc[ai][0][m][n]; f32x4 s;
#pragma unroll
                            for (int j = 0; j < 4; ++j) s[j] = __builtin_amdgcn_rcpf(1.0f + __builtin_amdgcn_exp2f(-1.4426950408889634f * a[j]));
                            *(f32x4*)(gp + 16 * n) = s; } }
            }
            return;
        }
        const int col0 = (u.pn & 1) * BM + wc * 32 + 4 * fq;
#pragma unroll
        for (int ai = 0; ai < 2; ++ai)
#pragma unroll
            for (int m = 0; m < 4; ++m) { float* rowp = O + (size_t)(row0 + ai * HALF + m * 16) * ldc + col0;
#pragma unroll
                for (int bj = 0; bj < 2; ++bj)
#pragma unroll
                    for (int n = 0; n < 2; ++n) *(f32x4*)(rowp + bj * HALF + n * 16) = acc[ai][bj][m][n]; }
    }
};
struct CmpGateOrder {
    int G, c, aT0, bT0, hT0, gT;
    __device__ bool next(int i, Unit& u) const { const int L = i * G + c; if (L >= 256) return false;
        if (L < 128) { const int pa = L >> 1; u.pm = pa; u.pn = 2 * (pa >= 32) + (L & 1); u.pa = aT0 + pa; u.pb = bT0 + u.pn; }
        else { u.pm = L - 128; u.pn = 8; u.pa = hT0 + u.pm; u.pb = gT; }
        return true; }
    __device__ __forceinline__ void a_ready(const Unit&) const {}
    __device__ __forceinline__ void done(const Unit&) const {}
};
struct CmpOrder {
    int G, c;
    __device__ bool next(int i, Unit& u) const { const int L = i * G + c; if (L >= 128) return false; u.pa = L >> 1; u.pm = u.pa; u.pb = 2 * (u.pa >= 32) + (L & 1); u.pn = u.pb; return true; }
    __device__ __forceinline__ void a_ready(const Unit&) const {}
    __device__ __forceinline__ void done(const Unit&) const {}
};
template <bool DOWN> struct MoeOrder {
    int t0, nt, nN, G, c; int tb1, tb2, tb3, tb4, tb5, tb6, tb7;
    __device__ bool next(int i, Unit& u) const {
        const int nwg = nt * nN; const long L = (long)i * G + c; if (L >= nwg) return false;
        int wgid = (int)L; { const int q = nwg / NXCD, r = nwg % NXCD, xcd = wgid % NXCD, off = wgid / NXCD; wgid = (xcd < r ? xcd * (q + 1) : r * (q + 1) + (xcd - r) * q) + off; }
        const int nig = WGM * nN, gid = wgid / nig, fm = gid * WGM, gsz = (nt - fm) < WGM ? (nt - fm) : WGM;
        const int pl = fm + ((wgid % nig) % gsz), pn = (wgid % nig) / gsz, pg = t0 + pl;
        const int e = (pg >= tb1) + (pg >= tb2) + (pg >= tb3) + (pg >= tb4) + (pg >= tb5) + (pg >= tb6) + (pg >= tb7);
        u.pn = pn; u.pb = e * nN + pn;
        u.pa = pg; u.pm = pg;
        return true;
    }
    __device__ __forceinline__ void a_ready(const Unit&) const {}
    __device__ __forceinline__ void done(const Unit&) const {}
};

typedef int i32x8 __attribute__((ext_vector_type(8)));
typedef int i32x4_ __attribute__((ext_vector_type(4)));
template <class Epi, class Sched, bool ALIGN_EPI = false, bool SP2 = false, bool F8 = false, int SCB = 0, int SCA = 0>
__device__ __forceinline__ void gemm_phase(PG8_LAS unsigned char* lds, const Gemm g, const Sched& S, const Epi& E) {
    const int tid = threadIdx.x, wid = __builtin_amdgcn_readfirstlane(tid >> 6), lane = tid & 63, wr = wid >> 2, wc = wid & 3, fr = lane & 15, fq = lane >> 4;
    const int KB = F8 ? g.K : 2 * g.K, nt = KB / (2 * BK);
    unsigned voffA[2], voffB[2];
#pragma unroll
    for (int i = 0; i < 2; ++i) { int R, C; stage_rc(tid * 16 + i * 8192, R, C); const int Rb = Epi::PERM ? ((R & ~31) + perm32(R & 31)) : R;
        voffA[i] = (unsigned)(R * KB + C * 2); voffB[i] = (unsigned)(Rb * KB + C * 2); }
    const size_t kstep = (size_t)(BK * 2);
    const size_t hstep = (size_t)HALF * KB;
    const size_t tstep = 2 * hstep;
    const unsigned ldsw = (unsigned)wid * 1024u;
    const int aoff = lds_byte(wr * 64 + fr, fq * 8), boff = lds_byte(wc * 32 + fr, fq * 8);
#define PG8_SA(b, h) (((b) * 2 + (h)) * HTB)
#define PG8_SB(b, h) ((4 + (b) * 2 + (h)) * HTB)
#define PG8_STAGE(bufoff, gbase, voff) do { _Pragma("unroll") for (int _i = 0; _i < 2; ++_i) \
        __builtin_amdgcn_global_load_lds((const unsigned*)((const char*)(gbase) + (voff)[_i]), (PG8_LAS unsigned*)(lds + (bufoff) + ldsw + _i * 8192), 16, 0, 0); } while (0)
#define PG8_LDA(dst, b, h) do { _Pragma("unroll") for (int m = 0; m < 4; ++m) { dst[m].lo = *(const PG8_LAS i32x4_*)(lds + PG8_SA(b, h) + aoff + m * 2048); dst[m].hi = *(const PG8_LAS i32x4_*)(lds + PG8_SA(b, h) + aoff + m * 2048 + 1024); } } while (0)
#define PG8_LDB(dst, b, h) do { _Pragma("unroll") for (int n = 0; n < 2; ++n) { dst[n].lo = *(const PG8_LAS i32x4_*)(lds + PG8_SB(b, h) + boff + n * 2048); dst[n].hi = *(const PG8_LAS i32x4_*)(lds + PG8_SB(b, h) + boff + n * 2048 + 1024); } } while (0)
#define PG8_LO(v) __builtin_bit_cast(bf16x8, __builtin_shufflevector(v, v, 0, 1, 2, 3))
#define PG8_HI(v) __builtin_bit_cast(bf16x8, __builtin_shufflevector(v, v, 4, 5, 6, 7))
#define PG8_MMA(ai, bj, At, Bt) do { __builtin_amdgcn_s_setprio(1); _Pragma("unroll") for (int m = 0; m < 4; ++m) _Pragma("unroll") for (int n = 0; n < 2; ++n) { \
        if constexpr (F8) asm volatile("v_mfma_scale_f32_16x16x128_f8f6f4 %0, %1, %2, %0, %3, %4 op_sel_hi:[0,0,0]" : "+v"(acc[ai][bj][m][n]) : "v"(Bt[n]), "v"(At[m]), "v"(scb_), "v"(sca_)); \
        else { acc[ai][bj][m][n] = __builtin_amdgcn_mfma_f32_16x16x32_bf16(PG8_LO(Bt[n]), PG8_LO(At[m]), acc[ai][bj][m][n], 0, 0, 0); \
               acc[ai][bj][m][n] = __builtin_amdgcn_mfma_f32_16x16x32_bf16(PG8_HI(Bt[n]), PG8_HI(At[m]), acc[ai][bj][m][n], 0, 0, 0); } } __builtin_amdgcn_s_setprio(0); } while (0)
#define PG8_WAIT_V(n) asm volatile("s_waitcnt vmcnt(" #n ")" ::: "memory")
#define PG8_WAIT_L(n) asm volatile("s_waitcnt lgkmcnt(" #n ")" ::: "memory")
#define PG8_BAR __builtin_amdgcn_s_barrier()
#define PG8_SCHED __builtin_amdgcn_sched_barrier(0)
    Unit cur, nxt; int ui = 0;
    if (!S.next(0, cur)) return;
    f32x4 acc[2][2][4][2];
#pragma unroll
    for (int a = 0; a < 2; ++a)
#pragma unroll
        for (int b = 0; b < 2; ++b)
#pragma unroll
            for (int m = 0; m < 4; ++m)
#pragma unroll
                for (int n = 0; n < 2; ++n) acc[a][b][m][n] = (f32x4){0.f, 0.f, 0.f, 0.f};
    const int scb_ = SCB, sca_ = SCA; (void)scb_; (void)sca_;
    i32x8 At[4], B0[2], B1[2];
    const char* cA = (const char*)g.A + (size_t)cur.pa * tstep; const char* cB = (const char*)g.Bt + (size_t)cur.pb * tstep;
    S.a_ready(cur);
    if constexpr (SP2) {
        PG8_STAGE(PG8_SB(0, 0), cB, voffB); PG8_STAGE(PG8_SB(0, 1), cB + hstep, voffB); PG8_STAGE(PG8_SA(0, 0), cA, voffA); PG8_STAGE(PG8_SA(0, 1), cA + hstep, voffA);
        if (wr == 1) PG8_BAR;
        PG8_WAIT_V(2); PG8_BAR;
        PG8_STAGE(PG8_SB(1, 0), cB + kstep, voffB); PG8_STAGE(PG8_SA(1, 0), cA + kstep, voffA); PG8_STAGE(PG8_SB(1, 1), cB + hstep + kstep, voffB);
        PG8_WAIT_V(6); PG8_BAR;
    } else {
        PG8_STAGE(PG8_SB(0, 0), cB, voffB); PG8_STAGE(PG8_SA(0, 0), cA, voffA); PG8_STAGE(PG8_SB(0, 1), cB + hstep, voffB); PG8_STAGE(PG8_SA(0, 1), cA + hstep, voffA);
        if (wr == 1) PG8_BAR;
        PG8_WAIT_V(4); PG8_BAR;
        PG8_STAGE(PG8_SB(1, 0), cB + kstep, voffB); PG8_STAGE(PG8_SA(1, 0), cA + kstep, voffA); PG8_STAGE(PG8_SB(1, 1), cB + hstep + kstep, voffB);
        PG8_WAIT_V(6); PG8_BAR;
    }
    for (;;) {
        const bool has_next = S.next(ui + 1, nxt);
        const char* nA = has_next ? (const char*)g.A + (size_t)nxt.pa * tstep : cA; const char* nB = has_next ? (const char*)g.Bt + (size_t)nxt.pb * tstep : cB;
        for (int t = 0; t < nt; t += 2) {
            const bool last = (t == nt - 2);
            const char* a1 = cA + (size_t)(t + 1) * kstep;
            const char* a2 = last ? nA : cA + (size_t)(t + 2) * kstep; const char* b2 = last ? nB : cB + (size_t)(t + 2) * kstep;
            const char* a3 = a2 + kstep; const char* b3 = b2 + kstep;
            if (last && has_next) S.a_ready(nxt);
            if constexpr (SP2) {
            PG8_LDB(B0, 0, 0); PG8_LDB(B1, 0, 1); PG8_SCHED; PG8_LDA(At, 0, 0); PG8_STAGE(PG8_SA(1, 1), a1 + hstep, voffA);
            PG8_WAIT_V(8); PG8_WAIT_L(0); PG8_BAR; PG8_MMA(0, 0, At, B0); PG8_MMA(0, 1, At, B1); PG8_BAR; PG8_SCHED;
            PG8_LDA(At, 0, 1); PG8_STAGE(PG8_SB(0, 0), b2, voffB); PG8_STAGE(PG8_SB(0, 1), b2 + hstep, voffB); PG8_STAGE(PG8_SA(0, 0), a2, voffA);
            PG8_WAIT_V(8); PG8_WAIT_L(0); PG8_BAR; PG8_MMA(1, 0, At, B0); PG8_MMA(1, 1, At, B1); PG8_BAR; PG8_SCHED;
            PG8_LDB(B0, 1, 0); PG8_LDB(B1, 1, 1); PG8_SCHED; PG8_LDA(At, 1, 0); PG8_STAGE(PG8_SA(0, 1), a2 + hstep, voffA);
            PG8_WAIT_V(8); PG8_WAIT_L(0); PG8_BAR; PG8_MMA(0, 0, At, B0); PG8_MMA(0, 1, At, B1); PG8_BAR; PG8_SCHED;
            PG8_LDA(At, 1, 1); PG8_STAGE(PG8_SB(1, 0), b3, voffB); PG8_STAGE(PG8_SB(1, 1), b3 + hstep, voffB); PG8_STAGE(PG8_SA(1, 0), a3, voffA);
            PG8_WAIT_V(8); PG8_WAIT_L(0); PG8_BAR; PG8_MMA(1, 0, At, B0); PG8_MMA(1, 1, At, B1); PG8_BAR; PG8_SCHED;
            } else {
            PG8_LDB(B0, 0, 0); PG8_SCHED; PG8_LDA(At, 0, 0); PG8_STAGE(PG8_SA(1, 1), a1 + hstep, voffA);
            PG8_WAIT_L(8); PG8_BAR; PG8_WAIT_L(0); PG8_MMA(0, 0, At, B0); PG8_BAR; PG8_SCHED;
            PG8_LDB(B1, 0, 1); PG8_STAGE(PG8_SB(0, 0), b2, voffB);
            PG8_BAR; PG8_WAIT_L(0); PG8_MMA(0, 1, At, B1); PG8_BAR;
            PG8_LDA(At, 0, 1); PG8_STAGE(PG8_SA(0, 0), a2, voffA);
            PG8_BAR; PG8_WAIT_L(0); PG8_MMA(1, 0, At, B0); PG8_BAR; PG8_SCHED;
            PG8_STAGE(PG8_SB(0, 1), b2 + hstep, voffB);
            PG8_WAIT_V(6); PG8_BAR; PG8_MMA(1, 1, At, B1); PG8_BAR;
            PG8_LDB(B0, 1, 0); PG8_SCHED; PG8_LDA(At, 1, 0); PG8_STAGE(PG8_SA(0, 1), a2 + hstep, voffA);
            PG8_WAIT_L(8); PG8_BAR; PG8_WAIT_L(0); PG8_MMA(0, 0, At, B0); PG8_BAR; PG8_SCHED;
            PG8_LDB(B1, 1, 1); PG8_STAGE(PG8_SB(1, 0), b3, voffB);
            PG8_BAR; PG8_WAIT_L(0); PG8_MMA(0, 1, At, B1); PG8_BAR;
            PG8_LDA(At, 1, 1); PG8_STAGE(PG8_SA(1, 0), a3, voffA);
            PG8_BAR; PG8_WAIT_L(0); PG8_MMA(1, 0, At, B0); PG8_BAR; PG8_SCHED;
            PG8_STAGE(PG8_SB(1, 1), b3 + hstep, voffB);
            PG8_WAIT_V(6); PG8_BAR; PG8_MMA(1, 1, At, B1); PG8_BAR;
            }
        }
        if constexpr (ALIGN_EPI) { if (wr == 0) PG8_BAR; }
        if constexpr (F8) asm volatile("s_nop 15\n\ts_nop 15" ::: "memory");
        if constexpr (Epi::ROWSCALE) {
            const float* rp = E.rs + cur.pm * BM + wr * 64 + fr;
#pragma unroll
            for (int a = 0; a < 2; ++a)
#pragma unroll
                for (int m = 0; m < 4; ++m) { const float s_ = rp[a * HALF + m * 16];
#pragma unroll
                    for (int b = 0; b < 2; ++b)
#pragma unroll
                        for (int n = 0; n < 2; ++n) acc[a][b][m][n] *= s_; } }
        if constexpr (!Epi::AFTER_DRAIN) { E(acc, cur, wr, wc, fr, fq); S.done(cur); }
        if (!has_next) break;
#pragma unroll
        for (int a = 0; a < 2; ++a)
#pragma unroll
            for (int b = 0; b < 2; ++b)
#pragma unroll
                for (int m = 0; m < 4; ++m)
#pragma unroll
                    for (int n = 0; n < 2; ++n) acc[a][b][m][n] = (f32x4){0.f, 0.f, 0.f, 0.f};
        cur = nxt; cA = nA; cB = nB; ++ui;
        if constexpr (ALIGN_EPI) { if (wr == 1) PG8_BAR; }
    }
    PG8_WAIT_V(0);
    if constexpr (!ALIGN_EPI) { if (wr == 0) PG8_BAR; }
    PG8_BAR;
    if constexpr (Epi::AFTER_DRAIN) { E.fused(acc, cur, wr, wc, fr, fq, lds, wid, lane); S.done(cur); }
#undef PG8_SA
#undef PG8_SB
#undef PG8_STAGE
#undef PG8_LDA
#undef PG8_LDB
#undef PG8_MMA
#undef PG8_WAIT_V
#undef PG8_WAIT_L
#undef PG8_BAR
#undef PG8_SCHED
}
}

namespace att {
typedef unsigned short bf16;
typedef short bf16x8 __attribute__((ext_vector_type(8)));
typedef short s16x4 __attribute__((ext_vector_type(4)));
typedef float f32x16 __attribute__((ext_vector_type(16)));
typedef float f32x4 __attribute__((ext_vector_type(4)));
typedef unsigned u32x4 __attribute__((ext_vector_type(4)));
constexpr int D = 128, NW = 8, QBLK = 32, KVBLK = 64, QB = NW * QBLK;
constexpr int SHM_V = KVBLK * D * 2, SHM_K = KVBLK * D * 2;
constexpr float SCALE = 0.08838834764831845f, THR = 8.f;
constexpr int WS_OFF = 2 * SHM_V + 2 * SHM_K, CB_OFF = WS_OFF + NW * 128 * 4, OT_OFF = CB_OFF + 512, OT_PITCH = 272, OT_WAVE = 32 * OT_PITCH, ATT_LDS = OT_OFF + NW * OT_WAVE;
enum { MODE_WIN = 0, MODE_SLC = 1, MODE_FOX = 2 };

#define KSWZ(row, colB) ((row) * 256 + ((colB) ^ (((row) & 15) << 4)))
#define SBAR() __builtin_amdgcn_sched_barrier(0)
__device__ __forceinline__ int v_st(int k, int c) { const int kk = (k & ~0xC) | ((k & 4) << 1) | ((k & 8) >> 1); return ((kk >> 3) * 4 + (c >> 5)) * 512 + ((kk & 7) * 32 + (c & 31)) * 2; }
__device__ __forceinline__ int v_rd_base(int lane) { return ((lane & 3) << 3) | (((lane >> 2) & 3) << 6) | (((lane >> 4) & 1) << 5) | (((lane >> 5) & 1) << 8); }
constexpr int v_rd_off(int d0, int ks, int half) { return d0 * 512 + ks * 4096 + half * 2048; }
__device__ __forceinline__ int crow(int r, int hi) { return (r & 3) + 8 * (r >> 2) + 4 * hi; }
__device__ __forceinline__ unsigned cvtpk(float lo, float hi) { unsigned r; asm volatile("v_cvt_pk_bf16_f32 %0, %1, %2" : "=v"(r) : "v"(lo), "v"(hi)); return r; }
__device__ __forceinline__ bf16x8 load8(const bf16* p) { return *reinterpret_cast<const bf16x8*>(p); }
__device__ __forceinline__ float bf_lo(unsigned w) { return __uint_as_float(w << 16); }
__device__ __forceinline__ float bf_hi(unsigned w) { return __uint_as_float(w & 0xffff0000u); }
__device__ __forceinline__ void mask_tile(f32x16& p0, f32x16& p1, int dq, unsigned W) {
    const float NEG = -__builtin_inff();
#pragma unroll
    for (int r = 0; r < 16; ++r) {
        const int c = (r & 3) + 8 * (r >> 2);
        if ((unsigned)(dq - c) >= W) p0[r] = NEG;
        if ((unsigned)(dq - c - 32) >= W) p1[r] = NEG;
    }
}
template <bool RS>
__device__ __forceinline__ void partialSM(f32x16& p0, f32x16& p1, float& m_reg, float& mn, float& alpha, bool sel) {
    float pmax = p0[0]; for (int r = 1; r < 16; ++r) pmax = fmaxf(pmax, p0[r]); for (int r = 0; r < 16; ++r) pmax = fmaxf(pmax, p1[r]);
    { auto rr = __builtin_amdgcn_permlane32_swap(__float_as_uint(pmax), __float_as_uint(pmax), false, false);
      pmax = fmaxf(__uint_as_float(rr[0]), __uint_as_float(rr[1])); }
    if (RS) pmax = sel ? pmax : -__builtin_inff();
    constexpr float C2 = 1.4426950408889634f * SCALE;
    if (__builtin_expect(__all((pmax - m_reg) * SCALE <= THR), 1)) { mn = m_reg; alpha = 1.f; }
    else { mn = fmaxf(m_reg, pmax); alpha = __builtin_amdgcn_exp2f((m_reg - mn) * C2); m_reg = mn; }
    float mnL = -mn * C2;
    if (RS) mnL = sel ? mnL : -__builtin_inff();
    for (int r = 0; r < 16; ++r) p0[r] = fmaf(p0[r], C2, mnL); for (int r = 0; r < 16; ++r) p1[r] = fmaf(p1[r], C2, mnL);
    for (int r = 0; r < 16; ++r) p0[r] = __builtin_amdgcn_exp2f(p0[r]);
}
#define ATT_PK4(P, B_, OUT) do { unsigned a0 = cvtpk(P[B_+0], P[B_+1]), a1 = cvtpk(P[B_+2], P[B_+3]);                          \
        unsigned b0 = cvtpk(P[B_+4], P[B_+5]), b1 = cvtpk(P[B_+6], P[B_+7]);                                             \
        auto r0 = __builtin_amdgcn_permlane32_swap(a0, b0, false, false); auto r1 = __builtin_amdgcn_permlane32_swap(a1, b1, false, false); \
        u32x4 w = {r0[0], r1[0], r0[1], r1[1]}; OUT = *reinterpret_cast<bf16x8*>(&w); } while (0)
__device__ __forceinline__ void finishSM(f32x16& p0, f32x16& p1, float alpha, float& l_reg, bf16x8& pa0, bf16x8& pa1, bf16x8& pa2, bf16x8& pa3) {
    for (int r = 0; r < 16; ++r) p1[r] = __builtin_amdgcn_exp2f(p1[r]);
    float ps = 0; for (int r = 0; r < 16; ++r) ps += p0[r]; for (int r = 0; r < 16; ++r) ps += p1[r];
    { auto rr = __builtin_amdgcn_permlane32_swap(__float_as_uint(ps), __float_as_uint(ps), false, false);
      ps = __uint_as_float(rr[0]) + __uint_as_float(rr[1]); }
    l_reg = l_reg * alpha + ps;
    ATT_PK4(p0, 0, pa0); ATT_PK4(p0, 8, pa1); ATT_PK4(p1, 0, pa2); ATT_PK4(p1, 8, pa3);
}
template <int KB, int MODE>
__device__ __forceinline__ void qkt(f32x16& p0, f32x16& p1, const char* K_lds, const char* C_lds, int r32, int hi, const bf16x8* qr, float cq, int tk = 0) {
    if (MODE == MODE_FOX) {
        const char* cb = C_lds + KB * 256 + hi * 16;
#pragma unroll
        for (int i = 0; i < 4; ++i) { const f32x4 a = *reinterpret_cast<const f32x4*>(cb + i * 32); const f32x4 b = *reinterpret_cast<const f32x4*>(cb + 128 + i * 32);
#pragma unroll
            for (int j = 0; j < 4; ++j) { p0[4 * i + j] = a[j]; p1[4 * i + j] = b[j]; } }
    } else { p0 = f32x16{}; p1 = f32x16{}; }
    typedef const __attribute__((address_space(3))) bf16x8* lds_b8p;
    unsigned ka = 0; int ko[4] = {0, 0, 0, 0}, flip = 128;
    if (MODE == MODE_WIN) {
#pragma unroll
        for (int dd = 0; dd < 4; ++dd) ko[dd] = KSWZ(r32, (dd * 16 + hi * 8) * 2);
        asm volatile("" : "+v"(flip));
    } else {
        ka = (unsigned)(uintptr_t)(const __attribute__((address_space(3))) char*)K_lds + KSWZ(r32, hi * 16);
        asm("" : "+v"(ka) : "s"(tk));
    }
#pragma unroll
    for (int d0 = 0; d0 < 8; ++d0) {
        bf16x8 b0, b1;
        if (MODE == MODE_WIN) { const char* a = K_lds + KB * SHM_K + (d0 < 4 ? ko[d0] : (ko[d0 & 3] ^ flip));
            b0 = *reinterpret_cast<const bf16x8*>(a); b1 = *reinterpret_cast<const bf16x8*>(a + 32 * 256);
        } else { const unsigned a = (ka ^ (unsigned)(d0 * 32)) + KB * SHM_K;
            b0 = *(lds_b8p)(uintptr_t)a; b1 = *(lds_b8p)(uintptr_t)(a + 32 * 256); }
        p0 = __builtin_amdgcn_mfma_f32_32x32x16_bf16(b0, qr[d0], p0, 0, 0, 0);
        p1 = __builtin_amdgcn_mfma_f32_32x32x16_bf16(b1, qr[d0], p1, 0, 0, 0); }
}
template <int VB>
__device__ __forceinline__ void pv_tile(f32x16* o, int vb0, bf16x8 pa0, bf16x8 pa1, bf16x8 pa2, bf16x8 pa3) {
#define TRRD(dst, off) asm volatile("ds_read_b64_tr_b16 %0, %1 offset:%2" : "=&v"(dst) : "v"(vb0), "i"(off) : "memory")
#define PV_D0(d0) do { s16x4 l0, l1, l2, l3, h0, h1, h2, h3; constexpr int b_ = VB * SHM_V + v_rd_off(d0, 0, 0);   \
        TRRD(l0, b_); TRRD(h0, b_ + 2048); TRRD(l1, b_ + 4096); TRRD(h1, b_ + 6144); TRRD(l2, b_ + 8192); TRRD(h2, b_ + 10240); TRRD(l3, b_ + 12288); TRRD(h3, b_ + 14336); \
        asm volatile("s_waitcnt lgkmcnt(0)" ::: "memory"); SBAR();   \
        o[d0] = __builtin_amdgcn_mfma_f32_32x32x16_bf16(pa0, (bf16x8){l0[0], l0[1], l0[2], l0[3], h0[0], h0[1], h0[2], h0[3]}, o[d0], 0, 0, 0);   \
        o[d0] = __builtin_amdgcn_mfma_f32_32x32x16_bf16(pa1, (bf16x8){l1[0], l1[1], l1[2], l1[3], h1[0], h1[1], h1[2], h1[3]}, o[d0], 0, 0, 0);   \
        o[d0] = __builtin_amdgcn_mfma_f32_32x32x16_bf16(pa2, (bf16x8){l2[0], l2[1], l2[2], l2[3], h2[0], h2[1], h2[2], h2[3]}, o[d0], 0, 0, 0);   \
        o[d0] = __builtin_amdgcn_mfma_f32_32x32x16_bf16(pa3, (bf16x8){l3[0], l3[1], l3[2], l3[3], h3[0], h3[1], h3[2], h3[3]}, o[d0], 0, 0, 0); } while (0)
    PV_D0(0); PV_D0(1); PV_D0(2); PV_D0(3);
#undef PV_D0
#undef TRRD
}

template <int VB, bool RS>
__device__ __forceinline__ void pv_sm_tile(f32x16* o, int vb0, bf16x8 pa0, bf16x8 pa1, bf16x8 pa2, bf16x8 pa3, f32x16& p0, f32x16& p1, float& m_reg, float& mn, float& alpha, bool sel) {
#define TRRD(dst, off) asm volatile("ds_read_b64_tr_b16 %0, %1 offset:%2" : "=&v"(dst) : "v"(vb0), "i"(off) : "memory")
#define PV_RD(g) s16x4 l0##g, l1##g, l2##g, l3##g, h0##g, h1##g, h2##g, h3##g; { constexpr int b_ = VB * SHM_V + v_rd_off(g, 0, 0);   \
        TRRD(l0##g, b_); TRRD(h0##g, b_ + 2048); TRRD(l1##g, b_ + 4096); TRRD(h1##g, b_ + 6144); TRRD(l2##g, b_ + 8192); TRRD(h2##g, b_ + 10240); TRRD(l3##g, b_ + 12288); TRRD(h3##g, b_ + 14336); }
#define PV_WT() do { asm volatile("s_waitcnt lgkmcnt(0)" ::: "memory"); SBAR(); } while (0)
#define PV_MM(g) do {   \
        o[g] = __builtin_amdgcn_mfma_f32_32x32x16_bf16(pa0, (bf16x8){l0##g[0], l0##g[1], l0##g[2], l0##g[3], h0##g[0], h0##g[1], h0##g[2], h0##g[3]}, o[g], 0, 0, 0);   \
        o[g] = __builtin_amdgcn_mfma_f32_32x32x16_bf16(pa1, (bf16x8){l1##g[0], l1##g[1], l1##g[2], l1##g[3], h1##g[0], h1##g[1], h1##g[2], h1##g[3]}, o[g], 0, 0, 0);   \
        o[g] = __builtin_amdgcn_mfma_f32_32x32x16_bf16(pa2, (bf16x8){l2##g[0], l2##g[1], l2##g[2], l2##g[3], h2##g[0], h2##g[1], h2##g[2], h2##g[3]}, o[g], 0, 0, 0);   \
        o[g] = __builtin_amdgcn_mfma_f32_32x32x16_bf16(pa3, (bf16x8){l3##g[0], l3##g[1], l3##g[2], l3##g[3], h3##g[0], h3##g[1], h3##g[2], h3##g[3]}, o[g], 0, 0, 0); } while (0)
    constexpr float C2 = 1.4426950408889634f * SCALE;
    PV_RD(0); PV_WT();
    PV_MM(0); PV_RD(1);
    float pmax = p0[0];
#pragma unroll
    for (int r = 1; r < 16; ++r) pmax = fmaxf(pmax, p0[r]);
#pragma unroll
    for (int r = 0; r < 16; ++r) pmax = fmaxf(pmax, p1[r]);
    { auto rr = __builtin_amdgcn_permlane32_swap(__float_as_uint(pmax), __float_as_uint(pmax), false, false);
      pmax = fmaxf(__uint_as_float(rr[0]), __uint_as_float(rr[1])); }
    if (RS) pmax = sel ? pmax : -__builtin_inff();
    PV_WT();
    PV_MM(1); PV_RD(2);
    { const bool keep = __all((pmax - m_reg) * SCALE <= THR);
      mn = keep ? m_reg : fmaxf(m_reg, pmax); alpha = __builtin_amdgcn_exp2f((m_reg - mn) * C2); m_reg = mn; }
    float mnL = -mn * C2;
    if (RS) mnL = sel ? mnL : -__builtin_inff();
#pragma unroll
    for (int r = 0; r < 16; ++r) p0[r] = fmaf(p0[r], C2, mnL);
#pragma unroll
    for (int r = 0; r < 16; ++r) p1[r] = fmaf(p1[r], C2, mnL);
    asm volatile("" : "+v"(p0), "+v"(p1));
    PV_WT();
    PV_MM(2); PV_RD(3);
#pragma unroll
    for (int r = 0; r < 8; ++r) p0[r] = __builtin_amdgcn_exp2f(p0[r]);
    asm volatile("" : "+v"(p0));
    PV_WT();
    PV_MM(3);
#pragma unroll
    for (int r = 8; r < 16; ++r) p0[r] = __builtin_amdgcn_exp2f(p0[r]);
    asm volatile("" : "+v"(p0));
#undef PV_MM
#undef PV_WT
#undef PV_RD
#undef TRRD
}

struct BlockRef { const bf16* Q; const bf16* K; const bf16* V; bf16* O; int P0; const float* aux; const unsigned long long* selm; };
struct Seam { bf16x8 qr[8]; bf16x8 st_v0, st_v1, st_k0, st_k1; float st_c; };
__device__ __forceinline__ int swa_jlo(int P0, int W) { const int lowk = P0 - W + 1; return lowk > 0 ? lowk / KVBLK : 0; }
template <int MODE, bool GQA>
__device__ __forceinline__ int first_kb(int P0, int W, int skv) {
    if (MODE == MODE_WIN) return swa_jlo(P0, W) * KVBLK;
    int jh = (P0 + (GQA ? 2 * QBLK : QB) - 1) / KVBLK + 1; if (jh > skv / KVBLK) jh = skv / KVBLK; return (jh - 1) * KVBLK; }
#define ROW(p, k0, hf) ((p) + (size_t)(((k0) + 32 * (hf)) * KS) + lane_off)
#define VMW() asm volatile("s_waitcnt vmcnt(0)" ::: "memory")
#define VMWN(n) asm volatile("s_waitcnt vmcnt(%0)" :: "i"(n) : "memory")
#define SLOAD_K(Kp, Cp, k0) do { S.st_k0 = load8(ROW(Kp, k0, 0)); S.st_k1 = load8(ROW(Kp, k0, 1));                  \
                         if (MODE == MODE_FOX) { if (tid < 64) S.st_c = (Cp)[(k0) + tid]; } } while (0)
#define SLOAD_V(Vp, k0) do { S.st_v0 = load8(ROW(Vp, k0, 0)); S.st_v1 = load8(ROW(Vp, k0, 1)); } while (0)
#define SLOAD_H(Kp, Vp, Cp, k0) do { SLOAD_K(Kp, Cp, k0); SLOAD_V(Vp, k0); } while (0)
#define SWRITE_HK(bf) do { *(bf16x8*)(K_lds + (bf) * SHM_K + kws) = S.st_k0; *(bf16x8*)(K_lds + (bf) * SHM_K + kws + 32 * 256) = S.st_k1;   \
                         if (MODE == MODE_FOX) { if (tid < 64) *reinterpret_cast<float*>(C_lds + (bf) * 256 + tid * 4) = -S.st_c; } } while (0)
#define SWRITE_HV(bf) do { *(bf16x8*)(V_lds + (bf) * SHM_V + vst0) = S.st_v0; *(bf16x8*)(V_lds + (bf) * SHM_V + vst1) = S.st_v1; } while (0)
#define SWRITE_H(bf) do { SWRITE_HV(bf); SWRITE_HK(bf); } while (0)
template <int MODE, int QS, int KS, bool GQA>
__device__ __forceinline__ void att_prime(const BlockRef& cur, int skv, int W, char* lds, Seam& S) {
    const int tid = threadIdx.x, wid = __builtin_amdgcn_readfirstlane(tid >> 6), lane = tid & 63, r32 = lane & 31, hi = lane >> 5;
    const int sr = tid >> 4, sc = (tid & 15) * 8, kws = KSWZ(sr, sc * 2); char* K_lds = lds + 2 * SHM_V; char* C_lds = lds + CB_OFF; const unsigned lane_off = (unsigned)(sr * KS + sc);
    const int kb0 = first_kb<MODE, GQA>(cur.P0, W, skv);
#pragma unroll
    for (int d0 = 0; d0 < 8; ++d0) S.qr[d0] = load8(cur.Q + (unsigned)((GQA ? ((wid & 1) * QBLK + r32) * QS + (wid >> 1) * D : (wid * QBLK + r32) * QS) + d0 * 16 + hi * 8));
    SLOAD_H(cur.K, cur.V, cur.aux, kb0); VMW(); SWRITE_HK(0);
    __syncthreads();
}
template <int MODE, int QS, int KS, int OS, bool ACCUM, bool GQA>
__device__ __forceinline__ void att_block(const BlockRef& cur, const BlockRef& nxt, int skv, int W, char* lds, Seam& S) {
    constexpr bool RS = MODE == MODE_SLC, AHEAD = MODE == MODE_FOX;
    const int tid = threadIdx.x, wid = __builtin_amdgcn_readfirstlane(tid >> 6), lane = tid & 63, r32 = lane & 31, hi = lane >> 5;
    const int j_lo = swa_jlo(cur.P0, W);
    constexpr int TOKB = GQA ? 2 * QBLK : QB;
    int j_hi = (cur.P0 + TOKB - 1) / KVBLK + 1; if (j_hi > skv / KVBLK) j_hi = skv / KVBLK;
    const int rowt = GQA ? (wid & 1) * QBLK : wid * QBLK;
    const int NT = j_hi - j_lo;
    const int kbn = first_kb<MODE, GQA>(nxt.P0, W, skv);
    const int qlo = cur.P0 + rowt, qm = qlo + r32 - 4 * hi;
    char* V_lds = lds; char* K_lds = lds + 2 * SHM_V; char* C_lds = lds + CB_OFF;
    float* ws = (float*)(lds + WS_OFF) + wid * 128; float* li_l = ws, * al_l = ws + 32; unsigned long long* rm_l = (unsigned long long*)(ws + 64);
    float m_reg = -1e30f, l_reg = 0; f32x16 o[4] = {};
    const int sr = tid >> 4, sc = (tid & 15) * 8, vst0 = v_st(sr, sc), vst1 = vst0 + 8192  , kws = KSWZ(sr, sc * 2); const unsigned lane_off = (unsigned)(sr * KS + sc);
    const int vb0 = (int)(uintptr_t)V_lds + v_rd_base(lane);
    const bf16* Kh = cur.K; const bf16* Vh = cur.V; const float* Ch = cur.aux;
    float cq = 0.f, gate = 1.f; unsigned long long rmask;
    if (MODE != MODE_FOX) { gate = cur.aux[(unsigned)((rowt + r32) * 48 + (GQA ? (wid >> 1) : 0))]; if (hi == 0) li_l[r32] = gate; }
    if (MODE == MODE_SLC) { rmask = cur.selm[rowt + r32]; if (hi == 0) rm_l[r32] = rmask; }
#define RESC(a) do { if (__any((a) < 1.f)) { if (hi == 0) al_l[r32] = (a); asm volatile("s_waitcnt lgkmcnt(0)" ::: "memory");              \
                     for (int d_ = 0; d_ < 4; ++d_) for (int r = 0; r < 16; ++r) o[d_][r] *= al_l[crow(r, hi)]; } } while (0)
#define TILE(t) (MODE != MODE_WIN ? j_hi - 1 - (t) : j_lo + (t))
#define KBASE(t) (TILE(t) * KVBLK)
#define SEL(t) (MODE == MODE_SLC ? (((rm_l[r32] >> TILE(t)) & 1ull) != 0ull) : true)
#define MASKT(P0_, P1_, t) do { const int kb_ = KBASE(t); if (kb_ + KVBLK - 1 > qlo || kb_ <= qlo + QBLK - 1 - W) mask_tile(P0_, P1_, qm - kb_, (unsigned)W); } while (0)
#define SEAM_K0() do { if constexpr (ACCUM) VMWN(16); else VMWN(8); SWRITE_HK(0); SBAR(); } while (0)
    f32x16 pA0, pA1, pB0, pB1; float mnA, mnB, alA, alB; bf16x8 pa0, pa1, pa2, pa3;
    SWRITE_HV(0); SBAR();
    if (NT > 1) SLOAD_H(Kh, Vh, Ch, KBASE(1));
    SBAR(); qkt<0, MODE>(pA0, pA1, K_lds, C_lds, r32, hi, S.qr, cq);
    MASKT(pA0, pA1, 0); partialSM<RS>(pA0, pA1, m_reg, mnA, alA, SEL(0));
    if (NT > 1) { if constexpr (AHEAD) { SWRITE_HK(1); if (NT > 2) SLOAD_K(Kh, Ch, KBASE(2)); } else { VMW(); SWRITE_H(1); } }
    __syncthreads();
#define HALF_STEP(PX0, PX1, mnX, alX, PY0, PY1, alY, t, KB, VB, SB) do {                                                      \
        SBAR(); qkt<KB, MODE>(PX0, PX1, K_lds, C_lds, r32, hi, S.qr, cq, (t));                                                     \
        finishSM(PY0, PY1, alY, l_reg, pa0, pa1, pa2, pa3); SBAR();                                                           \
        if constexpr (AHEAD) { SWRITE_HV(KB); if ((t) + 1 < NT) { SLOAD_V(Vh, KBASE((t) + 1)); } SBAR(); }                    \
        else if ((t) + 1 < NT) { SLOAD_H(Kh, Vh, Ch, KBASE((t) + 1)); SBAR(); }                                               \
        MASKT(PX0, PX1, (t)); SBAR(); pv_sm_tile<VB, RS>(o, vb0, pa0, pa1, pa2, pa3, PX0, PX1, m_reg, mnX, alX, SEL(t));          \
        if constexpr (AHEAD) { if ((t) + 1 < NT) SWRITE_HK(SB); if ((t) + 2 < NT) SLOAD_K(Kh, Ch, KBASE((t) + 2)); }          \
        else if ((t) + 1 < NT) { VMWN(2); SWRITE_HK(SB); }     \
        __syncthreads();                                               \
        if constexpr (!AHEAD) { if ((t) + 1 < NT) { VMW(); SWRITE_HV(SB); } }     \
        RESC(alX); } while (0)
    for (int t = 1; t + 1 < NT; t += 2) {
        HALF_STEP(pB0, pB1, mnB, alB, pA0, pA1, alA, t, 1, 0, 0);
        HALF_STEP(pA0, pA1, mnA, alA, pB0, pB1, alB, t + 1, 0, 1, 1);
    }
    const bool even = (NT & 1) == 0;
    if (even) { SBAR(); qkt<1, MODE>(pB0, pB1, K_lds, C_lds, r32, hi, S.qr, cq, NT); if constexpr (AHEAD) SWRITE_HV(1); SBAR(); }
    SLOAD_H(nxt.K, nxt.V, nxt.aux, kbn); SBAR();
#pragma unroll
    for (int d0 = 0; d0 < 8; ++d0) S.qr[d0] = load8(nxt.Q + (unsigned)((GQA ? (rowt + r32) * QS + (wid >> 1) * D : (rowt + r32) * QS) + d0 * 16 + hi * 8));
    bf16* Ow = cur.O + (GQA ? (unsigned)(rowt * OS + (wid >> 1) * D) : (unsigned)(rowt * OS));
    u32x4 oldv[8];
    if constexpr (ACCUM) {
#pragma unroll
        for (int j = 0; j < 8; ++j) oldv[j] = *(const u32x4*)(Ow + (size_t)(j * 4 * OS) + (unsigned)((lane >> 4) * OS + (lane & 15) * 8)); }
    SBAR();
    finishSM(pA0, pA1, alA, l_reg, pa0, pa1, pa2, pa3); SBAR();
    pv_tile<0>(o, vb0, pa0, pa1, pa2, pa3);
    if (even) { MASKT(pB0, pB1, NT - 1); partialSM<RS>(pB0, pB1, m_reg, mnB, alB, SEL(NT - 1)); __syncthreads(); RESC(alB);
        finishSM(pB0, pB1, alB, l_reg, pa0, pa1, pa2, pa3); SBAR(); pv_tile<1>(o, vb0, pa0, pa1, pa2, pa3); }
    SBAR(); SEAM_K0();
    if (hi == 0) li_l[r32] = (MODE == MODE_FOX ? 1.f : li_l[r32]) / l_reg; asm volatile("s_waitcnt lgkmcnt(0)" ::: "memory");
    float rli[16];
#pragma unroll
    for (int r = 0; r < 16; ++r) rli[r] = li_l[crow(r, hi)];
    if constexpr (ACCUM) {
    int lane_e = lane; asm volatile("" : "+v"(lane_e));
    const int r32e = lane_e & 31, hie = lane_e >> 5;
    char* ot = lds + OT_OFF + wid * OT_WAVE;
    char* otw = ot + hie * (4 * OT_PITCH) + r32e * 2;
#pragma unroll
    for (int r = 0; r < 16; ++r) { const int cr = (r & 3) + 8 * (r >> 2);
#pragma unroll
        for (int d0 = 0; d0 < 4; ++d0) { const float v = o[d0][r] * rli[r]; const float vn = __shfl_xor(v, 1);
            if ((r32e & 1) == 0) *(unsigned*)(otw + cr * OT_PITCH + d0 * 64) = cvtpk(v, vn); } }
    asm volatile("s_waitcnt lgkmcnt(0)" ::: "memory");
    const char* otr = ot + (lane_e >> 4) * OT_PITCH + (lane_e & 15) * 16;
    const unsigned goff = (unsigned)((lane_e >> 4) * OS + (lane_e & 15) * 8);
#pragma unroll
    for (int j = 0; j < 8; ++j) {
        u32x4 w = *(const u32x4*)(otr + j * 4 * OT_PITCH); u32x4* gp = (u32x4*)(Ow + (size_t)(j * 4 * OS) + goff);
        if (ACCUM) { const u32x4 old = oldv[j];
#pragma unroll
            for (int e = 0; e < 4; ++e) w[e] = cvtpk(bf_lo(w[e]) + bf_lo(old[e]), bf_hi(w[e]) + bf_hi(old[e])); }
        *gp = w; }
    } else {
#pragma unroll
        for (int r = 0; r < 16; ++r) { const int orow = crow(r, hi);
#pragma unroll
            for (int d0 = 0; d0 < 4; ++d0) { const float v = o[d0][r] * rli[r]; const float vn = __shfl_xor(v, 1);
                if ((r32 & 1) == 0) *(unsigned*)(Ow + (unsigned)(orow * OS + d0 * 32 + r32)) = cvtpk(v, vn); } }
    }
    __syncthreads();
#undef RESC
#undef KBASE
#undef TILE
#undef SEL
#undef MASKT
#undef SEAM_K0
#undef HALF_STEP
}
#undef ROW
#undef VMWN
#undef SLOAD_H
#undef SWRITE_HK
#undef SWRITE_HV
#undef SWRITE_H

struct AttnPtrs { const bf16* Q; const bf16* K; const bf16* V; bf16* O; const float* aux; const unsigned long long* selm; };
template <int MODE, int KS, bool GQA>
__device__ __forceinline__ BlockRef att_ref(const AttnPtrs& P, int b, int h, int qb) {
    constexpr int TOKB = GQA ? 2 * QBLK : QB;
    BlockRef r; const size_t row0 = (size_t)b * SEQ + (size_t)qb * TOKB;
    r.Q = P.Q + row0 * DM + h * HD; r.O = P.O + row0 * DM + h * HD; r.P0 = qb * TOKB;
    if (MODE == MODE_FOX) { r.K = P.K + (size_t)b * SEQ * KS + h * HD; r.V = P.V + (size_t)b * SEQ * KS + h * HD; r.aux = P.aux + ((size_t)b * NH + h) * SEQ; r.selm = nullptr; }
    else { const int g = h >> 2; r.K = P.K + (size_t)b * SEQ * KS + g * HD; r.V = P.V + (size_t)b * SEQ * KS + g * HD;
           r.aux = P.aux + row0 * 48 + (MODE == MODE_SLC ? 16 : 32) + h; r.selm = MODE == MODE_SLC ? P.selm + ((size_t)b * NG + g) * SEQ + (size_t)qb * TOKB : nullptr; }
    return r;
}
template <int MODE, int KS, bool ACCUM>
__device__ __forceinline__ void attn_phase(char* lds, const AttnPtrs& P, int G, int c) {
    constexpr bool GQA = MODE != MODE_FOX;
    constexpr bool PAIRED = MODE != MODE_WIN; constexpr int W = MODE == MODE_WIN ? 512 : (1 << 20);
    constexpr int NBLK = GQA ? SEQ / 64 : SEQ / QB, NHEADU = GQA ? NG : NH;
    constexpr int PER = PAIRED ? NBLK / 2 : NBLK, total = NB * NHEADU * PER;
    int L = c; if (L >= total) return;
    int pass = 0;
#define DEC(L_, pass_, out) do { const int b_ = (L_) & 7, s_ = (L_) >> 3, hu_ = s_ / PER, x_ = s_ % PER; const int qb_ = PAIRED ? ((pass_) ? NBLK - 1 - x_ : x_) : x_; \
        out = att_ref<MODE, KS, GQA>(P, b_, GQA ? 4 * hu_ : hu_, qb_); } while (0)
    BlockRef cur; DEC(L, 0, cur);
    Seam S;
    att_prime<MODE, DM, KS, GQA>(cur, SEQ, W, lds, S);
    for (;;) {
        const bool more_pass = PAIRED && pass == 0, more_item = L + G < total, last = !more_pass && !more_item;
        int passn = pass + 1, Ln = L;
        if (!more_pass) { passn = 0; Ln = more_item ? L + G : L; }
        BlockRef nxt; if (last) nxt = cur; else DEC(Ln, passn, nxt);
        att_block<MODE, DM, KS, DM, ACCUM, GQA>(cur, nxt, SEQ, W, lds, S);
        if (last) break;
        cur = nxt; pass = passn; L = Ln;
    }
#undef DEC
}
#undef VMW
constexpr int CMP_K_OFF = 4 * SHM_V, CMP_IMP_OFF = 8 * SHM_V, CMP_WS_OFF = CMP_IMP_OFF + 16896, CMP_LDS = CMP_WS_OFF + NW * 256;
template <int T> __device__ __forceinline__ void cmp_mask(f32x16& p0, f32x16& p1, int dq) {
    const float NEG = -__builtin_inff();
#pragma unroll
    for (int r = 0; r < 16; ++r) { const int cc = (r & 3) + 8 * (r >> 2); if (cc > dq) p0[r] = NEG; if (cc + 32 > dq) p1[r] = NEG; }
}
struct CmpPtrs { const bf16* Q; const bf16* CK; const bf16* CV; bf16* O; const float* gates; unsigned long long* selm; };
__device__ __forceinline__ void cmp_stage(char* lds, const CmpPtrs& P, int b, int g, int NT) {
    const int tid = threadIdx.x; char* V_lds = lds; char* K_lds = lds + CMP_K_OFF;
    const int sr = tid >> 4, sc = (tid & 15) * 8, vst0 = v_st(sr, sc), vst1 = v_st(32 + sr, sc), kws = KSWZ(sr, sc * 2);
    const bf16* kp = P.CK + ((size_t)(b * 256) * NG + g) * HD + sc; const bf16* vp = P.CV + ((size_t)(b * 256) * NG + g) * HD + sc;
    bf16x8 k0[4], k1[4], v0[4], v1[4];
#pragma unroll
    for (int T = 0; T < 4; ++T) if (T < NT) { const unsigned o0 = (unsigned)((T * 64 + sr) * NG * HD), o1 = (unsigned)((T * 64 + 32 + sr) * NG * HD);
        k0[T] = load8(kp + o0); k1[T] = load8(kp + o1); v0[T] = load8(vp + o0); v1[T] = load8(vp + o1); }
#pragma unroll
    for (int T = 0; T < 4; ++T) if (T < NT) {
        *(bf16x8*)(K_lds + T * SHM_K + kws) = k0[T]; *(bf16x8*)(K_lds + T * SHM_K + kws + 32 * 256) = k1[T];
        *(bf16x8*)(V_lds + T * SHM_V + vst0) = v0[T]; *(bf16x8*)(V_lds + T * SHM_V + vst1) = v1[T]; }
}
__device__ __forceinline__ void cmp_load_q(const CmpPtrs& P, int b, int g, int tb, int wid, int r32, int hi, bf16x8* qr, float& gate) {
    const int pos = tb * 64 + 8 * wid + (r32 & 7), h = 4 * g + (r32 >> 3);
    const bf16* qp = P.Q + ((size_t)b * SEQ + pos) * DM + h * HD + hi * 8;
#pragma unroll
    for (int d0 = 0; d0 < 8; ++d0) qr[d0] = load8(qp + d0 * 16);
    gate = P.gates[((size_t)b * SEQ + pos) * 48 + h];
}
__device__ __forceinline__ void cmp_unit(char* lds, const CmpPtrs& P, int b, int g, int tb, const bf16x8* qr, float gate) {
    const int tid = threadIdx.x, wid = __builtin_amdgcn_readfirstlane(tid >> 6), lane = tid & 63, r32 = lane & 31, hi = lane >> 5;
    char* V_lds = lds; char* K_lds = lds + CMP_K_OFF; float* imp = (float*)(lds + CMP_IMP_OFF); float* li_l = (float*)(lds + CMP_WS_OFF) + wid * 64;
    const int t0 = tb * 64, tok = 8 * wid + (r32 & 7), pos = t0 + tok;
    const int nkeys = 4 * tb + 3 > 255 ? 255 : 4 * tb + 3, NT = (nkeys + 63) >> 6;
    const bool need_imp = tb >= 16;
    constexpr float C2 = 1.4426950408889634f * SCALE;
    const int cm = (pos - 31) >> 4;
    const int vb0 = (int)(uintptr_t)V_lds + v_rd_base(lane);
    float m_run = -1e30f, l_run = 0.f;
    f32x16 p0, p1;
#define CMP_PASS_A(T) if ((T) < NT) { SBAR(); qkt<T, MODE_WIN>(p0, p1, K_lds, nullptr, r32, hi, qr, 0.f); cmp_mask<T>(p0, p1, cm - 64 * (T) - 4 * hi);                      \
        float pmax = p0[0]; for (int r = 1; r < 16; ++r) pmax = fmaxf(pmax, p0[r]); for (int r = 0; r < 16; ++r) pmax = fmaxf(pmax, p1[r]);                                  \
        { auto rr = __builtin_amdgcn_permlane32_swap(__float_as_uint(pmax), __float_as_uint(pmax), false, false); pmax = fmaxf(__uint_as_float(rr[0]), __uint_as_float(rr[1])); } \
        const float mn = fmaxf(m_run, pmax), so = __builtin_amdgcn_exp2f((m_run - mn) * C2), mnL = -mn * C2; float ps = 0.f;                                                 \
        for (int r = 0; r < 16; ++r) ps += __builtin_amdgcn_exp2f(fmaf(p0[r], C2, mnL)) + __builtin_amdgcn_exp2f(fmaf(p1[r], C2, mnL));                                     \
        l_run = l_run * so + ps; m_run = mn; }
    CMP_PASS_A(0) CMP_PASS_A(1) CMP_PASS_A(2) CMP_PASS_A(3)
#undef CMP_PASS_A
    { auto rr = __builtin_amdgcn_permlane32_swap(__float_as_uint(l_run), __float_as_uint(l_run), false, false); l_run = __uint_as_float(rr[0]) + __uint_as_float(rr[1]); }
    const float inv_l = l_run > 0.f ? 1.0f / l_run : 0.f;
    const float mL = -m_run * C2;
    f32x16 o[4] = {}; float carry = 0.f; bf16x8 pa0, pa1, pa2, pa3;
#define CMP_IMP(P_, T, ph) do { float G_[4], x_[4];                                                                                            \
        for (int i = 0; i < 4; ++i) { G_[i] = (P_[4 * i] + P_[4 * i + 1]) + (P_[4 * i + 2] + P_[4 * i + 3]); x_[i] = __shfl_xor(P_[4 * i + 3], 32); }  \
        for (int i = 0; i < 4; ++i) { const float ex = hi ? x_[i] : (i ? x_[i > 0 ? i - 1 : 0] : carry); float v = (G_[i] + ex) * inv_l;     \
            v += __shfl_xor(v, 8); v += __shfl_xor(v, 16);                                                                                     \
            if (r32 < 8) imp[(8 * wid + r32) * 65 + 16 * (T) + 8 * (ph) + 2 * i + hi] = v; }                                                  \
        carry = x_[3]; } while (0)
#define CMP_PASS_B(T) if ((T) < NT) { SBAR(); qkt<T, MODE_WIN>(p0, p1, K_lds, nullptr, r32, hi, qr, 0.f); cmp_mask<T>(p0, p1, cm - 64 * (T) - 4 * hi);   \
        for (int r = 0; r < 16; ++r) { p0[r] = __builtin_amdgcn_exp2f(fmaf(p0[r], C2, mL)); p1[r] = __builtin_amdgcn_exp2f(fmaf(p1[r], C2, mL)); }        \
        if (need_imp) { CMP_IMP(p0, T, 0); CMP_IMP(p1, T, 1); }                                                                                         \
        ATT_PK4(p0, 0, pa0); ATT_PK4(p0, 8, pa1); ATT_PK4(p1, 0, pa2); ATT_PK4(p1, 8, pa3); SBAR();                                                     \
        pv_tile<T>(o, vb0, pa0, pa1, pa2, pa3); }
    CMP_PASS_B(0) CMP_PASS_B(1) CMP_PASS_B(2) CMP_PASS_B(3)
#undef CMP_PASS_B
#undef CMP_IMP
    if (hi == 0) li_l[r32] = gate * inv_l; asm volatile("s_waitcnt lgkmcnt(0)" ::: "memory");
    float rli[16];
#pragma unroll
    for (int r = 0; r < 16; ++r) rli[r] = li_l[crow(r, hi)];
#pragma unroll
    for (int r = 0; r < 16; ++r) { const int rho = crow(r, hi); bf16* orow = P.O + ((size_t)b * SEQ + t0 + 8 * wid + (rho & 7)) * DM + (4 * g + (rho >> 3)) * HD;
#pragma unroll
        for (int d0 = 0; d0 < 4; ++d0) { const float v = o[d0][r] * rli[r]; const float vn = __shfl_xor(v, 1);
            if ((r32 & 1) == 0) *(unsigned*)(orow + d0 * 32 + r32) = cvtpk(v, vn); } }
    asm volatile("s_waitcnt lgkmcnt(0)" ::: "memory");
    const int jq = tb;
#pragma unroll 1
    for (int k = 0; k < 8; k += 2) {
        unsigned long long mask0, mask1;
        if (!need_imp) { mask0 = (1ull << (jq + 1)) - 1ull; mask1 = mask0; }
        else {
            const int n = lane; unsigned key0 = 0u, key1 = 0u;
            if (n <= jq) { const float bonus = (n == 0 || n == jq || n == jq - 1) ? 1000.0f : 0.0f;
                key0 = __float_as_uint(imp[(8 * wid + k) * 65 + n] + bonus) + 1u; key1 = __float_as_uint(imp[(8 * wid + k + 1) * 65 + n] + bonus) + 1u; }
            unsigned T0 = 0u, T1 = 0u;
#pragma unroll 1
            for (int bit = 31; bit >= 0; --bit) { const unsigned c0 = T0 | (1u << bit), c1 = T1 | (1u << bit);
                const unsigned long long b0 = __ballot(key0 >= c0), b1 = __ballot(key1 >= c1);
                if (__popcll(b0) >= 16) T0 = c0; if (__popcll(b1) >= 16) T1 = c1; }
            const unsigned long long lt = (1ull << lane) - 1ull;
            { const unsigned long long gt = __ballot(key0 > T0), eq = __ballot(key0 == T0); const int need = 16 - __popcll(gt); mask0 = __ballot(key0 > T0 || (key0 == T0 && __popcll(eq & lt) < need)); }
            { const unsigned long long gt = __ballot(key1 > T1), eq = __ballot(key1 == T1); const int need = 16 - __popcll(gt); mask1 = __ballot(key1 > T1 || (key1 == T1 && __popcll(eq & lt) < need)); }
        }
        if (lane == 0) { unsigned long long* sp = P.selm + ((size_t)b * NG + g) * SEQ + t0 + 8 * wid + k; sp[0] = mask0; sp[1] = mask1; }
    }
}
__device__ __forceinline__ void cmp_phase(char* lds, const CmpPtrs& P, int G, int c) {
    const int tid = threadIdx.x, wid = __builtin_amdgcn_readfirstlane(tid >> 6), lane = tid & 63, r32 = lane & 31, hi = lane >> 5;
#pragma unroll 1
    for (int L = c; L < NB * NG * 8; L += G) {
        const int b = L & 7, k = L >> 3, g = k & 3, j = (k >> 2) & 7;
        cmp_stage(lds, P, b, g, 4);
        bf16x8 qa[8], qb[8]; float ga, gb;
        cmp_load_q(P, b, g, j, wid, r32, hi, qa, ga);
        __syncthreads();
#define CMP_TB(u) (16 * ((u) >> 1) + (((u) & 1) ? 15 - j : j))
#pragma unroll 1
        for (int u = 0; u < 8; ++u) {
            if (u + 1 < 8) cmp_load_q(P, b, g, CMP_TB(u + 1), wid, r32, hi, qb, gb);
            cmp_unit(lds, P, b, g, CMP_TB(u), qa, ga);
#pragma unroll
            for (int d0 = 0; d0 < 8; ++d0) qa[d0] = qb[d0];
            ga = gb;
        }
#undef CMP_TB
        __syncthreads();
    }
}
}

constexpr size_t MiB = 1u << 20;
constexpr size_t WS_CTL = 0, CTL_ZERO_BYTES = 1 * MiB;
constexpr size_t WS_COS = 1 * MiB, WS_SIN = WS_COS + 256 * 1024;
constexpr size_t WS_PT = WS_SIN + 256 * 1024;
constexpr size_t WS_W2C = WS_PT + 64 * 1024;
constexpr size_t WS_RS = 3 * MiB;
constexpr size_t WS_RTE = 2 * MiB, WS_RTW = WS_RTE + 128 * 1024, WS_SLOT = WS_RTW + 256 * 1024;
constexpr size_t WS_WNSA = 4 * MiB, WS_WCMP1 = 25 * MiB, WS_WNO = 29 * MiB, WS_WFGU = 37 * MiB, WS_WFD = 81 * MiB, WS_WFOX = 103 * MiB, WS_WFO = 128 * MiB, WS_WMGU = 136 * MiB, WS_WMD = 360 * MiB;
constexpr size_t WS_HN = 472 * MiB, WS_HN8 = 472 * MiB;
constexpr size_t WS_Q = 600 * MiB, WS_KV = 728 * MiB, WS_GATES = 920 * MiB, WS_UV = 926 * MiB, WS_CK = 958 * MiB, WS_CV = 960 * MiB, WS_SELM = 962 * MiB;
constexpr size_t WS_O = 1096 * MiB, WS_MIX = 1224 * MiB;
constexpr size_t WS_ACT = 600 * MiB;
constexpr size_t WS_FQKV = 600 * MiB, WS_FL = 984 * MiB, WS_CS = 986 * MiB, WS_TOT = 988 * MiB;
constexpr size_t WS_XG = 600 * MiB, WS_H = 732 * MiB, WS_Y = 1194 * MiB, WS_XR = 1458 * MiB, WS_END = 1586 * MiB;
constexpr int MOE_MAX_TILES = 264, MOE_NCHUNK = 1;
constexpr float XG_SCALE = 16.f, H_SCALE = 8.f, W8_SCALE = 256.f;
constexpr int CW_BAR = 4096;
constexpr int CW_CNT = 64, CW_CWG = 1024;

constexpr int LDS_BYTES = 155648;
constexpr int LDSCTL_OFF = LDS_BYTES - 256;
constexpr int NWAVES = 8;

template <int CTRL, int ROWMASK> __device__ __forceinline__ float dpp_add(float v) {
    return v + __int_as_float(__builtin_amdgcn_update_dpp(0, __float_as_int(v), CTRL, ROWMASK, 0xF, false)); }
__device__ __forceinline__ float wave_sum(float v) {
    v = dpp_add<0xB1, 0xF>(v);
    v = dpp_add<0x4E, 0xF>(v);
    v = dpp_add<0x141, 0xF>(v);
    v = dpp_add<0x140, 0xF>(v);
    v = dpp_add<0x142, 0xA>(v);
    v = dpp_add<0x143, 0xC>(v);
    return __int_as_float(__builtin_amdgcn_readlane(__float_as_int(v), 63));
}
__device__ __forceinline__ float bfu_lo(unsigned w) { return __uint_as_float(w << 16); }
__device__ __forceinline__ float bfu_hi(unsigned w) { return __uint_as_float(w & 0xffff0000u); }
__device__ __forceinline__ void tr_item(const float* W, size_t ldw, int K, bf16* WT, size_t dst_row0, int k0, int n0, LAS float* scr, int lane, const float* gain = nullptr) {
    const int cq = lane & 15, rq = lane >> 4;
    f32x4 tv[16];
#pragma unroll
    for (int i = 0; i < 16; ++i) tv[i] = __builtin_nontemporal_load((const GAS f32x4*)(W + (size_t)(k0 + 4 * i + rq) * ldw + n0 + 4 * cq));
#pragma unroll
    for (int i = 0; i < 16; ++i) { const int kk = 4 * i + rq; f32x4 v = tv[i]; if (gain) v *= gain[k0 + kk];
        LAS float* s = scr + kk * 65 + 4 * cq; s[0] = v.x; s[1] = v.y; s[2] = v.z; s[3] = v.w; }
    LDS_WAIT(); asm volatile("" ::: "memory");
    const int c = lane & 7;
#pragma unroll
    for (int j = 0; j < 8; ++j) { const int n = (lane >> 3) + 8 * j; const LAS float* s = scr + (8 * c) * 65 + n;
        v4u o; o.x = pk2(s[0], s[65]); o.y = pk2(s[130], s[195]); o.z = pk2(s[260], s[325]); o.w = pk2(s[390], s[455]);
        *(GAS v4u*)(WT + (dst_row0 + n) * (size_t)K + k0 + 8 * c) = o; }
    LDS_WAIT(); asm volatile("" ::: "memory");
}
__device__ __forceinline__ void tr_item_f8(const float* W, size_t ldw, int K, unsigned char* WT, size_t dst_row0, int k0, int n0, LAS float* scr, int lane) {
    const int cq = lane & 7, rq = lane >> 3;
    f32x4 tv[16];
#pragma unroll
    for (int i = 0; i < 16; ++i) tv[i] = __builtin_nontemporal_load((const GAS f32x4*)(W + (size_t)(k0 + 8 * i + rq) * ldw + n0 + 4 * cq));
#pragma unroll
    for (int i = 0; i < 16; ++i) { const int kk = 8 * i + rq; const f32x4 v = tv[i];
        LAS float* s = scr + kk * 33 + 4 * cq; s[0] = v.x * W8_SCALE; s[1] = v.y * W8_SCALE; s[2] = v.z * W8_SCALE; s[3] = v.w * W8_SCALE; }
    LDS_WAIT(); asm volatile("" ::: "memory");
    const int c = lane & 7;
#pragma unroll
    for (int j = 0; j < 4; ++j) { const int n = (lane >> 3) + 8 * j; const LAS float* s = scr + (16 * c) * 33 + n;
        v4u o; o.x = pg8::pk4_fp8(s[0], s[33], s[66], s[99]); o.y = pg8::pk4_fp8(s[132], s[165], s[198], s[231]); o.z = pg8::pk4_fp8(s[264], s[297], s[330], s[363]); o.w = pg8::pk4_fp8(s[396], s[429], s[462], s[495]);
        *(GAS v4u*)(WT + (dst_row0 + n) * (size_t)K + k0 + 16 * c) = o; }
    LDS_WAIT(); asm volatile("" ::: "memory");
}
struct TrJob { const float* W; size_t ldw; int K, N; bf16* WT; int grp, gstride, roff; int f8; const float* gain; };
__device__ __forceinline__ int tr_items(const TrJob& j) { return (j.K / 64) * (j.N / 64); }
__device__ __forceinline__ void tr_run(const TrJob& j, int it, LAS float* scr, int lane) {
    if (j.f8) { const int nb = j.N / 32, kb = it / nb, n0 = (it % nb) * 32; const size_t r0 = (size_t)(n0 / j.grp) * j.gstride + (n0 % j.grp) + j.roff;
        tr_item_f8(j.W, j.ldw, j.K, (unsigned char*)j.WT, r0, kb * 128, n0, scr, lane); return; }
    const int nb = j.N / 64, kb = it / nb, n0 = (it % nb) * 64;
    const size_t r0 = (size_t)(n0 / j.grp) * j.gstride + (n0 % j.grp) + j.roff;
    tr_item(j.W, j.ldw, j.K, j.WT, r0, kb * 64, n0, scr, lane, j.gain);
}
__device__ __forceinline__ float gelu_tanh(float x) {
    const float u = 0.7978845608028654f * (x + 0.044715f * x * x * x);
    const float e = __builtin_amdgcn_exp2f(-2.0f * 1.4426950408889634f * u);
    const float th = (1.0f - e) * __builtin_amdgcn_rcpf(1.0f + e);
    return 0.5f * x * (1.0f + th);
}

enum Phase { PH_PRO = 0, PH_NSA_IN, PH_CMP1, PH_CMP2, PH_ATT_CMP, PH_ATT_SLC, PH_ATT_WIN, PH_NSA_OUT, PH_NORM_A, PH_FFN_GU, PH_FFN_DN, PH_NORM_B, PH_FOX_IN, PH_FOX_SCAN, PH_FOX_ATT, PH_FOX_OUT,
             PH_NORM_C, PH_MOE_DISP, PH_MOE0, PH_FINAL = PH_MOE0 + 2 * MOE_NCHUNK, PH_COUNT };
struct Args { const float* in[20]; float* out; unsigned char* ws; int ph_lo, ph_hi; };

typedef unsigned u32x2 __attribute__((ext_vector_type(2)));
struct Row8 { f32x4 v[8]; };
__device__ __forceinline__ Row8 ld_row_f32(const float* p, int lane) { Row8 r; const GAS f32x4* q = (const GAS f32x4*)p + lane;
#pragma unroll
    for (int j = 0; j < 8; ++j) r.v[j] = q[64 * j]; return r; }
__device__ __forceinline__ Row8 ld_row_bf16(const bf16* p, int lane) { Row8 r; const GAS u32x2* q = (const GAS u32x2*)p + lane;
#pragma unroll
    for (int j = 0; j < 8; ++j) { const u32x2 w = q[64 * j]; r.v[j] = (f32x4){bfu_lo(w.x), bfu_hi(w.x), bfu_lo(w.y), bfu_hi(w.y)}; } return r; }
__device__ __forceinline__ void st_row_f32(float* p, int lane, const Row8& r) { GAS f32x4* q = (GAS f32x4*)p + lane;
#pragma unroll
    for (int j = 0; j < 8; ++j) q[64 * j] = r.v[j]; }
__device__ __forceinline__ void st_row_bf16(bf16* p, int lane, const Row8& r) { GAS u32x2* q = (GAS u32x2*)p + lane;
#pragma unroll
    for (int j = 0; j < 8; ++j) { u32x2 w; w.x = pk2(r.v[j].x, r.v[j].y); w.y = pk2(r.v[j].z, r.v[j].w); q[64 * j] = w; } }
__device__ __forceinline__ Row8 ld_row_f32_nt(const float* p, int lane) { Row8 r; const GAS f32x4* q = (const GAS f32x4*)p + lane;
#pragma unroll
    for (int j = 0; j < 8; ++j) r.v[j] = __builtin_nontemporal_load(q + 64 * j); return r; }
__device__ __forceinline__ Row8 ld_row_bf16_nt(const bf16* p, int lane) { Row8 r; const GAS u32x2* q = (const GAS u32x2*)p + lane;
#pragma unroll
    for (int j = 0; j < 8; ++j) { const u32x2 w = __builtin_nontemporal_load(q + 64 * j); r.v[j] = (f32x4){bfu_lo(w.x), bfu_hi(w.x), bfu_lo(w.y), bfu_hi(w.y)}; } return r; }
__device__ __forceinline__ void st_row_f32_nt(float* p, int lane, const Row8& r) { GAS f32x4* q = (GAS f32x4*)p + lane;
#pragma unroll
    for (int j = 0; j < 8; ++j) __builtin_nontemporal_store(r.v[j], q + 64 * j); }
__device__ __forceinline__ void st_row_bf16_nt(bf16* p, int lane, const Row8& r) { GAS u32x2* q = (GAS u32x2*)p + lane;
#pragma unroll
    for (int j = 0; j < 8; ++j) { u32x2 w; w.x = pk2(r.v[j].x, r.v[j].y); w.y = pk2(r.v[j].z, r.v[j].w); __builtin_nontemporal_store(w, q + 64 * j); } }
__device__ __forceinline__ float row_rs(const Row8& r) { float s = 0.f;
#pragma unroll
    for (int j = 0; j < 8; ++j) s += (r.v[j].x * r.v[j].x + r.v[j].y * r.v[j].y) + (r.v[j].z * r.v[j].z + r.v[j].w * r.v[j].w);
    return 1.0f / sqrtf(wave_sum(s) * (1.0f / DM) + RMS_EPS); }

__global__ void __launch_bounds__(NWAVES * 64, 2) mk_fwd(Args args) {
    extern __shared__ __attribute__((aligned(1024))) unsigned char lds[];
    LAS unsigned char* ldsl = (LAS unsigned char*)lds;
    volatile LAS unsigned* LCTL = (volatile LAS unsigned*)(ldsl + LDSCTL_OFF);
    const int tid = threadIdx.x, lane = tid & 63, wave = __builtin_amdgcn_readfirstlane(tid >> 6);
    const int G = gridDim.x, bx = blockIdx.x;
    const int gw = bx * NWAVES + wave, NGW = G * NWAVES;
    unsigned char* ws = args.ws;
    gu32* ctl = (gu32*)(ws + WS_CTL);
    if (tid < 64) LCTL[tid] = 0u;
    __syncthreads();
    XcdBarrier bar; bar.bar = (unsigned*)ctl + CW_BAR; bar.x = 0; bar.st = nullptr;
    if (MK_N_LAUNCHES == 1) bar = xcd_barrier_post((unsigned*)ctl + CW_BAR, LCTL);
    const int lo = args.ph_lo, hi = args.ph_hi;
#ifdef MK_ONLY
#define IN(k) ((k) == MK_ONLY && lo <= (k) && (k) < hi)
#elif defined(MK_SKIP)
#define IN(k) ((k) != MK_SKIP && lo <= (k) && (k) < hi)
#else
#define IN(k) (lo <= (k) && (k) < hi)
#endif
#ifdef MK_PROBE_MASK
    unsigned long long pr_last = rt(), pr_acc = 0ull;
#define SEAM(k) do { if (IN(k) && IN((k) + 1)) xcd_barrier(bar); { const unsigned long long t_ = rt(); if ((MK_PROBE_MASK >> (k)) & 1ull) pr_acc += t_ - pr_last; pr_last = t_; } } while (0)
#else
#define SEAM(k) do { if (IN(k) && IN((k) + 1)) xcd_barrier(bar); } while (0)
#endif

    const float* x_in = args.in[0]; const float* ln_g = args.in[1];
    float* xout = args.out; bf16* XR = (bf16*)(ws + WS_XR);
    bf16* HN = (bf16*)(ws + WS_HN); bf16* OB = (bf16*)(ws + WS_O); bf16* MIX = (bf16*)(ws + WS_MIX);
    float* cosT = (float*)(ws + WS_COS); float* sinT = (float*)(ws + WS_SIN); float* PT = (float*)(ws + WS_PT); bf16* W2C = (bf16*)(ws + WS_W2C);
    unsigned* RTE = (unsigned*)(ws + WS_RTE); float2* RTW = (float2*)(ws + WS_RTW); int2* SLOT = (int2*)(ws + WS_SLOT);

    if (IN(PH_PRO)) {
        LAS float* scr = (LAS float*)(ldsl + wave * 16896);
        int it0 = gw;
#define RUN_JOB(job) do { const TrJob j_ = (job); const int n_ = tr_items(j_); for (; it0 < n_; it0 += NGW) tr_run(j_, it0, scr, lane); it0 -= n_; } while (0)
        RUN_JOB((TrJob{args.in[2], NSA_NV, DM, 5120, (bf16*)(ws + WS_WNSA), 1 << 30, 0, 0, 0}));
        RUN_JOB((TrJob{args.in[5], 256, DM, 256, (bf16*)(ws + WS_WCMP1), 1 << 30, 0, 0, 0}));
        RUN_JOB((TrJob{args.in[5] + (size_t)2048 * 256, 256, DM, 256, (bf16*)(ws + WS_WCMP1), 1 << 30, 0, 256, 0}));
        RUN_JOB((TrJob{args.in[7], 256, DM, 256, (bf16*)(ws + WS_WCMP1), 1 << 30, 0, 512, 0}));
        RUN_JOB((TrJob{args.in[7] + (size_t)2048 * 256, 256, DM, 256, (bf16*)(ws + WS_WCMP1), 1 << 30, 0, 768, 0}));
        RUN_JOB((TrJob{args.in[6], 128, 256, 128, W2C, 1 << 30, 0, 0, 0}));
        RUN_JOB((TrJob{args.in[8], 128, 256, 128, W2C + 128 * 256, 1 << 30, 0, 0, 0}));
        RUN_JOB((TrJob{args.in[9], DM, DM, DM, (bf16*)(ws + WS_WNO), 1 << 30, 0, 0, 0}));
        RUN_JOB((TrJob{args.in[13], FFD, DM, FFD, (bf16*)(ws + WS_WFGU), 128, 256, 0, 0, ln_g + 2 * DM}));
        RUN_JOB((TrJob{args.in[14], FFD, DM, FFD, (bf16*)(ws + WS_WFGU), 128, 256, 128, 0, ln_g + 2 * DM}));
        RUN_JOB((TrJob{args.in[15], DM, FFD, DM, (bf16*)(ws + WS_WFD), 1 << 30, 0, 0, 0}));
        RUN_JOB((TrJob{args.in[10], FOX_NV, DM, 6144, (bf16*)(ws + WS_WFOX), 1 << 30, 0, 0, 0, ln_g + 4 * DM}));
        RUN_JOB((TrJob{args.in[12], DM, DM, DM, (bf16*)(ws + WS_WFO), 1 << 30, 0, 0, 0}));
        for (int e = 0; e < NE; ++e) {
            RUN_JOB((TrJob{args.in[17] + (size_t)e * DM * FFE, FFE, DM, FFE, (bf16*)(ws + WS_WMGU + (size_t)e * 2 * FFE * DM), 128, 256, 0, 1}));
            RUN_JOB((TrJob{args.in[18] + (size_t)e * DM * FFE, FFE, DM, FFE, (bf16*)(ws + WS_WMGU + (size_t)e * 2 * FFE * DM), 128, 256, 128, 1}));
            RUN_JOB((TrJob{args.in[19] + (size_t)e * FFE * DM, DM, FFE, DM, (bf16*)(ws + WS_WMD + (size_t)e * DM * FFE), 1 << 30, 0, 0, 1}));
        }
#undef RUN_JOB
        const int gt = bx * (NWAVES * 64) + tid, NGT = G * NWAVES * 64;
        for (int i = gt; i < 48 * DM; i += NGT) { const int j = i / DM, k = i % DM; ((bf16*)(ws + WS_WNSA))[(size_t)(5120 + j) * DM + k] = (bf16)f2bf(args.in[2][(size_t)k * NSA_NV + 5120 + j]); }
        for (int i = gt; i < 16 * DM; i += NGT) { const int j = i / DM, k = i % DM; ((bf16*)(ws + WS_WFOX))[(size_t)(6144 + j) * DM + k] = (bf16)f2bf(args.in[10][(size_t)k * FOX_NV + 6144 + j] * ln_g[4 * DM + k]); }
        for (int i = gt; i < SEQ * 16; i += NGT) { const int pos = i >> 4, k = i & 15;
            const double inv = exp2(-(double)k * (18.931568569324174 / 16.0));
            double a = (double)pos * inv; a -= 6.283185307179586476925 * rint(a * 0.15915494309189533577);
            cosT[i] = cosf((float)a); sinT[i] = sinf((float)a); }
        for (int t = gw; t < 64; t += NGW) { const int kv = t >> 5, part = (t >> 2) & 7, hb = t & 3; const float* pos = args.in[kv ? 4 : 3]; const float* w1 = args.in[kv ? 7 : 5];
            float acc = 0.f; for (int k = part * 512; k < part * 512 + 512; ++k) acc = fmaf(pos[k], w1[(size_t)k * 256 + hb * 64 + lane], acc);
            PT[(kv * 8 + part) * 256 + hb * 64 + lane] = acc; }
        { const Row8 g0 = ld_row_f32(ln_g, lane);
          int m = gw; Row8 r; if (m < MTOK) r = ld_row_f32_nt(x_in + (size_t)m * DM, lane);
          for (; m < MTOK; m += NGW) { const int m2 = m + NGW; Row8 rn = r; if (m2 < MTOK) rn = ld_row_f32_nt(x_in + (size_t)m2 * DM, lane);
              const float rs = row_rs(r);
#pragma unroll
              for (int j = 0; j < 8; ++j) r.v[j] = r.v[j] * rs * g0.v[j];
              st_row_bf16(HN + (size_t)m * DM, lane, r); r = rn; } }
    }
    SEAM(PH_PRO);

    if (IN(PH_NSA_IN)) {
        pg8::Gemm g{(const pg8::bf16_t*)HN, (const pg8::bf16_t*)(ws + WS_WNSA), MTOK, 5120, DM}; pg8::StaticOrder S; S.init(MTOK, 5120, G, bx);
        pg8::EpiNsaIn E{(pg8::bf16_t*)(ws + WS_Q), (pg8::bf16_t*)(ws + WS_KV), (float*)(ws + WS_GATES), cosT, sinT};
        pg8::gemm_phase<pg8::EpiNsaIn, pg8::StaticOrder, true, true>(ldsl, g, S, E);
    }
    SEAM(PH_NSA_IN);

    if (IN(PH_CMP1)) {
        static_assert(WS_KV % MiB == 0 && WS_WCMP1 % MiB == 0 && WS_HN % MiB == 0 && WS_WNSA % MiB == 0, "absolute 1 MiB tile indices");
        pg8::Gemm g{(const pg8::bf16_t*)ws, (const pg8::bf16_t*)ws, 0, 0, DM};
        pg8::CmpGateOrder S{G, bx, (int)(WS_KV / MiB), (int)(WS_WCMP1 / MiB), (int)(WS_HN / MiB), (int)(WS_WNSA / MiB) + 20};
        pg8::EpiCmpGates E{(float*)(ws + WS_UV), 512, (float*)(ws + WS_GATES)};
        pg8::gemm_phase<pg8::EpiCmpGates, pg8::CmpGateOrder, false, true>(ldsl, g, S, E);
    }
    SEAM(PH_CMP1);

    if (IN(PH_CMP2)) {
        typedef float f32x4v __attribute__((ext_vector_type(4)));
        const float* UV = (const float*)(ws + WS_UV);
        for (int t = gw; t < 2 * NB * NG * 16; t += NGW) {
            const int kv = t >> 9, b = (t >> 6) & 7, g = (t >> 4) & 3, i0 = (t & 15) * 16;
            const int fr = lane & 15, fq = lane >> 4, i = i0 + fr;
            const bool valid = i < 255;
            const float* urow = UV + ((size_t)kv * 8192 + ((size_t)(b * 256 + i) * NG + g)) * 512;
            const float* vrow = UV + ((size_t)kv * 8192 + ((size_t)(b * 256 + (valid ? i + 1 : i)) * NG + g)) * 512 + 256;
            f32x4 acc[8];
#pragma unroll
            for (int n = 0; n < 8; ++n) acc[n] = (f32x4){0.f, 0.f, 0.f, 0.f};
            const bf16* w2 = W2C + (size_t)kv * 128 * 256;
#pragma unroll 2
            for (int ks = 0; ks < 8; ++ks) { const int h0 = 32 * ks + 8 * fq;
                float hv[8];
#pragma unroll
                for (int q = 0; q < 2; ++q) { const f32x4 a = *(const GAS f32x4*)(urow + h0 + 4 * q), c = *(const GAS f32x4*)(vrow + h0 + 4 * q);
                    f32x4 p = (f32x4){0.f, 0.f, 0.f, 0.f};
#pragma unroll
                    for (int pt = 0; pt < 8; ++pt) p += *(const GAS f32x4*)(PT + (kv * 8 + pt) * 256 + h0 + 4 * q);
#pragma unroll
                    for (int e = 0; e < 4; ++e) hv[4 * q + e] = gelu_tanh(a[e] + c[e] + p[e]); }
                v4u aw; aw.x = pk2(hv[0], hv[1]); aw.y = pk2(hv[2], hv[3]); aw.z = pk2(hv[4], hv[5]); aw.w = pk2(hv[6], hv[7]);
                const bf16x8 af = __builtin_bit_cast(bf16x8, aw);
#pragma unroll
                for (int n = 0; n < 8; ++n) { const bf16x8 bfr = *(const GAS bf16x8*)(w2 + (size_t)(16 * n + fr) * 256 + h0);
                    acc[n] = __builtin_amdgcn_mfma_f32_16x16x32_bf16(af, bfr, acc[n], 0, 0, 0); } }
            bf16* outp = (bf16*)(ws + (kv ? WS_CV : WS_CK));
#pragma unroll
            for (int n = 0; n < 8; ++n)
#pragma unroll
                for (int r = 0; r < 4; ++r) { const int ii = i0 + 4 * fq + r; outp[((size_t)(b * 256 + ii) * NG + g) * HD + 16 * n + fr] = (bf16)(ii < 255 ? f2bf(acc[n][r]) : 0u); }
        }
    }
    SEAM(PH_CMP2);

    if (IN(PH_ATT_CMP)) {
        att::CmpPtrs P{(const att::bf16*)(ws + WS_Q), (const att::bf16*)(ws + WS_CK), (const att::bf16*)(ws + WS_CV), (att::bf16*)OB, (const float*)(ws + WS_GATES), (unsigned long long*)(ws + WS_SELM)};
        att::cmp_phase((char*)lds, P, G, bx);
    }
    SEAM(PH_ATT_CMP);
    if (IN(PH_ATT_SLC)) {
        att::AttnPtrs P{(const att::bf16*)(ws + WS_Q), (const att::bf16*)(ws + WS_KV) + (size_t)2 * MTOK * 512, (const att::bf16*)(ws + WS_KV) + (size_t)3 * MTOK * 512, (att::bf16*)OB,
                        (const float*)(ws + WS_GATES), (const unsigned long long*)(ws + WS_SELM)};
        att::attn_phase<att::MODE_SLC, 512, true>((char*)lds, P, G, bx);
    }
    SEAM(PH_ATT_SLC);
    if (IN(PH_ATT_WIN)) {
        att::AttnPtrs P{(const att::bf16*)(ws + WS_Q), (const att::bf16*)(ws + WS_KV) + (size_t)4 * MTOK * 512, (const att::bf16*)(ws + WS_KV) + (size_t)5 * MTOK * 512, (att::bf16*)OB,
                        (const float*)(ws + WS_GATES), nullptr};
        att::attn_phase<att::MODE_WIN, 512, true>((char*)lds, P, G, bx);
    }
    SEAM(PH_ATT_WIN);

    if (IN(PH_NSA_OUT)) {
        pg8::Gemm g{(const pg8::bf16_t*)OB, (const pg8::bf16_t*)(ws + WS_WNO), MTOK, DM, DM}; pg8::StaticOrder S; S.init(MTOK, DM, G, bx);
        pg8::EpiBf16Plain E{(pg8::bf16_t*)MIX, DM};
        pg8::gemm_phase<pg8::EpiBf16Plain, pg8::StaticOrder, true, true>(ldsl, g, S, E);
    }
    SEAM(PH_NSA_OUT);

#define NORM_AB(LDX, gpost) do { const Row8 ga = ld_row_f32(gpost, lane); float* RS = (float*)(ws + WS_RS);                        \
        int m = gw; Row8 y, xr; if (m < MTOK) { y = ld_row_bf16_nt(MIX + (size_t)m * DM, lane); xr = LDX(m); }                    \
        for (; m < MTOK; m += NGW) { const int m2 = m + NGW; Row8 yn = y, xn = xr;                                               \
            if (m2 < MTOK) { yn = ld_row_bf16_nt(MIX + (size_t)m2 * DM, lane); xn = LDX(m2); }                                   \
            const float rs = row_rs(y);                                                                                           \
            _Pragma("unroll") for (int j = 0; j < 8; ++j) xr.v[j] = xr.v[j] + y.v[j] * rs * ga.v[j];                              \
            st_row_bf16(XR + (size_t)m * DM, lane, xr); const float rs2 = row_rs(xr);                                             \
            if (lane == 0) RS[m] = rs2; y = yn; xr = xn; } } while (0)
#define LDX_A(mm) ld_row_f32_nt(x_in + (size_t)(mm) * DM, lane)
#define LDX_B(mm) ld_row_bf16_nt(XR + (size_t)(mm) * DM, lane)
    if (IN(PH_NORM_A)) NORM_AB(LDX_A, ln_g + 1 * DM);
    SEAM(PH_NORM_A);

    if (IN(PH_FFN_GU)) {
        pg8::Gemm g{(const pg8::bf16_t*)XR, (const pg8::bf16_t*)(ws + WS_WFGU), MTOK, 2 * FFD, DM}; pg8::StaticOrder S; S.init(MTOK, 2 * FFD, G, bx);
        pg8::EpiSwiGLU E{(pg8::bf16_t*)(ws + WS_ACT), FFD, (const float*)(ws + WS_RS)};
        pg8::gemm_phase<pg8::EpiSwiGLU, pg8::StaticOrder, true, true>(ldsl, g, S, E);
    }
    SEAM(PH_FFN_GU);
    if (IN(PH_FFN_DN)) {
        pg8::Gemm g{(const pg8::bf16_t*)(ws + WS_ACT), (const pg8::bf16_t*)(ws + WS_WFD), MTOK, DM, FFD}; pg8::StaticOrder S; S.init(MTOK, DM, G, bx);
        pg8::EpiBf16Plain E{(pg8::bf16_t*)MIX, DM};
        pg8::gemm_phase<pg8::EpiBf16Plain, pg8::StaticOrder, true, true>(ldsl, g, S, E);
    }
    SEAM(PH_FFN_DN);
    if (IN(PH_NORM_B)) NORM_AB(LDX_B, ln_g + 3 * DM);
    SEAM(PH_NORM_B);

    if (IN(PH_FOX_IN)) {
        pg8::Gemm g{(const pg8::bf16_t*)XR, (const pg8::bf16_t*)(ws + WS_WFOX), MTOK, FOX_N, DM}; pg8::StaticOrder S; S.init(MTOK, FOX_N, G, bx);
        pg8::EpiFoxIn E{(pg8::bf16_t*)(ws + WS_FQKV), (float*)(ws + WS_FL), (float*)(ws + WS_TOT), args.in[11], (const float*)(ws + WS_RS)};
        pg8::gemm_phase<pg8::EpiFoxIn, pg8::StaticOrder, true, true>(ldsl, g, S, E);
    }
    SEAM(PH_FOX_IN);
    if (IN(PH_FOX_SCAN)) {
        const float* FL = (const float*)(ws + WS_FL); const float* TOT = (const float*)(ws + WS_TOT); float* CS = (float*)(ws + WS_CS);
        for (int t = gw; t < NB * 64; t += NGW) { const int b = t >> 6, c = t & 63;
            const GAS f32x4* src = (const GAS f32x4*)(FL + ((size_t)b * SEQ + c * 64 + lane) * 16); const GAS f32x4* tp = (const GAS f32x4*)(TOT + ((size_t)b * 64 + lane) * 16);
            f32x4 ls[4], tt[4];
#pragma unroll
            for (int q = 0; q < 4; ++q) { ls[q] = src[q]; tt[q] = tp[q]; }
#pragma unroll
            for (int q = 0; q < 4; ++q)
#pragma unroll
                for (int j = 0; j < 4; ++j) { const int h = 4 * q + j; const float pre = wave_sum(lane < c ? tt[q][j] : 0.f); float v = ls[q][j];
#pragma unroll
                    for (int o = 1; o < 64; o <<= 1) { const float n = __shfl_up(v, o); if (lane >= o) v += n; }
                    CS[((size_t)b * NH + h) * SEQ + c * 64 + lane] = (v + pre) * 11.313708498984761f; }
        }
    }
    SEAM(PH_FOX_SCAN);
    if (IN(PH_FOX_ATT)) {
        att::AttnPtrs P{(const att::bf16*)(ws + WS_FQKV), (const att::bf16*)(ws + WS_FQKV) + (size_t)MTOK * DM, (const att::bf16*)(ws + WS_FQKV) + (size_t)2 * MTOK * DM, (att::bf16*)OB,
                        (const float*)(ws + WS_CS), nullptr};
        att::attn_phase<att::MODE_FOX, DM, false>((char*)lds, P, G, bx);
    }
    SEAM(PH_FOX_ATT);
    if (IN(PH_FOX_OUT)) {
        pg8::Gemm g{(const pg8::bf16_t*)OB, (const pg8::bf16_t*)(ws + WS_WFO), MTOK, DM, DM}; pg8::StaticOrder S; S.init(MTOK, DM, G, bx);
        pg8::EpiBf16Plain E{(pg8::bf16_t*)MIX, DM};
        pg8::gemm_phase<pg8::EpiBf16Plain, pg8::StaticOrder, true, true>(ldsl, g, S, E);
    }
    SEAM(PH_FOX_OUT);

    if (IN(PH_NORM_C)) {
        LAS float* wrt = (LAS float*)ldsl;
        const float* wr = args.in[16];
        for (int i = tid; i < DM * NE; i += NWAVES * 64) wrt[(i & 7) * DM + (i >> 3)] = wr[i];
        __syncthreads();
        const Row8 ga = ld_row_f32(ln_g + 5 * DM, lane), gb = ld_row_f32(ln_g + 6 * DM, lane);
        int m = gw; Row8 y, xr; if (m < MTOK) { y = ld_row_bf16_nt(MIX + (size_t)m * DM, lane); xr = ld_row_bf16_nt(XR + (size_t)m * DM, lane); }
        for (; m < MTOK; m += NGW) { const int m2 = m + NGW; Row8 yn = y, xn = xr;
            if (m2 < MTOK) { yn = ld_row_bf16_nt(MIX + (size_t)m2 * DM, lane); xn = ld_row_bf16_nt(XR + (size_t)m2 * DM, lane); }
            const float rs = row_rs(y);
#pragma unroll
            for (int j = 0; j < 8; ++j) xr.v[j] = xr.v[j] + y.v[j] * rs * ga.v[j];
            st_row_bf16_nt(XR + (size_t)m * DM, lane, xr); const float rs2 = row_rs(xr);
#pragma unroll
            for (int j = 0; j < 8; ++j) xr.v[j] = xr.v[j] * rs2 * gb.v[j];
            { unsigned char* h8 = (unsigned char*)(ws + WS_HN8) + (size_t)m * DM + 4 * lane;
#pragma unroll
              for (int j = 0; j < 8; ++j) *(GAS unsigned*)(h8 + 256 * j) = pg8::pk4_fp8(xr.v[j].x * XG_SCALE, xr.v[j].y * XG_SCALE, xr.v[j].z * XG_SCALE, xr.v[j].w * XG_SCALE); }
            float lg[NE];
#pragma unroll
            for (int e = 0; e < NE; ++e) { float s = 0.f;
#pragma unroll
                for (int j = 0; j < 8; ++j) { const f32x4 w = *(const LAS f32x4*)(wrt + e * DM + 256 * j + 4 * lane); s += (xr.v[j].x * w.x + xr.v[j].y * w.y) + (xr.v[j].z * w.z + xr.v[j].w * w.w); }
                asm volatile("" : "+v"(s) :: "memory");
                lg[e] = wave_sum(s); }
            int e1 = 0; float v1 = lg[0];
#pragma unroll
            for (int e = 1; e < NE; ++e) if (lg[e] > v1) { v1 = lg[e]; e1 = e; }
            int e2 = -1; float v2 = -__builtin_inff();
#pragma unroll
            for (int e = 0; e < NE; ++e) if (e != e1 && lg[e] > v2) { v2 = lg[e]; e2 = e; }
            const float ex = expf(v2 - v1), w1 = 1.0f / (1.0f + ex), w2 = ex * w1;
            if (lane == 0) {
                const unsigned i1 = __hip_atomic_fetch_add((LAS unsigned*)(ldsl + LDSCTL_OFF) + 8 + e1, 1u, __ATOMIC_RELAXED, __HIP_MEMORY_SCOPE_WORKGROUP);
                const unsigned i2 = __hip_atomic_fetch_add((LAS unsigned*)(ldsl + LDSCTL_OFF) + 8 + e2, 1u, __ATOMIC_RELAXED, __HIP_MEMORY_SCOPE_WORKGROUP);
                RTE[m] = (unsigned)e1 | ((unsigned)e2 << 8) | (i1 << 16) | (i2 << 24); RTW[m] = make_float2(w1, w2); }
            y = yn; xr = xn;
        }
        __syncthreads();
        if (tid < NE) { const unsigned c = LCTL[8 + tid]; ctl[CW_CWG + bx * NE + tid] = c; if (c) __hip_atomic_fetch_add(ctl + CW_CNT + tid, c, RLX_AGENT); }
    }
    SEAM(PH_NORM_C);

    int tb[NE + 1];
#pragma unroll
    for (int e = 0; e <= NE; ++e) tb[e] = 0;
    if (hi > PH_NORM_C + 1) {
#pragma unroll
        for (int e = 0; e < NE; ++e) { const unsigned c = __builtin_amdgcn_readfirstlane(__hip_atomic_load(ctl + CW_CNT + e, RLX_AGENT)); tb[e + 1] = tb[e] + (int)((c + 255u) >> 8); }
    }
    const int ttot = tb[NE] < MOE_MAX_TILES ? tb[NE] : MOE_MAX_TILES;

    if (IN(PH_MOE_DISP)) {
        unsigned char* XG = ws + WS_XG; const unsigned char* HN8 = ws + WS_HN8;
        LAS unsigned* part = (LAS unsigned*)ldsl; LAS int* sbase = (LAS int*)(ldsl + 4096);
        { const int e = tid & 7, k = tid >> 3; unsigned s = 0; for (int j = k; j < bx; j += 64) s += ctl[CW_CWG + j * NE + e]; part[k * 8 + e] = s; }
        __syncthreads();
        if (tid < NE) { unsigned s = 0; for (int k = 0; k < 64; ++k) s += part[k * 8 + tid]; sbase[tid] = tb[tid] * 256 + (int)s; }
        __syncthreads();
        for (int i0 = 0; gw + NGW * i0 < MTOK; i0 += 8) {
            const int ml = gw + NGW * (i0 + (lane & 7)); int sa = 0, sb = 0;
            if (lane < 8 && ml < MTOK) { const unsigned re = RTE[ml]; sa = sbase[re & 0xff] + (int)((re >> 16) & 0xff); sb = sbase[(re >> 8) & 0xff] + (int)(re >> 24); SLOT[ml] = make_int2(sa, sb); }
            v4u v[8][2];
#pragma unroll
            for (int u = 0; u < 8; ++u) { const int m = gw + NGW * (i0 + u); if (m < MTOK) { const GAS v4u* src = (const GAS v4u*)(HN8 + (size_t)m * DM) + lane; v[u][0] = src[0]; v[u][1] = src[64]; } }
#pragma unroll
            for (int u = 0; u < 8; ++u) { const int m = gw + NGW * (i0 + u); const int ra = __builtin_amdgcn_readlane(sa, u), rb = __builtin_amdgcn_readlane(sb, u);
                if (m < MTOK) { GAS v4u* da = (GAS v4u*)(XG + (size_t)ra * DM) + lane; GAS v4u* db = (GAS v4u*)(XG + (size_t)rb * DM) + lane;
                    da[0] = v[u][0]; da[64] = v[u][1]; db[0] = v[u][0]; db[64] = v[u][1]; } }
        }
    }
    SEAM(PH_MOE_DISP);

    if (IN(PH_MOE0) && ttot > 0) {
        pg8::Gemm g{(const pg8::bf16_t*)(ws + WS_XG), (const pg8::bf16_t*)(ws + WS_WMGU), 0, 2 * FFE, DM};
        pg8::MoeOrder<false> S{0, ttot, 2 * FFE / 256, G, bx, tb[1], tb[2], tb[3], tb[4], tb[5], tb[6], tb[7]};
        pg8::EpiSwiGLU8 E{ws + WS_H, FFE, H_SCALE};
        pg8::gemm_phase<pg8::EpiSwiGLU8, pg8::MoeOrder<false>, true, true, true, 0x77777777, 0x7B7B7B7B>(ldsl, g, S, E);
    }
    SEAM(PH_MOE0);
    if (IN(PH_MOE0 + 1) && ttot > 0) {
        pg8::Gemm g{(const pg8::bf16_t*)(ws + WS_H), (const pg8::bf16_t*)(ws + WS_WMD), 0, DM, FFE};
        pg8::MoeOrder<true> S{0, ttot, DM / 256, G, bx, tb[1], tb[2], tb[3], tb[4], tb[5], tb[6], tb[7]};
        pg8::EpiBf16Plain E{(pg8::bf16_t*)(ws + WS_Y), DM};
        pg8::gemm_phase<pg8::EpiBf16Plain, pg8::MoeOrder<true>, true, true, true, 0x77777777, 0x7C7C7C7C>(ldsl, g, S, E);
    }
    SEAM(PH_MOE0 + 1);

    if (IN(PH_FINAL)) {
        const bf16* Y = (const bf16*)(ws + WS_Y); const Row8 ga = ld_row_f32(ln_g + 7 * DM, lane);
        int m = gw; int2 sl = make_int2(0, 0), sl2 = sl; float2 w = make_float2(0.f, 0.f), w2 = w; Row8 ya, yb, xr;
        if (m < MTOK) { sl = SLOT[m]; w = RTW[m]; ya = ld_row_bf16_nt(Y + (size_t)sl.x * DM, lane); yb = ld_row_bf16_nt(Y + (size_t)sl.y * DM, lane); xr = ld_row_bf16_nt(XR + (size_t)m * DM, lane); }
        if (m + NGW < MTOK) { sl2 = SLOT[m + NGW]; w2 = RTW[m + NGW]; }
        for (; m < MTOK; m += NGW) { const int m2 = m + NGW, m3 = m + 2 * NGW; Row8 yan = ya, ybn = yb, xn = xr; int2 sl3 = sl2; float2 w3 = w2;
            if (m2 < MTOK) { yan = ld_row_bf16_nt(Y + (size_t)sl2.x * DM, lane); ybn = ld_row_bf16_nt(Y + (size_t)sl2.y * DM, lane); xn = ld_row_bf16_nt(XR + (size_t)m2 * DM, lane); }
            if (m3 < MTOK) { sl3 = SLOT[m3]; w3 = RTW[m3]; }
            Row8 f;
#pragma unroll
            for (int j = 0; j < 8; ++j) f.v[j] = ya.v[j] * w.x + yb.v[j] * w.y;
            const float rs = row_rs(f);
#pragma unroll
            for (int j = 0; j < 8; ++j) xr.v[j] = xr.v[j] + f.v[j] * rs * ga.v[j];
            st_row_f32_nt(xout + (size_t)m * DM, lane, xr);
            ya = yan; yb = ybn; xr = xn; w = w2; sl2 = sl3; w2 = w3; }
    }
#ifdef MK_PROBE_MASK
    { const unsigned long long t_ = rt(); if ((MK_PROBE_MASK >> PH_FINAL) & 1ull) pr_acc += t_ - pr_last;
      if (bx == 0 && tid == 0) { const unsigned long long t0_ = rt(); while (rt() - t0_ < pr_acc) __builtin_amdgcn_s_sleep(8); } }
#endif
#undef IN
#undef SEAM
#undef NORM_AB
#undef LDX_A
#undef LDX_B
}

extern "C" void kernel_launch(void* const* d_in, const int* in_sizes, int n_in, void* d_out, int out_size, void* d_ws, size_t ws_size, hipStream_t stream) {
    static int grid = 0;
    if (grid == 0) {
        if (n_in != 20 || in_sizes[0] != MTOK * DM || out_size != MTOK * DM || ws_size < WS_END) { fprintf(stderr, "kernel_launch: unexpected shapes (n_in %d, ws %zu < %zu?)\n", n_in, ws_size, (size_t)WS_END); grid = -1; return; }
        int dev = 0, cus = 0, per_cu = 0;
        if (hipGetDevice(&dev) != hipSuccess || hipDeviceGetAttribute(&cus, hipDeviceAttributeMultiprocessorCount, dev) != hipSuccess) { grid = -1; return; }
        if (hipFuncSetAttribute((const void*)mk_fwd, hipFuncAttributeMaxDynamicSharedMemorySize, LDS_BYTES) != hipSuccess) { fprintf(stderr, "kernel_launch: hipFuncSetAttribute failed\n"); grid = -1; return; }
        if (hipOccupancyMaxActiveBlocksPerMultiprocessor(&per_cu, (const void*)mk_fwd, NWAVES * 64, LDS_BYTES) != hipSuccess || per_cu < 1) { fprintf(stderr, "kernel_launch: occupancy query says %d blocks per CU\n", per_cu); }
        (void)hipGetLastError();
        grid = cus;
    }
    if (grid < 0) return;
    (void)hipMemsetAsync((char*)d_ws + WS_CTL, 0, CTL_ZERO_BYTES, stream);
    Args a{};
    for (int i = 0; i < 20; ++i) a.in[i] = (const float*)d_in[i];
    a.out = (float*)d_out; a.ws = (unsigned char*)d_ws;
#if MK_N_LAUNCHES == 1
    a.ph_lo = 0; a.ph_hi = PH_COUNT;
    hipLaunchKernelGGL(mk_fwd, dim3(grid), dim3(NWAVES * 64), LDS_BYTES, stream, a);
#else
    for (int p = 0; p < PH_COUNT; ++p) { a.ph_lo = p; a.ph_hi = p + 1; hipLaunchKernelGGL(mk_fwd, dim3(grid), dim3(NWAVES * 64), LDS_BYTES, stream, a); }
#endif
}
```

```cpp
#include <hip/hip_runtime.h>
#include <cstdio>
#include <cstdint>

#ifndef MK_N_LAUNCHES
#define MK_N_LAUNCHES 1
#endif

constexpr int NB = 8, SEQ = 4096, DM = 2048, MTOK = NB * SEQ;
constexpr int NH = 16, HD = 128, NG = 4;
constexpr int NSA_NV = 5168, NSA_N = 5376;
constexpr int FOX_NV = 6160, FOX_N = 6400;
constexpr int FFD = 5632, NE = 8, FFE = 7168;
constexpr float RMS_EPS = 1e-6f;

#define GAS __attribute__((address_space(1)))
#define LAS __attribute__((address_space(3)))
typedef unsigned short bf16;
typedef unsigned v4u __attribute__((ext_vector_type(4)));
typedef float f32x4 __attribute__((ext_vector_type(4)));
typedef short bf16x8 __attribute__((ext_vector_type(8)));
typedef GAS unsigned gu32;
typedef GAS unsigned long long gu64;
#define RLX_AGENT __ATOMIC_RELAXED, __HIP_MEMORY_SCOPE_AGENT
#define LDS_WAIT() asm volatile("s_waitcnt lgkmcnt(0)" ::: "memory")
#define VM_WAIT() asm volatile("s_waitcnt vmcnt(0)" ::: "memory")
__device__ __forceinline__ unsigned long long rt() { return __builtin_amdgcn_s_memrealtime(); }
__device__ __forceinline__ float xlane1(float v) { return __int_as_float(__builtin_amdgcn_update_dpp(0, __float_as_int(v), 0xB1, 0xF, 0xF, false)); }
__device__ __forceinline__ float xlane8(float v) { return __int_as_float(__builtin_amdgcn_update_dpp(0, __float_as_int(v), 0x128, 0xF, 0xF, false)); }
__device__ __forceinline__ float xlane32(float v) { const unsigned u = __float_as_uint(v); auto rr = __builtin_amdgcn_permlane32_swap(u, u, false, false);
    return __uint_as_float((threadIdx.x & 32) ? rr[0] : rr[1]); }
__device__ __forceinline__ unsigned f2bf(float f) { unsigned u = __builtin_bit_cast(unsigned, f); return (u + 0x7fffu + ((u >> 16) & 1u)) >> 16; }
__device__ __forceinline__ unsigned pk2(float lo, float hi) { return f2bf(lo) | (f2bf(hi) << 16); }

#define XB_TMO      128
#define XB_XCNT(j)  (256  + 64 * (j))
#define XB_XSUB(j)  (1280 + 64 * (j))
#define XB_XGEN(j)  (2304 + 64 * (j))
#define XB_TOP      3328
#define XB_TOPGEN   3392
#define XCD_BAR_WORDS 3456
#define XB_SPIN_CAP (1u << 20)

__device__ __forceinline__ unsigned xb_ld(unsigned* p)              { return __hip_atomic_load(p, __ATOMIC_RELAXED, __HIP_MEMORY_SCOPE_AGENT); }
__device__ __forceinline__ unsigned xb_add(unsigned* p, unsigned v) { return __hip_atomic_fetch_add(p, v, __ATOMIC_RELAXED, __HIP_MEMORY_SCOPE_AGENT); }
__device__ __forceinline__ unsigned xb_xcc_id() { return (unsigned)__builtin_amdgcn_s_getreg((3 << 11) | 20) & 0xFu; }
#define XB_SPIN(cond, bar) do { unsigned _sp = 0; while (cond) { __builtin_amdgcn_s_sleep(1); \
    if ((++_sp & 255u) == 0u) { if (xb_ld(&(bar)[XB_TMO])) break; if (_sp > XB_SPIN_CAP) { atomicAdd(&(bar)[XB_TMO], 1u); break; } } } } while (0)

struct XcdBarrier {
    unsigned* bar; unsigned x;
    volatile LAS unsigned* st;
};

__device__ __forceinline__ XcdBarrier xcd_barrier_post(unsigned* bar, volatile LAS unsigned* st) {
    XcdBarrier b; b.bar = bar; b.x = xb_xcc_id(); b.st = st;
    if (threadIdx.x == 0) (void)xb_add(&bar[XB_XCNT(b.x)], 1u);
    return b;
}
__device__ __forceinline__ void xcd_barrier_complete(unsigned* bar, unsigned x, unsigned& nloc, unsigned& nx) {
    const unsigned G = gridDim.x * gridDim.y * gridDim.z;
    unsigned sum, cnt, mine, sp = 0u;
    for (;;) {
        sum = 0u; cnt = 0u; mine = 0u;
#pragma unroll
        for (unsigned j = 0; j < 16; ++j) { const unsigned c = xb_ld(&bar[XB_XCNT(j)]); sum += c; cnt += (c > 0u) ? 1u : 0u; mine = (j == x) ? c : mine; }
        if (sum == G) break;
        __builtin_amdgcn_s_sleep(1);
        if ((++sp & 255u) == 0u) { if (xb_ld(&bar[XB_TMO])) break; if (sp > XB_SPIN_CAP) { atomicAdd(&bar[XB_TMO], 1u); break; } }
    }
    nloc = mine > 0u ? mine : 1u; nx = cnt > 0u ? cnt : 1u;
}

__device__ __forceinline__ void xcd_barrier(const XcdBarrier& b) {
    asm volatile("s_waitcnt vmcnt(0)" ::: "memory");
    __syncthreads();
    if (threadIdx.x == 0) {
        unsigned* bar = b.bar;
        __builtin_amdgcn_s_waitcnt(0);
        unsigned nloc = b.st[0], nx = b.st[1];
        if (nloc == 0u) { xcd_barrier_complete(bar, b.x, nloc, nx); b.st[0] = nloc; b.st[1] = nx; }
        const unsigned old = xb_add(&bar[XB_XSUB(b.x)], 1u);
        const unsigned gen = old / nloc;
        if (old + 1u == (gen + 1u) * nloc) {
            __builtin_amdgcn_fence(__ATOMIC_RELEASE, "agent");
            asm volatile("s_waitcnt vmcnt(0)" ::: "memory");
            const unsigned og = xb_add(&bar[XB_TOP], 1u);
            const unsigned tg = og / nx;
            if (og + 1u == (tg + 1u) * nx) xb_add(&bar[XB_TOPGEN], 1u);
            else XB_SPIN(xb_ld(&bar[XB_TOPGEN]) == tg, bar);
            __builtin_amdgcn_fence(__ATOMIC_ACQUIRE, "agent");
            xb_add(&bar[XB_XGEN(b.x)], 1u);
            asm volatile("s_waitcnt vmcnt(0)" ::: "memory");
        } else {
            XB_SPIN(xb_ld(&bar[XB_XGEN(b.x)]) == gen, bar);
            __builtin_amdgcn_fence(__ATOMIC_ACQUIRE, "agent");
            asm volatile("s_waitcnt vmcnt(0)" ::: "memory");
        }
    }
    __syncthreads();
}


namespace pg8 {
#define PG8_LAS __attribute__((address_space(3)))
typedef unsigned short bf16_t;
typedef short bf16x8 __attribute__((ext_vector_type(8)));
typedef float f32x4 __attribute__((ext_vector_type(4)));
typedef unsigned u32x4 __attribute__((ext_vector_type(4)));
constexpr int BM = 256, BK = 64, HALF = 128, HTB = HALF * BK * 2  , STAGE_BYTES = 8 * HTB, NXCD = 8, WGM = 8;

__host__ __device__ __forceinline__ int lds_byte(int r, int c) { const int st = (r >> 4) * 2 + (c >> 5), rr = r & 15, cc = c & 31, ob = rr * 64 + cc * 2; return st * 1024 + (ob ^ (((ob >> 9) & 1) << 5)); }
__host__ __device__ __forceinline__ void stage_rc(int b, int& R, int& C) { const int st = b / 1024, sb = b % 1024, swz = sb ^ (((sb >> 9) & 1) << 5); R = (st >> 1) * 16 + swz / 64; C = (st & 1) * 32 + (swz % 64) / 2; }
__host__ __device__ __forceinline__ int perm32(int rho) { const int n = rho >> 4, i = rho & 15; return 8 * (i >> 2) + 4 * n + (i & 3); }

struct Unit { int pm, pn, pa, pb; };
struct Gemm { const bf16_t* A; const bf16_t* Bt; int M, N, K; };

struct StaticOrder {
    int nM, nN, nwg, G, c;
    __host__ __device__ void init(int M, int N, int G_, int c_) { nM = M / BM; nN = N / BM; nwg = nM * nN; G = G_; c = c_; }
    __host__ __device__ bool next(int i, Unit& u) const {
        const long L = (long)i * G + c; if (L >= nwg) return false;
        int wgid = (int)L; { const int q = nwg / NXCD, r = nwg % NXCD, xcd = wgid % NXCD, off = wgid / NXCD; wgid = (xcd < r ? xcd * (q + 1) : r * (q + 1) + (xcd - r) * q) + off; }
        const int nig = WGM * nN, gid = wgid / nig, fm = gid * WGM, gsz = (nM - fm) < WGM ? (nM - fm) : WGM;
        u.pm = fm + ((wgid % nig) % gsz); u.pn = (wgid % nig) / gsz; u.pa = u.pm; u.pb = u.pn; return true;
    }
    __device__ __forceinline__ void a_ready(const Unit&) const {}
    __device__ __forceinline__ void done(const Unit&) const {}
};

__device__ __forceinline__ unsigned cvt_pk_bf16(float lo, float hi) { unsigned r; asm volatile("v_cvt_pk_bf16_f32 %0, %1, %2" : "=v"(r) : "v"(lo), "v"(hi)); return r; }
typedef float f32x2 __attribute__((ext_vector_type(2)));
__device__ __forceinline__ u32x4 pack8_bf16(const f32x4 a, const f32x4 b) { u32x4 w; w.x = cvt_pk_bf16(a[0], a[1]); w.y = cvt_pk_bf16(a[2], a[3]); w.z = cvt_pk_bf16(b[0], b[1]); w.w = cvt_pk_bf16(b[2], b[3]); return w; }

struct EpiBf16Plain {
    static constexpr bool PERM = true, AFTER_DRAIN = false, ROWSCALE = false;
    bf16_t* O; int ldc;
    __device__ __forceinline__ void operator()(const f32x4 (&acc)[2][2][4][2], const Unit& u, int wr, int wc, int fr, int fq) const {
        const int row0 = u.pm * BM + wr * 64 + fr, col0 = u.pn * BM + wc * 32 + 8 * fq;
#pragma unroll
        for (int ai = 0; ai < 2; ++ai)
#pragma unroll
            for (int m = 0; m < 4; ++m) { bf16_t* rowp = O + (size_t)(row0 + ai * HALF + m * 16) * ldc + col0;
#pragma unroll
                for (int bj = 0; bj < 2; ++bj) *(u32x4*)(rowp + bj * HALF) = pack8_bf16(acc[ai][bj][m][0], acc[ai][bj][m][1]); }
    }
};
struct EpiF32Cmp {
    static constexpr bool PERM = false, AFTER_DRAIN = false, ROWSCALE = false;
    float* O; int ldc;
    __device__ __forceinline__ void operator()(const f32x4 (&acc)[2][2][4][2], const Unit& u, int wr, int wc, int fr, int fq) const {
        const int row0 = u.pm * BM + wr * 64 + fr, col0 = (u.pn & 1) * BM + wc * 32 + 4 * fq;
#pragma unroll
        for (int ai = 0; ai < 2; ++ai)
#pragma unroll
            for (int m = 0; m < 4; ++m) { float* rowp = O + (size_t)(row0 + ai * HALF + m * 16) * ldc + col0;
#pragma unroll
                for (int bj = 0; bj < 2; ++bj)
#pragma unroll
                    for (int n = 0; n < 2; ++n) *(f32x4*)(rowp + bj * HALF + n * 16) = acc[ai][bj][m][n]; }
    }
};
struct EpiSwiGLU {
    static constexpr bool PERM = true, AFTER_DRAIN = false, ROWSCALE = true;
    bf16_t* O; int ldc; const float* rs;
    __device__ __forceinline__ void operator()(const f32x4 (&acc)[2][2][4][2], const Unit& u, int wr, int wc, int fr, int fq) const {
        const int row0 = u.pm * BM + wr * 64 + fr, col0 = u.pn * HALF + wc * 32 + 8 * fq;
#pragma unroll
        for (int ai = 0; ai < 2; ++ai)
#pragma unroll
            for (int m = 0; m < 4; ++m) { f32x4 h[2];
#pragma unroll
                for (int n = 0; n < 2; ++n) { const f32x4 g = acc[ai][0][m][n], up = acc[ai][1][m][n];
#pragma unroll
                    for (int j = 0; j < 4; j += 2) {
                        const f32x2 gg = {g[j], g[j + 1]}, uu = {up[j], up[j + 1]}; const f32x2 t = gg * -1.4426950408889634f;
                        f32x2 d = {__builtin_amdgcn_exp2f(t.x), __builtin_amdgcn_exp2f(t.y)}; d = d + 1.0f;
                        const f32x2 r = {__builtin_amdgcn_rcpf(d.x), __builtin_amdgcn_rcpf(d.y)}; const f32x2 hh = (gg * uu) * r;
                        h[n][j] = hh.x; h[n][j + 1] = hh.y; } }
                *(u32x4*)(O + (size_t)(row0 + ai * HALF + m * 16) * ldc + col0) = pack8_bf16(h[0], h[1]); }
    }
};
__device__ __forceinline__ unsigned pk4_fp8(float a, float b, float c, float d) {
    a = __builtin_amdgcn_fmed3f(a, -448.f, 448.f); b = __builtin_amdgcn_fmed3f(b, -448.f, 448.f); c = __builtin_amdgcn_fmed3f(c, -448.f, 448.f); d = __builtin_amdgcn_fmed3f(d, -448.f, 448.f);
    int w = 0; w = __builtin_amdgcn_cvt_pk_fp8_f32(a, b, w, false); w = __builtin_amdgcn_cvt_pk_fp8_f32(c, d, w, true); return (unsigned)w; }
struct EpiSwiGLU8 {
    static constexpr bool PERM = true, AFTER_DRAIN = false, ROWSCALE = false;
    unsigned char* O; int ldc; float oscale;
    __device__ __forceinline__ void operator()(const f32x4 (&acc)[2][2][4][2], const Unit& u, int wr, int wc, int fr, int fq) const {
        typedef unsigned u32x2 __attribute__((ext_vector_type(2)));
        const int row0 = u.pm * BM + wr * 64 + fr, col0 = u.pn * HALF + wc * 32 + 8 * fq; const float ic = 1.0f / oscale;
#pragma unroll
        for (int ai = 0; ai < 2; ++ai)
#pragma unroll
            for (int m = 0; m < 4; ++m) { f32x4 h[2];
#pragma unroll
                for (int n = 0; n < 2; ++n) { const f32x4 g = acc[ai][0][m][n], up = acc[ai][1][m][n];
#pragma unroll
                    for (int j = 0; j < 4; j += 2) {
                        const f32x2 gg = {g[j], g[j + 1]}, uu = {up[j], up[j + 1]}; const f32x2 t = gg * -1.4426950408889634f;
                        f32x2 d = {__builtin_amdgcn_exp2f(t.x), __builtin_amdgcn_exp2f(t.y)}; d = d * ic + ic;
                        const f32x2 r = {__builtin_amdgcn_rcpf(d.x), __builtin_amdgcn_rcpf(d.y)}; const f32x2 hh = (gg * uu) * r;
                        h[n][j] = hh.x; h[n][j + 1] = hh.y; } }
                u32x2 w; w.x = pk4_fp8(h[0][0], h[0][1], h[0][2], h[0][3]); w.y = pk4_fp8(h[1][0], h[1][1], h[1][2], h[1][3]);
                *(u32x2*)(O + (size_t)(row0 + ai * HALF + m * 16) * ldc + col0) = w; }
    }
};
struct EpiNsaIn {
    static constexpr bool PERM = true, AFTER_DRAIN = false, ROWSCALE = false;
    bf16_t* Q; bf16_t* KV; float* gates; const float* cosT; const float* sinT;
    __device__ __forceinline__ void operator()(const f32x4 (&acc)[2][2][4][2], const Unit& u, int wr, int wc, int fr, int fq) const {
        const int pn = u.pn, row0 = u.pm * BM + wr * 64 + fr;
        if (pn == 20) {
            if (wc == 0 || (wc == 1 && fq < 2)) {
#pragma unroll
                for (int ai = 0; ai < 2; ++ai)
#pragma unroll
                    for (int m = 0; m < 4; ++m) { float* gp = gates + (size_t)(row0 + ai * HALF + m * 16) * 48 + wc * 32 + 8 * fq;
#pragma unroll
                        for (int n = 0; n < 2; ++n) { const f32x4 a = acc[ai][0][m][n]; f32x4 s;
#pragma unroll
                            for (int j = 0; j < 4; ++j) s[j] = __builtin_amdgcn_rcpf(1.0f + __builtin_amdgcn_exp2f(-1.4426950408889634f * a[j]));
                            *(f32x4*)(gp + 4 * n) = s; } }
            }
            return;
        }
        bf16_t* base; int ldc, colt; bool rot, chunk;
        if (pn < 8) { base = Q; ldc = DM; colt = pn * BM; rot = true; chunk = false; }
        else { const int sec = (pn - 8) >> 1; base = KV + (size_t)sec * ((size_t)MTOK * 512); ldc = 512; colt = (pn & 1) * BM; rot = (sec & 1) == 0; chunk = sec < 2; }
        const bool dorot = rot && wc == 0;
#pragma unroll
        for (int ai = 0; ai < 2; ++ai)
#pragma unroll
            for (int m = 0; m < 4; ++m) { const int row = row0 + ai * HALF + m * 16, pos = row & (SEQ - 1);
                f32x4 c0, c1, s0, s1;
                if (dorot) { const float* cp = cosT + pos * 16 + 8 * (fq & 1); const float* sp = sinT + pos * 16 + 8 * (fq & 1);
                    c0 = *(const f32x4*)cp; c1 = *(const f32x4*)(cp + 4); s0 = *(const f32x4*)sp; s1 = *(const f32x4*)(sp + 4); }
#pragma unroll
                for (int bj = 0; bj < 2; ++bj) { f32x4 v0 = acc[ai][bj][m][0], v1 = acc[ai][bj][m][1];
                    if (dorot) { f32x4 o0, o1;
#pragma unroll
                        for (int j = 0; j < 4; ++j) { o0[j] = xlane32(v0[j]); o1[j] = xlane32(v1[j]); }
                        if (fq < 2) { v0 = v0 * c0 - o0 * s0; v1 = v1 * c1 - o1 * s1; }
                        else        { v0 = v0 * c0 + o0 * s0; v1 = v1 * c1 + o1 * s1; } }
                    const int col = colt + bj * HALF + wc * 32 + 8 * fq;
                    size_t off;
                    if (!chunk) off = (size_t)row * ldc + col;
                    else { const int b = row >> 12, t = row & (SEQ - 1), g = col >> 7, d = col & 127; off = ((size_t)((b * 256 + (t >> 4)) * 4 + g) * 16 + (t & 15)) * 128 + d; }
                    *(u32x4*)(base + off) = pack8_bf16(v0, v1); } }
    }
};
__device__ __forceinline__ float log_sigmoid_fast(float z) { const float e = __builtin_amdgcn_exp2f(-1.4426950408889634f * __builtin_fabsf(z)); return __builtin_fminf(z, 0.f) - 0.6931471805599453f * __builtin_amdgcn_logf(1.0f + e); }
struct EpiFoxIn {
    static constexpr bool PERM = true, AFTER_DRAIN = false, ROWSCALE = true;
    bf16_t* QKV; float* fl; float* tot; const float* fbias; const float* rs;
    __device__ __forceinline__ void operator()(const f32x4 (&acc)[2][2][4][2], const Unit& u, int wr, int wc, int fr, int fq) const {
        const int pn = u.pn, row0 = u.pm * BM + wr * 64 + fr;
        if (pn == 24) {
            if (wc == 0) {
                const int hb = 8 * (fq & 1); const f32x4 b0 = *(const f32x4*)(fbias + hb), b1 = *(const f32x4*)(fbias + hb + 4);
#pragma unroll
                for (int ai = 0; ai < 2; ++ai) { f32x4 s0 = (f32x4){0.f, 0.f, 0.f, 0.f}, s1 = s0;
#pragma unroll
                    for (int m = 0; m < 4; ++m) { f32x4 v0 = acc[ai][0][m][0] + b0, v1 = acc[ai][0][m][1] + b1;
#pragma unroll
                        for (int j = 0; j < 4; ++j) { v0[j] = log_sigmoid_fast(v0[j]); v1[j] = log_sigmoid_fast(v1[j]); }
                        s0 += v0; s1 += v1;
                        if (fq < 2) { float* gp = fl + (size_t)(row0 + ai * HALF + m * 16) * 16 + 8 * fq; *(f32x4*)gp = v0; *(f32x4*)(gp + 4) = v1; } }
#pragma unroll
                    for (int o = 1; o < 16; o <<= 1)
#pragma unroll
                        for (int j = 0; j < 4; ++j) { s0[j] += __shfl_xor(s0[j], o); s1[j] += __shfl_xor(s1[j], o); }
                    if (fq < 2 && fr == 0) { const int rowc = u.pm * BM + ai * HALF + wr * 64; float* tp = tot + ((size_t)((rowc >> 12) * 64 + ((rowc & (SEQ - 1)) >> 6))) * 16 + 8 * fq; *(f32x4*)tp = s0; *(f32x4*)(tp + 4) = s1; } }
            }
            return;
        }
        bf16_t* base = QKV + (size_t)(pn >> 3) * ((size_t)MTOK * DM); const int col0 = (pn & 7) * BM + wc * 32 + 8 * fq;
#pragma unroll
        for (int ai = 0; ai < 2; ++ai)
#pragma unroll
            for (int m = 0; m < 4; ++m) { bf16_t* rowp = base + (size_t)(row0 + ai * HALF + m * 16) * DM + col0;
#pragma unroll
                for (int bj = 0; bj < 2; ++bj) *(u32x4*)(rowp + bj * HALF) = pack8_bf16(acc[ai][bj][m][0], acc[ai][bj][m][1]); }
    }
};
struct EpiCmpGates {
    static constexpr bool PERM = false, AFTER_DRAIN = false, ROWSCALE = false;
    float* O; int ldc; float* gates;
    __device__ __forceinline__ void operator()(const f32x4 (&acc)[2][2][4][2], const Unit& u, int wr, int wc, int fr, int fq) const {
        const int row0 = u.pm * BM + wr * 64 + fr;
        if (u.pn >= 8) {
            if (wc < 2) {
#pragma unroll
                for (int ai = 0; ai < 2; ++ai)
#pragma unroll
                    for (int m = 0; m < 4; ++m) { float* gp = gates + (size_t)(row0 + ai * HALF + m * 16) * 48 + wc * 32 + 4 * fq;
#pragma unroll
                        for (int n = 0; n < 2; ++n) if (wc == 0 || n == 0) { const f32x4 a = acc[ai][0][m][n]; f32x4 s;
#pragma unroll
                            for (int j = 0; j < 4; ++j) s[j] = __builtin_amdgcn_rcpf(1.0f + __builtin_amdgcn_exp2f(-1.4426950408889634f * a[j]));
                            *(f32x4*)(gp + 16 * n) = s; } }
            }
            return;
        }
        const int col0 = (u.pn & 1) * BM + wc * 32 + 4 * fq;
#pragma unroll
        for (int ai = 0; ai < 2; ++ai)
#pragma unroll
            for (int m = 0; m < 4; ++m) { float* rowp = O + (size_t)(row0 + ai * HALF + m * 16) * ldc + col0;
#pragma unroll
                for (int bj = 0; bj < 2; ++bj)
#pragma unroll
                    for (int n = 0; n < 2; ++n) *(f32x4*)(rowp + bj * HALF + n * 16) = acc[ai][bj][m][n]; }
    }
};
struct CmpGateOrder {
    int G, c, aT0, bT0, hT0, gT;
    __device__ bool next(int i, Unit& u) const { const int L = i * G + c; if (L >= 256) return false;
        if (L < 128) { const int pa = L >> 1; u.pm = pa; u.pn = 2 * (pa >= 32) + (L & 1); u.pa = aT0 + pa; u.pb = bT0 + u.pn; }
        else { u.pm = L - 128; u.pn = 8; u.pa = hT0 + u.pm; u.pb = gT; }
        return true; }
    __device__ __forceinline__ void a_ready(const Unit&) const {}
    __device__ __forceinline__ void done(const Unit&) const {}
};
struct CmpOrder {
    int G, c;
    __device__ bool next(int i, Unit& u) const { const int L = i * G + c; if (L >= 128) return false; u.pa = L >> 1; u.pm = u.pa; u.pb = 2 * (u.pa >= 32) + (L & 1); u.pn = u.pb; return true; }
    __device__ __forceinline__ void a_ready(const Unit&) const {}
    __device__ __forceinline__ void done(const Unit&) const {}
};
template <bool DOWN> struct MoeOrder {
    int t0, nt, nN, G, c; int tb1, tb2, tb3, tb4, tb5, tb6, tb7;
    __device__ bool next(int i, Unit& u) const {
        const int nwg = nt * nN; const long L = (long)i * G + c; if (L >= nwg) return false;
        int wgid = (int)L; { const int q = nwg / NXCD, r = nwg % NXCD, xcd = wgid % NXCD, off = wgid / NXCD; wgid = (xcd < r ? xcd * (q + 1) : r * (q + 1) + (xcd - r) * q) + off; }
        const int nig = WGM * nN, gid = wgid / nig, fm = gid * WGM, gsz = (nt - fm) < WGM ? (nt - fm) : WGM;
        const int pl = fm + ((wgid % nig) % gsz), pn = (wgid % nig) / gsz, pg = t0 + pl;
        const int e = (pg >= tb1) + (pg >= tb2) + (pg >= tb3) + (pg >= tb4) + (pg >= tb5) + (pg >= tb6) + (pg >= tb7);
        u.pn = pn; u.pb = e * nN + pn;
        u.pa = pg; u.pm = pg;
        return true;
    }
    __device__ __forceinline__ void a_ready(const Unit&) const {}
    __device__ __forceinline__ void done(const Unit&) const {}
};

typedef int i32x8 __attribute__((ext_vector_type(8)));
typedef int i32x4_ __attribute__((ext_vector_type(4)));
template <class Epi, class Sched, bool ALIGN_EPI = false, bool SP2 = false, bool F8 = false, int SCB = 0, int SCA = 0>
__device__ __forceinline__ void gemm_phase(PG8_LAS unsigned char* lds, const Gemm g, const Sched& S, const Epi& E) {
    const int tid = threadIdx.x, wid = __builtin_amdgcn_readfirstlane(tid >> 6), lane = tid & 63, wr = wid >> 2, wc = wid & 3, fr = lane & 15, fq = lane >> 4;
    const int KB = F8 ? g.K : 2 * g.K, nt = KB / (2 * BK);
    unsigned voffA[2], voffB[2];
#pragma unroll
    for (int i = 0; i < 2; ++i) { int R, C; stage_rc(tid * 16 + i * 8192, R, C); const int Rb = Epi::PERM ? ((R & ~31) + perm32(R & 31)) : R;
        voffA[i] = (unsigned)(R * KB + C * 2); voffB[i] = (unsigned)(Rb * KB + C * 2); }
    const size_t kstep = (size_t)(BK * 2);
    const size_t hstep = (size_t)HALF * KB;
    const size_t tstep = 2 * hstep;
    const unsigned ldsw = (unsigned)wid * 1024u;
    const int aoff = lds_byte(wr * 64 + fr, fq * 8), boff = lds_byte(wc * 32 + fr, fq * 8);
#define PG8_SA(b, h) (((b) * 2 + (h)) * HTB)
#define PG8_SB(b, h) ((4 + (b) * 2 + (h)) * HTB)
#define PG8_STAGE(bufoff, gbase, voff) do { _Pragma("unroll") for (int _i = 0; _i < 2; ++_i) \
        __builtin_amdgcn_global_load_lds((const unsigned*)((const char*)(gbase) + (voff)[_i]), (PG8_LAS unsigned*)(lds + (bufoff) + ldsw + _i * 8192), 16, 0, 0); } while (0)
#define PG8_LDA(dst, b, h) do { _Pragma("unroll") for (int m = 0; m < 4; ++m) { dst[m].lo = *(const PG8_LAS i32x4_*)(lds + PG8_SA(b, h) + aoff + m * 2048); dst[m].hi = *(const PG8_LAS i32x4_*)(lds + PG8_SA(b, h) + aoff + m * 2048 + 1024); } } while (0)
#define PG8_LDB(dst, b, h) do { _Pragma("unroll") for (int n = 0; n < 2; ++n) { dst[n].lo = *(const PG8_LAS i32x4_*)(lds + PG8_SB(b, h) + boff + n * 2048); dst[n].hi = *(const PG8_LAS i32x4_*)(lds + PG8_SB(b, h) + boff + n * 2048 + 1024); } } while (0)
#define PG8_LO(v) __builtin_bit_cast(bf16x8, __builtin_shufflevector(v, v, 0, 1, 2, 3))
#define PG8_HI(v) __builtin_bit_cast(bf16x8, __builtin_shufflevector(v, v, 4, 5, 6, 7))
#define PG8_MMA(ai, bj, At, Bt) do { __builtin_amdgcn_s_setprio(1); _Pragma("unroll") for (int m = 0; m < 4; ++m) _Pragma("unroll") for (int n = 0; n < 2; ++n) { \
        if constexpr (F8) asm volatile("v_mfma_scale_f32_16x16x128_f8f6f4 %0, %1, %2, %0, %3, %4 op_sel_hi:[0,0,0]" : "+v"(acc[ai][bj][m][n]) : "v"(Bt[n]), "v"(At[m]), "v"(scb_), "v"(sca_)); \
        else { acc[ai][bj][m][n] = __builtin_amdgcn_mfma_f32_16x16x32_bf16(PG8_LO(Bt[n]), PG8_LO(At[m]), acc[ai][bj][m][n], 0, 0, 0); \
               acc[ai][bj][m][n] = __builtin_amdgcn_mfma_f32_16x16x32_bf16(PG8_HI(Bt[n]), PG8_HI(At[m]), acc[ai][bj][m][n], 0, 0, 0); } } __builtin_amdgcn_s_setprio(0); } while (0)
#define PG8_WAIT_V(n) asm volatile("s_waitcnt vmcnt(" #n ")" ::: "memory")
#define PG8_WAIT_L(n) asm volatile("s_waitcnt lgkmcnt(" #n ")" ::: "memory")
#define PG8_BAR __builtin_amdgcn_s_barrier()
#define PG8_SCHED __builtin_amdgcn_sched_barrier(0)
    Unit cur, nxt; int ui = 0;
    if (!S.next(0, cur)) return;
    f32x4 acc[2][2][4][2];
#pragma unroll
    for (int a = 0; a < 2; ++a)
#pragma unroll
        for (int b = 0; b < 2; ++b)
#pragma unroll
            for (int m = 0; m < 4; ++m)
#pragma unroll
                for (int n = 0; n < 2; ++n) acc[a][b][m][n] = (f32x4){0.f, 0.f, 0.f, 0.f};
    const int scb_ = SCB, sca_ = SCA; (void)scb_; (void)sca_;
    i32x8 At[4], B0[2], B1[2];
    const char* cA = (const char*)g.A + (size_t)cur.pa * tstep; const char* cB = (const char*)g.Bt + (size_t)cur.pb * tstep;
    S.a_ready(cur);
    if constexpr (SP2) {
        PG8_STAGE(PG8_SB(0, 0), cB, voffB); PG8_STAGE(PG8_SB(0, 1), cB + hstep, voffB); PG8_STAGE(PG8_SA(0, 0), cA, voffA); PG8_STAGE(PG8_SA(0, 1), cA + hstep, voffA);
        if (wr == 1) PG8_BAR;
        PG8_WAIT_V(2); PG8_BAR;
        PG8_STAGE(PG8_SB(1, 0), cB + kstep, voffB); PG8_STAGE(PG8_SA(1, 0), cA + kstep, voffA); PG8_STAGE(PG8_SB(1, 1), cB + hstep + kstep, voffB);
        PG8_WAIT_V(6); PG8_BAR;
    } else {
        PG8_STAGE(PG8_SB(0, 0), cB, voffB); PG8_STAGE(PG8_SA(0, 0), cA, voffA); PG8_STAGE(PG8_SB(0, 1), cB + hstep, voffB); PG8_STAGE(PG8_SA(0, 1), cA + hstep, voffA);
        if (wr == 1) PG8_BAR;
        PG8_WAIT_V(4); PG8_BAR;
        PG8_STAGE(PG8_SB(1, 0), cB + kstep, voffB); PG8_STAGE(PG8_SA(1, 0), cA + kstep, voffA); PG8_STAGE(PG8_SB(1, 1), cB + hstep + kstep, voffB);
        PG8_WAIT_V(6); PG8_BAR;
    }
    for (;;) {
        const bool has_next = S.next(ui + 1, nxt);
        const char* nA = has_next ? (const char*)g.A + (size_t)nxt.pa * tstep : cA; const char* nB = has_next ? (const char*)g.Bt + (size_t)nxt.pb * tstep : cB;
        for (int t = 0; t < nt; t += 2) {
            const bool last = (t == nt - 2);
            const char* a1 = cA + (size_t)(t + 1) * kstep;
            const char* a2 = last ? nA : cA + (size_t)(t + 2) * kstep; const char* b2 = last ? nB : cB + (size_t)(t + 2) * kstep;
            const char* a3 = a2 + kstep; const char* b3 = b2 + kstep;
            if (last && has_next) S.a_ready(nxt);
            if constexpr (SP2) {
            PG8_LDB(B0, 0, 0); PG8_LDB(B1, 0, 1); PG8_SCHED; PG8_LDA(At, 0, 0); PG8_STAGE(PG8_SA(1, 1), a1 + hstep, voffA);
            PG8_WAIT_V(8); PG8_WAIT_L(0); PG8_BAR; PG8_MMA(0, 0, At, B0); PG8_MMA(0, 1, At, B1); PG8_BAR; PG8_SCHED;
            PG8_LDA(At, 0, 1); PG8_STAGE(PG8_SB(0, 0), b2, voffB); PG8_STAGE(PG8_SB(0, 1), b2 + hstep, voffB); PG8_STAGE(PG8_SA(0, 0), a2, voffA);
            PG8_WAIT_V(8); PG8_WAIT_L(0); PG8_BAR; PG8_MMA(1, 0, At, B0); PG8_MMA(1, 1, At, B1); PG8_BAR; PG8_SCHED;
            PG8_LDB(B0, 1, 0); PG8_LDB(B1, 1, 1); PG8_SCHED; PG8_LDA(At, 1, 0); PG8_STAGE(PG8_SA(0, 1), a2 + hstep, voffA);
            PG8_WAIT_V(8); PG8_WAIT_L(0); PG8_BAR; PG8_MMA(0, 0, At, B0); PG8_MMA(0, 1, At, B1); PG8_BAR; PG8_SCHED;
            PG8_LDA(At, 1, 1); PG8_STAGE(PG8_SB(1, 0), b3, voffB); PG8_STAGE(PG8_SB(1, 1), b3 + hstep, voffB); PG8_STAGE(PG8_SA(1, 0), a3, voffA);
            PG8_WAIT_V(8); PG8_WAIT_L(0); PG8_BAR; PG8_MMA(1, 0, At, B0); PG8_MMA(1, 1, At, B1); PG8_BAR; PG8_SCHED;
            } else {
            PG8_LDB(B0, 0, 0); PG8_SCHED; PG8_LDA(At, 0, 0); PG8_STAGE(PG8_SA(1, 1), a1 + hstep, voffA);
            PG8_WAIT_L(8); PG8_BAR; PG8_WAIT_L(0); PG8_MMA(0, 0, At, B0); PG8_BAR; PG8_SCHED;
            PG8_LDB(B1, 0, 1); PG8_STAGE(PG8_SB(0, 0), b2, voffB);
            PG8_BAR; PG8_WAIT_L(0); PG8_MMA(0, 1, At, B1); PG8_BAR;
            PG8_LDA(At, 0, 1); PG8_STAGE(PG8_SA(0, 0), a2, voffA);
            PG8_BAR; PG8_WAIT_L(0); PG8_MMA(1, 0, At, B0); PG8_BAR; PG8_SCHED;
            PG8_STAGE(PG8_SB(0, 1), b2 + hstep, voffB);
            PG8_WAIT_V(6); PG8_BAR; PG8_MMA(1, 1, At, B1); PG8_BAR;
            PG8_LDB(B0, 1, 0); PG8_SCHED; PG8_LDA(At, 1, 0); PG8_STAGE(PG8_SA(0, 1), a2 + hstep, voffA);
            PG8_WAIT_L(8); PG8_BAR; PG8_WAIT_L(0); PG8_MMA(0, 0, At, B0); PG8_BAR; PG8_SCHED;
            PG8_LDB(B1, 1, 1); PG8_STAGE(PG8_SB(1, 0), b3, voffB);
            PG8_BAR; PG8_WAIT_L(0); PG8_MMA(0, 1, At, B1); PG8_BAR;
            PG8_LDA(At, 1, 1); PG8_STAGE(PG8_SA(1, 0), a3, voffA);
            PG8_BAR; PG8_WAIT_L(0); PG8_MMA(1, 0, At, B0); PG8_BAR; PG8_SCHED;
            PG8_STAGE(PG8_SB(1, 1), b3 + hstep, voffB);
            PG8_WAIT_V(6); PG8_BAR; PG8_MMA(1, 1, At, B1); PG8_BAR;
            }
        }
        if constexpr (ALIGN_EPI) { if (wr == 0) PG8_BAR; }
        if constexpr (F8) asm volatile("s_nop 15\n\ts_nop 15" ::: "memory");
        if constexpr (Epi::ROWSCALE) {
            const float* rp = E.rs + cur.pm * BM + wr * 64 + fr;
#pragma unroll
            for (int a = 0; a < 2; ++a)
#pragma unroll
                for (int m = 0; m < 4; ++m) { const float s_ = rp[a * HALF + m * 16];
#pragma unroll
                    for (int b = 0; b < 2; ++b)
#pragma unroll
                        for (int n = 0; n < 2; ++n) acc[a][b][m][n] *= s_; } }
        if constexpr (!Epi::AFTER_DRAIN) { E(acc, cur, wr, wc, fr, fq); S.done(cur); }
        if (!has_next) break;
#pragma unroll
        for (int a = 0; a < 2; ++a)
#pragma unroll
            for (int b = 0; b < 2; ++b)
#pragma unroll
                for (int m = 0; m < 4; ++m)
#pragma unroll
                    for (int n = 0; n < 2; ++n) acc[a][b][m][n] = (f32x4){0.f, 0.f, 0.f, 0.f};
        cur = nxt; cA = nA; cB = nB; ++ui;
        if constexpr (ALIGN_EPI) { if (wr == 1) PG8_BAR; }
    }
    PG8_WAIT_V(0);
    if constexpr (!ALIGN_EPI) { if (wr == 0) PG8_BAR; }
    PG8_BAR;
    if constexpr (Epi::AFTER_DRAIN) { E.fused(acc, cur, wr, wc, fr, fq, lds, wid, lane); S.done(cur); }
#undef PG8_SA
#undef PG8_SB
#undef PG8_STAGE
#undef PG8_LDA
#undef PG8_LDB
#undef PG8_MMA
#undef PG8_WAIT_V
#undef PG8_WAIT_L
#undef PG8_BAR
#undef PG8_SCHED
}
}

namespace att {
typedef unsigned short bf16;
typedef short bf16x8 __attribute__((ext_vector_type(8)));
typedef short s16x4 __attribute__((ext_vector_type(4)));
typedef float f32x16 __attribute__((ext_vector_type(16)));
typedef float f32x4 __attribute__((ext_vector_type(4)));
typedef unsigned u32x4 __attribute__((ext_vector_type(4)));
constexpr int D = 128, NW = 8, QBLK = 32, KVBLK = 64, QB = NW * QBLK;
constexpr int SHM_V = KVBLK * D * 2, SHM_K = KVBLK * D * 2;
constexpr float SCALE = 0.08838834764831845f, THR = 8.f;
constexpr int WS_OFF = 2 * SHM_V + 2 * SHM_K, CB_OFF = WS_OFF + NW * 128 * 4, OT_OFF = CB_OFF + 512, OT_PITCH = 272, OT_WAVE = 32 * OT_PITCH, ATT_LDS = OT_OFF + NW * OT_WAVE;
enum { MODE_WIN = 0, MODE_SLC = 1, MODE_FOX = 2 };

#define KSWZ(row, colB) ((row) * 256 + ((colB) ^ (((row) & 15) << 4)))
#define SBAR() __builtin_amdgcn_sched_barrier(0)
__device__ __forceinline__ int v_st(int k, int c) { const int kk = (k & ~0xC) | ((k & 4) << 1) | ((k & 8) >> 1); return ((kk >> 3) * 4 + (c >> 5)) * 512 + ((kk & 7) * 32 + (c & 31)) * 2; }
__device__ __forceinline__ int v_rd_base(int lane) { return ((lane & 3) << 3) | (((lane >> 2) & 3) << 6) | (((lane >> 4) & 1) << 5) | (((lane >> 5) & 1) << 8); }
constexpr int v_rd_off(int d0, int ks, int half) { return d0 * 512 + ks * 4096 + half * 2048; }
__device__ __forceinline__ int crow(int r, int hi) { return (r & 3) + 8 * (r >> 2) + 4 * hi; }
__device__ __forceinline__ unsigned cvtpk(float lo, float hi) { unsigned r; asm volatile("v_cvt_pk_bf16_f32 %0, %1, %2" : "=v"(r) : "v"(lo), "v"(hi)); return r; }
__device__ __forceinline__ bf16x8 load8(const bf16* p) { return *reinterpret_cast<const bf16x8*>(p); }
__device__ __forceinline__ float bf_lo(unsigned w) { return __uint_as_float(w << 16); }
__device__ __forceinline__ float bf_hi(unsigned w) { return __uint_as_float(w & 0xffff0000u); }
__device__ __forceinline__ void mask_tile(f32x16& p0, f32x16& p1, int dq, unsigned W) {
    const float NEG = -__builtin_inff();
#pragma unroll
    for (int r = 0; r < 16; ++r) {
        const int c = (r & 3) + 8 * (r >> 2);
        if ((unsigned)(dq - c) >= W) p0[r] = NEG;
        if ((unsigned)(dq - c - 32) >= W) p1[r] = NEG;
    }
}
template <bool RS>
__device__ __forceinline__ void partialSM(f32x16& p0, f32x16& p1, float& m_reg, float& mn, float& alpha, bool sel) {
    float pmax = p0[0]; for (int r = 1; r < 16; ++r) pmax = fmaxf(pmax, p0[r]); for (int r = 0; r < 16; ++r) pmax = fmaxf(pmax, p1[r]);
    { auto rr = __builtin_amdgcn_permlane32_swap(__float_as_uint(pmax), __float_as_uint(pmax), false, false);
      pmax = fmaxf(__uint_as_float(rr[0]), __uint_as_float(rr[1])); }
    if (RS) pmax = sel ? pmax : -__builtin_inff();
    constexpr float C2 = 1.4426950408889634f * SCALE;
    if (__builtin_expect(__all((pmax - m_reg) * SCALE <= THR), 1)) { mn = m_reg; alpha = 1.f; }
    else { mn = fmaxf(m_reg, pmax); alpha = __builtin_amdgcn_exp2f((m_reg - mn) * C2); m_reg = mn; }
    float mnL = -mn * C2;
    if (RS) mnL = sel ? mnL : -__builtin_inff();
    for (int r = 0; r < 16; ++r) p0[r] = fmaf(p0[r], C2, mnL); for (int r = 0; r < 16; ++r) p1[r] = fmaf(p1[r], C2, mnL);
    for (int r = 0; r < 16; ++r) p0[r] = __builtin_amdgcn_exp2f(p0[r]);
}
#define ATT_PK4(P, B_, OUT) do { unsigned a0 = cvtpk(P[B_+0], P[B_+1]), a1 = cvtpk(P[B_+2], P[B_+3]);                          \
        unsigned b0 = cvtpk(P[B_+4], P[B_+5]), b1 = cvtpk(P[B_+6], P[B_+7]);                                             \
        auto r0 = __builtin_amdgcn_permlane32_swap(a0, b0, false, false); auto r1 = __builtin_amdgcn_permlane32_swap(a1, b1, false, false); \
        u32x4 w = {r0[0], r1[0], r0[1], r1[1]}; OUT = *reinterpret_cast<bf16x8*>(&w); } while (0)
__device__ __forceinline__ void finishSM(f32x16& p0, f32x16& p1, float alpha, float& l_reg, bf16x8& pa0, bf16x8& pa1, bf16x8& pa2, bf16x8& pa3) {
    for (int r = 0; r < 16; ++r) p1[r] = __builtin_amdgcn_exp2f(p1[r]);
    float ps = 0; for (int r = 0; r < 16; ++r) ps += p0[r]; for (int r = 0; r < 16; ++r) ps += p1[r];
    { auto rr = __builtin_amdgcn_permlane32_swap(__float_as_uint(ps), __float_as_uint(ps), false, false);
      ps = __uint_as_float(rr[0]) + __uint_as_float(rr[1]); }
    l_reg = l_reg * alpha + ps;
    ATT_PK4(p0, 0, pa0); ATT_PK4(p0, 8, pa1); ATT_PK4(p1, 0, pa2); ATT_PK4(p1, 8, pa3);
}
template <int KB, int MODE>
__device__ __forceinline__ void qkt(f32x16& p0, f32x16& p1, const char* K_lds, const char* C_lds, int r32, int hi, const bf16x8* qr, float cq, int tk = 0) {
    if (MODE == MODE_FOX) {
        const char* cb = C_lds + KB * 256 + hi * 16;
#pragma unroll
        for (int i = 0; i < 4; ++i) { const f32x4 a = *reinterpret_cast<const f32x4*>(cb + i * 32); const f32x4 b = *reinterpret_cast<const f32x4*>(cb + 128 + i * 32);
#pragma unroll
            for (int j = 0; j < 4; ++j) { p0[4 * i + j] = a[j]; p1[4 * i + j] = b[j]; } }
    } else { p0 = f32x16{}; p1 = f32x16{}; }
    typedef const __attribute__((address_space(3))) bf16x8* lds_b8p;
    unsigned ka = 0; int ko[4] = {0, 0, 0, 0}, flip = 128;
    if (MODE == MODE_WIN) {
#pragma unroll
        for (int dd = 0; dd < 4; ++dd) ko[dd] = KSWZ(r32, (dd * 16 + hi * 8) * 2);
        asm volatile("" : "+v"(flip));
    } else {
        ka = (unsigned)(uintptr_t)(const __attribute__((address_space(3))) char*)K_lds + KSWZ(r32, hi * 16);
        asm("" : "+v"(ka) : "s"(tk));
    }
#pragma unroll
    for (int d0 = 0; d0 < 8; ++d0) {
        bf16x8 b0, b1;
        if (MODE == MODE_WIN) { const char* a = K_lds + KB * SHM_K + (d0 < 4 ? ko[d0] : (ko[d0 & 3] ^ flip));
            b0 = *reinterpret_cast<const bf16x8*>(a); b1 = *reinterpret_cast<const bf16x8*>(a + 32 * 256);
        } else { const unsigned a = (ka ^ (unsigned)(d0 * 32)) + KB * SHM_K;
            b0 = *(lds_b8p)(uintptr_t)a; b1 = *(lds_b8p)(uintptr_t)(a + 32 * 256); }
        p0 = __builtin_amdgcn_mfma_f32_32x32x16_bf16(b0, qr[d0], p0, 0, 0, 0);
        p1 = __builtin_amdgcn_mfma_f32_32x32x16_bf16(b1, qr[d0], p1, 0, 0, 0); }
}
template <int VB>
__device__ __forceinline__ void pv_tile(f32x16* o, int vb0, bf16x8 pa0, bf16x8 pa1, bf16x8 pa2, bf16x8 pa3) {
#define TRRD(dst, off) asm volatile("ds_read_b64_tr_b16 %0, %1 offset:%2" : "=&v"(dst) : "v"(vb0), "i"(off) : "memory")
#define PV_D0(d0) do { s16x4 l0, l1, l2, l3, h0, h1, h2, h3; constexpr int b_ = VB * SHM_V + v_rd_off(d0, 0, 0);   \
        TRRD(l0, b_); TRRD(h0, b_ + 2048); TRRD(l1, b_ + 4096); TRRD(h1, b_ + 6144); TRRD(l2, b_ + 8192); TRRD(h2, b_ + 10240); TRRD(l3, b_ + 12288); TRRD(h3, b_ + 14336); \
        asm volatile("s_waitcnt lgkmcnt(0)" ::: "memory"); SBAR();   \
        o[d0] = __builtin_amdgcn_mfma_f32_32x32x16_bf16(pa0, (bf16x8){l0[0], l0[1], l0[2], l0[3], h0[0], h0[1], h0[2], h0[3]}, o[d0], 0, 0, 0);   \
        o[d0] = __builtin_amdgcn_mfma_f32_32x32x16_bf16(pa1, (bf16x8){l1[0], l1[1], l1[2], l1[3], h1[0], h1[1], h1[2], h1[3]}, o[d0], 0, 0, 0);   \
        o[d0] = __builtin_amdgcn_mfma_f32_32x32x16_bf16(pa2, (bf16x8){l2[0], l2[1], l2[2], l2[3], h2[0], h2[1], h2[2], h2[3]}, o[d0], 0, 0, 0);   \
        o[d0] = __builtin_amdgcn_mfma_f32_32x32x16_bf16(pa3, (bf16x8){l3[0], l3[1], l3[2], l3[3], h3[0], h3[1], h3[2], h3[3]}, o[d0], 0, 0, 0); } while (0)
    PV_D0(0); PV_D0(1); PV_D0(2); PV_D0(3);
#undef PV_D0
#undef TRRD
}

template <int VB, bool RS>
__device__ __forceinline__ void pv_sm_tile(f32x16* o, int vb0, bf16x8 pa0, bf16x8 pa1, bf16x8 pa2, bf16x8 pa3, f32x16& p0, f32x16& p1, float& m_reg, float& mn, float& alpha, bool sel) {
#define TRRD(dst, off) asm volatile("ds_read_b64_tr_b16 %0, %1 offset:%2" : "=&v"(dst) : "v"(vb0), "i"(off) : "memory")
#define PV_RD(g) s16x4 l0##g, l1##g, l2##g, l3##g, h0##g, h1##g, h2##g, h3##g; { constexpr int b_ = VB * SHM_V + v_rd_off(g, 0, 0);   \
        TRRD(l0##g, b_); TRRD(h0##g, b_ + 2048); TRRD(l1##g, b_ + 4096); TRRD(h1##g, b_ + 6144); TRRD(l2##g, b_ + 8192); TRRD(h2##g, b_ + 10240); TRRD(l3##g, b_ + 12288); TRRD(h3##g, b_ + 14336); }
#define PV_WT() do { asm volatile("s_waitcnt lgkmcnt(0)" ::: "memory"); SBAR(); } while (0)
#define PV_MM(g) do {   \
        o[g] = __builtin_amdgcn_mfma_f32_32x32x16_bf16(pa0, (bf16x8){l0##g[0], l0##g[1], l0##g[2], l0##g[3], h0##g[0], h0##g[1], h0##g[2], h0##g[3]}, o[g], 0, 0, 0);   \
        o[g] = __builtin_amdgcn_mfma_f32_32x32x16_bf16(pa1, (bf16x8){l1##g[0], l1##g[1], l1##g[2], l1##g[3], h1##g[0], h1##g[1], h1##g[2], h1##g[3]}, o[g], 0, 0, 0);   \
        o[g] = __builtin_amdgcn_mfma_f32_32x32x16_bf16(pa2, (bf16x8){l2##g[0], l2##g[1], l2##g[2], l2##g[3], h2##g[0], h2##g[1], h2##g[2], h2##g[3]}, o[g], 0, 0, 0);   \
        o[g] = __builtin_amdgcn_mfma_f32_32x32x16_bf16(pa3, (bf16x8){l3##g[0], l3##g[1], l3##g[2], l3##g[3], h3##g[0], h3##g[1], h3##g[2], h3##g[3]}, o[g], 0, 0, 0); } while (0)
    constexpr float C2 = 1.4426950408889634f * SCALE;
    PV_RD(0); PV_WT();
    PV_MM(0); PV_RD(1);
    float pmax = p0[0];
#pragma unroll
    for (int r = 1; r < 16; ++r) pmax = fmaxf(pmax, p0[r]);
#pragma unroll
    for (int r = 0; r < 16; ++r) pmax = fmaxf(pmax, p1[r]);
    { auto rr = __builtin_amdgcn_permlane32_swap(__float_as_uint(pmax), __float_as_uint(pmax), false, false);
      pmax = fmaxf(__uint_as_float(rr[0]), __uint_as_float(rr[1])); }
    if (RS) pmax = sel ? pmax : -__builtin_inff();
    PV_WT();
    PV_MM(1); PV_RD(2);
    { const bool keep = __all((pmax - m_reg) * SCALE <= THR);
      mn = keep ? m_reg : fmaxf(m_reg, pmax); alpha = __builtin_amdgcn_exp2f((m_reg - mn) * C2); m_reg = mn; }
    float mnL = -mn * C2;
    if (RS) mnL = sel ? mnL : -__builtin_inff();
#pragma unroll
    for (int r = 0; r < 16; ++r) p0[r] = fmaf(p0[r], C2, mnL);
#pragma unroll
    for (int r = 0; r < 16; ++r) p1[r] = fmaf(p1[r], C2, mnL);
    asm volatile("" : "+v"(p0), "+v"(p1));
    PV_WT();
    PV_MM(2); PV_RD(3);
#pragma unroll
    for (int r = 0; r < 8; ++r) p0[r] = __builtin_amdgcn_exp2f(p0[r]);
    asm volatile("" : "+v"(p0));
    PV_WT();
    PV_MM(3);
#pragma unroll
    for (int r = 8; r < 16; ++r) p0[r] = __builtin_amdgcn_exp2f(p0[r]);
    asm volatile("" : "+v"(p0));
#undef PV_MM
#undef PV_WT
#undef PV_RD
#undef TRRD
}

struct BlockRef { const bf16* Q; const bf16* K; const bf16* V; bf16* O; int P0; const float* aux; const unsigned long long* selm; };
struct Seam { bf16x8 qr[8]; bf16x8 st_v0, st_v1, st_k0, st_k1; float st_c; };
__device__ __forceinline__ int swa_jlo(int P0, int W) { const int lowk = P0 - W + 1; return lowk > 0 ? lowk / KVBLK : 0; }
template <int MODE, bool GQA>
__device__ __forceinline__ int first_kb(int P0, int W, int skv) {
    if (MODE == MODE_WIN) return swa_jlo(P0, W) * KVBLK;
    int jh = (P0 + (GQA ? 2 * QBLK : QB) - 1) / KVBLK + 1; if (jh > skv / KVBLK) jh = skv / KVBLK; return (jh - 1) * KVBLK; }
#define ROW(p, k0, hf) ((p) + (size_t)(((k0) + 32 * (hf)) * KS) + lane_off)
#define VMW() asm volatile("s_waitcnt vmcnt(0)" ::: "memory")
#define VMWN(n) asm volatile("s_waitcnt vmcnt(%0)" :: "i"(n) : "memory")
#define SLOAD_K(Kp, Cp, k0) do { S.st_k0 = load8(ROW(Kp, k0, 0)); S.st_k1 = load8(ROW(Kp, k0, 1));                  \
                         if (MODE == MODE_FOX) { if (tid < 64) S.st_c = (Cp)[(k0) + tid]; } } while (0)
#define SLOAD_V(Vp, k0) do { S.st_v0 = load8(ROW(Vp, k0, 0)); S.st_v1 = load8(ROW(Vp, k0, 1)); } while (0)
#define SLOAD_H(Kp, Vp, Cp, k0) do { SLOAD_K(Kp, Cp, k0); SLOAD_V(Vp, k0); } while (0)
#define SWRITE_HK(bf) do { *(bf16x8*)(K_lds + (bf) * SHM_K + kws) = S.st_k0; *(bf16x8*)(K_lds + (bf) * SHM_K + kws + 32 * 256) = S.st_k1;   \
                         if (MODE == MODE_FOX) { if (tid < 64) *reinterpret_cast<float*>(C_lds + (bf) * 256 + tid * 4) = -S.st_c; } } while (0)
#define SWRITE_HV(bf) do { *(bf16x8*)(V_lds + (bf) * SHM_V + vst0) = S.st_v0; *(bf16x8*)(V_lds + (bf) * SHM_V + vst1) = S.st_v1; } while (0)
#define SWRITE_H(bf) do { SWRITE_HV(bf); SWRITE_HK(bf); } while (0)
template <int MODE, int QS, int KS, bool GQA>
__device__ __forceinline__ void att_prime(const BlockRef& cur, int skv, int W, char* lds, Seam& S) {
    const int tid = threadIdx.x, wid = __builtin_amdgcn_readfirstlane(tid >> 6), lane = tid & 63, r32 = lane & 31, hi = lane >> 5;
    const int sr = tid >> 4, sc = (tid & 15) * 8, kws = KSWZ(sr, sc * 2); char* K_lds = lds + 2 * SHM_V; char* C_lds = lds + CB_OFF; const unsigned lane_off = (unsigned)(sr * KS + sc);
    const int kb0 = first_kb<MODE, GQA>(cur.P0, W, skv);
#pragma unroll
    for (int d0 = 0; d0 < 8; ++d0) S.qr[d0] = load8(cur.Q + (unsigned)((GQA ? ((wid & 1) * QBLK + r32) * QS + (wid >> 1) * D : (wid * QBLK + r32) * QS) + d0 * 16 + hi * 8));
    SLOAD_H(cur.K, cur.V, cur.aux, kb0); VMW(); SWRITE_HK(0);
    __syncthreads();
}
template <int MODE, int QS, int KS, int OS, bool ACCUM, bool GQA>
__device__ __forceinline__ void att_block(const BlockRef& cur, const BlockRef& nxt, int skv, int W, char* lds, Seam& S) {
    constexpr bool RS = MODE == MODE_SLC, AHEAD = MODE == MODE_FOX;
    const int tid = threadIdx.x, wid = __builtin_amdgcn_readfirstlane(tid >> 6), lane = tid & 63, r32 = lane & 31, hi = lane >> 5;
    const int j_lo = swa_jlo(cur.P0, W);
    constexpr int TOKB = GQA ? 2 * QBLK : QB;
    int j_hi = (cur.P0 + TOKB - 1) / KVBLK + 1; if (j_hi > skv / KVBLK) j_hi = skv / KVBLK;
    const int rowt = GQA ? (wid & 1) * QBLK : wid * QBLK;
    const int NT = j_hi - j_lo;
    const int kbn = first_kb<MODE, GQA>(nxt.P0, W, skv);
    const int qlo = cur.P0 + rowt, qm = qlo + r32 - 4 * hi;
    char* V_lds = lds; char* K_lds = lds + 2 * SHM_V; char* C_lds = lds + CB_OFF;
    float* ws = (float*)(lds + WS_OFF) + wid * 128; float* li_l = ws, * al_l = ws + 32; unsigned long long* rm_l = (unsigned long long*)(ws + 64);
    float m_reg = -1e30f, l_reg = 0; f32x16 o[4] = {};
    const int sr = tid >> 4, sc = (tid & 15) * 8, vst0 = v_st(sr, sc), vst1 = vst0 + 8192  , kws = KSWZ(sr, sc * 2); const unsigned lane_off = (unsigned)(sr * KS + sc);
    const int vb0 = (int)(uintptr_t)V_lds + v_rd_base(lane);
    const bf16* Kh = cur.K; const bf16* Vh = cur.V; const float* Ch = cur.aux;
    float cq = 0.f, gate = 1.f; unsigned long long rmask;
    if (MODE != MODE_FOX) { gate = cur.aux[(unsigned)((rowt + r32) * 48 + (GQA ? (wid >> 1) : 0))]; if (hi == 0) li_l[r32] = gate; }
    if (MODE == MODE_SLC) { rmask = cur.selm[rowt + r32]; if (hi == 0) rm_l[r32] = rmask; }
#define RESC(a) do { if (__any((a) < 1.f)) { if (hi == 0) al_l[r32] = (a); asm volatile("s_waitcnt lgkmcnt(0)" ::: "memory");              \
                     for (int d_ = 0; d_ < 4; ++d_) for (int r = 0; r < 16; ++r) o[d_][r] *= al_l[crow(r, hi)]; } } while (0)
#define TILE(t) (MODE != MODE_WIN ? j_hi - 1 - (t) : j_lo + (t))
#define KBASE(t) (TILE(t) * KVBLK)
#define SEL(t) (MODE == MODE_SLC ? (((rm_l[r32] >> TILE(t)) & 1ull) != 0ull) : true)
#define MASKT(P0_, P1_, t) do { const int kb_ = KBASE(t); if (kb_ + KVBLK - 1 > qlo || kb_ <= qlo + QBLK - 1 - W) mask_tile(P0_, P1_, qm - kb_, (unsigned)W); } while (0)
#define SEAM_K0() do { if constexpr (ACCUM) VMWN(16); else VMWN(8); SWRITE_HK(0); SBAR(); } while (0)
    f32x16 pA0, pA1, pB0, pB1; float mnA, mnB, alA, alB; bf16x8 pa0, pa1, pa2, pa3;
    SWRITE_HV(0); SBAR();
    if (NT > 1) SLOAD_H(Kh, Vh, Ch, KBASE(1));
    SBAR(); qkt<0, MODE>(pA0, pA1, K_lds, C_lds, r32, hi, S.qr, cq);
    MASKT(pA0, pA1, 0); partialSM<RS>(pA0, pA1, m_reg, mnA, alA, SEL(0));
    if (NT > 1) { if constexpr (AHEAD) { SWRITE_HK(1); if (NT > 2) SLOAD_K(Kh, Ch, KBASE(2)); } else { VMW(); SWRITE_H(1); } }
    __syncthreads();
#define HALF_STEP(PX0, PX1, mnX, alX, PY0, PY1, alY, t, KB, VB, SB) do {                                                      \
        SBAR(); qkt<KB, MODE>(PX0, PX1, K_lds, C_lds, r32, hi, S.qr, cq, (t));                                                     \
        finishSM(PY0, PY1, alY, l_reg, pa0, pa1, pa2, pa3); SBAR();                                                           \
        if constexpr (AHEAD) { SWRITE_HV(KB); if ((t) + 1 < NT) { SLOAD_V(Vh, KBASE((t) + 1)); } SBAR(); }                    \
        else if ((t) + 1 < NT) { SLOAD_H(Kh, Vh, Ch, KBASE((t) + 1)); SBAR(); }                                               \
        MASKT(PX0, PX1, (t)); SBAR(); pv_sm_tile<VB, RS>(o, vb0, pa0, pa1, pa2, pa3, PX0, PX1, m_reg, mnX, alX, SEL(t));          \
        if constexpr (AHEAD) { if ((t) + 1 < NT) SWRITE_HK(SB); if ((t) + 2 < NT) SLOAD_K(Kh, Ch, KBASE((t) + 2)); }          \
        else if ((t) + 1 < NT) { VMWN(2); SWRITE_HK(SB); }     \
        __syncthreads();                                               \
        if constexpr (!AHEAD) { if ((t) + 1 < NT) { VMW(); SWRITE_HV(SB); } }     \
        RESC(alX); } while (0)
    for (int t = 1; t + 1 < NT; t += 2) {
        HALF_STEP(pB0, pB1, mnB, alB, pA0, pA1, alA, t, 1, 0, 0);
        HALF_STEP(pA0, pA1, mnA, alA, pB0, pB1, alB, t + 1, 0, 1, 1);
    }
    const bool even = (NT & 1) == 0;
    if (even) { SBAR(); qkt<1, MODE>(pB0, pB1, K_lds, C_lds, r32, hi, S.qr, cq, NT); if constexpr (AHEAD) SWRITE_HV(1); SBAR(); }
    SLOAD_H(nxt.K, nxt.V, nxt.aux, kbn); SBAR();
#pragma unroll
    for (int d0 = 0; d0 < 8; ++d0) S.qr[d0] = load8(nxt.Q + (unsigned)((GQA ? (rowt + r32) * QS + (wid >> 1) * D : (rowt + r32) * QS) + d0 * 16 + hi * 8));
    bf16* Ow = cur.O + (GQA ? (unsigned)(rowt * OS + (wid >> 1) * D) : (unsigned)(rowt * OS));
    u32x4 oldv[8];
    if constexpr (ACCUM) {
#pragma unroll
        for (int j = 0; j < 8; ++j) oldv[j] = *(const u32x4*)(Ow + (size_t)(j * 4 * OS) + (unsigned)((lane >> 4) * OS + (lane & 15) * 8)); }
    SBAR();
    finishSM(pA0, pA1, alA, l_reg, pa0, pa1, pa2, pa3); SBAR();
    pv_tile<0>(o, vb0, pa0, pa1, pa2, pa3);
    if (even) { MASKT(pB0, pB1, NT - 1); partialSM<RS>(pB0, pB1, m_reg, mnB, alB, SEL(NT - 1)); __syncthreads(); RESC(alB);
        finishSM(pB0, pB1, alB, l_reg, pa0, pa1, pa2, pa3); SBAR(); pv_tile<1>(o, vb0, pa0, pa1, pa2, pa3); }
    SBAR(); SEAM_K0();
    if (hi == 0) li_l[r32] = (MODE == MODE_FOX ? 1.f : li_l[r32]) / l_reg; asm volatile("s_waitcnt lgkmcnt(0)" ::: "memory");
    float rli[16];
#pragma unroll
    for (int r = 0; r < 16; ++r) rli[r] = li_l[crow(r, hi)];
    if constexpr (ACCUM) {
    int lane_e = lane; asm volatile("" : "+v"(lane_e));
    const int r32e = lane_e & 31, hie = lane_e >> 5;
    char* ot = lds + OT_OFF + wid * OT_WAVE;
    char* otw = ot + hie * (4 * OT_PITCH) + r32e * 2;
#pragma unroll
    for (int r = 0; r < 16; ++r) { const int cr = (r & 3) + 8 * (r >> 2);
#pragma unroll
        for (int d0 = 0; d0 < 4; ++d0) { const float v = o[d0][r] * rli[r]; const float vn = xlane1(v);
            if ((r32e & 1) == 0) *(unsigned*)(otw + cr * OT_PITCH + d0 * 64) = cvtpk(v, vn); } }
    asm volatile("s_waitcnt lgkmcnt(0)" ::: "memory");
    const char* otr = ot + (lane_e >> 4) * OT_PITCH + (lane_e & 15) * 16;
    const unsigned goff = (unsigned)((lane_e >> 4) * OS + (lane_e & 15) * 8);
#pragma unroll
    for (int j = 0; j < 8; ++j) {
        u32x4 w = *(const u32x4*)(otr + j * 4 * OT_PITCH); u32x4* gp = (u32x4*)(Ow + (size_t)(j * 4 * OS) + goff);
        if (ACCUM) { const u32x4 old = oldv[j];
#pragma unroll
            for (int e = 0; e < 4; ++e) w[e] = cvtpk(bf_lo(w[e]) + bf_lo(old[e]), bf_hi(w[e]) + bf_hi(old[e])); }
        *gp = w; }
    } else {
#pragma unroll
        for (int r = 0; r < 16; ++r) { const int orow = crow(r, hi);
#pragma unroll
            for (int d0 = 0; d0 < 4; ++d0) { const float v = o[d0][r] * rli[r]; const float vn = xlane1(v);
                if ((r32 & 1) == 0) *(unsigned*)(Ow + (unsigned)(orow * OS + d0 * 32 + r32)) = cvtpk(v, vn); } }
    }
    __syncthreads();
#undef RESC
#undef KBASE
#undef TILE
#undef SEL
#undef MASKT
#undef SEAM_K0
#undef HALF_STEP
}
#undef ROW
#undef VMWN
#undef SLOAD_H
#undef SWRITE_HK
#undef SWRITE_HV
#undef SWRITE_H

struct AttnPtrs { const bf16* Q; const bf16* K; const bf16* V; bf16* O; const float* aux; const unsigned long long* selm; };
template <int MODE, int KS, bool GQA>
__device__ __forceinline__ BlockRef att_ref(const AttnPtrs& P, int b, int h, int qb) {
    constexpr int TOKB = GQA ? 2 * QBLK : QB;
    BlockRef r; const size_t row0 = (size_t)b * SEQ + (size_t)qb * TOKB;
    r.Q = P.Q + row0 * DM + h * HD; r.O = P.O + row0 * DM + h * HD; r.P0 = qb * TOKB;
    if (MODE == MODE_FOX) { r.K = P.K + (size_t)b * SEQ * KS + h * HD; r.V = P.V + (size_t)b * SEQ * KS + h * HD; r.aux = P.aux + ((size_t)b * NH + h) * SEQ; r.selm = nullptr; }
    else { const int g = h >> 2; r.K = P.K + (size_t)b * SEQ * KS + g * HD; r.V = P.V + (size_t)b * SEQ * KS + g * HD;
           r.aux = P.aux + row0 * 48 + (MODE == MODE_SLC ? 16 : 32) + h; r.selm = MODE == MODE_SLC ? P.selm + ((size_t)b * NG + g) * SEQ + (size_t)qb * TOKB : nullptr; }
    return r;
}
template <int MODE, int KS, bool ACCUM>
__device__ __forceinline__ void attn_phase(char* lds, const AttnPtrs& P, int G, int c) {
    constexpr bool GQA = MODE != MODE_FOX;
    constexpr bool PAIRED = MODE != MODE_WIN; constexpr int W = MODE == MODE_WIN ? 512 : (1 << 20);
    constexpr int NBLK = GQA ? SEQ / 64 : SEQ / QB, NHEADU = GQA ? NG : NH;
    constexpr int PER = PAIRED ? NBLK / 2 : NBLK, total = NB * NHEADU * PER;
    int L = c; if (L >= total) return;
    int pass = 0;
#define DEC(L_, pass_, out) do { const int b_ = (L_) & 7, s_ = (L_) >> 3, hu_ = s_ / PER, x_ = s_ % PER; const int qb_ = PAIRED ? ((pass_) ? NBLK - 1 - x_ : x_) : x_; \
        out = att_ref<MODE, KS, GQA>(P, b_, GQA ? 4 * hu_ : hu_, qb_); } while (0)
    BlockRef cur; DEC(L, 0, cur);
    Seam S;
    att_prime<MODE, DM, KS, GQA>(cur, SEQ, W, lds, S);
    for (;;) {
        const bool more_pass = PAIRED && pass == 0, more_item = L + G < total, last = !more_pass && !more_item;
        int passn = pass + 1, Ln = L;
        if (!more_pass) { passn = 0; Ln = more_item ? L + G : L; }
        BlockRef nxt; if (last) nxt = cur; else DEC(Ln, passn, nxt);
        att_block<MODE, DM, KS, DM, ACCUM, GQA>(cur, nxt, SEQ, W, lds, S);
        if (last) break;
        cur = nxt; pass = passn; L = Ln;
    }
#undef DEC
}
#undef VMW
constexpr int CMP_K_OFF = 4 * SHM_V, CMP_IMP_OFF = 8 * SHM_V, CMP_WS_OFF = CMP_IMP_OFF + 16896, CMP_LDS = CMP_WS_OFF + NW * 256;
template <int T> __device__ __forceinline__ void cmp_mask(f32x16& p0, f32x16& p1, int dq) {
    const float NEG = -__builtin_inff();
#pragma unroll
    for (int r = 0; r < 16; ++r) { const int cc = (r & 3) + 8 * (r >> 2); if (cc > dq) p0[r] = NEG; if (cc + 32 > dq) p1[r] = NEG; }
}
struct CmpPtrs { const bf16* Q; const bf16* CK; const bf16* CV; bf16* O; const float* gates; unsigned long long* selm; };
__device__ __forceinline__ void cmp_stage(char* lds, const CmpPtrs& P, int b, int g, int NT) {
    const int tid = threadIdx.x; char* V_lds = lds; char* K_lds = lds + CMP_K_OFF;
    const int sr = tid >> 4, sc = (tid & 15) * 8, vst0 = v_st(sr, sc), vst1 = v_st(32 + sr, sc), kws = KSWZ(sr, sc * 2);
    const bf16* kp = P.CK + ((size_t)(b * 256) * NG + g) * HD + sc; const bf16* vp = P.CV + ((size_t)(b * 256) * NG + g) * HD + sc;
    bf16x8 k0[4], k1[4], v0[4], v1[4];
#pragma unroll
    for (int T = 0; T < 4; ++T) if (T < NT) { const unsigned o0 = (unsigned)((T * 64 + sr) * NG * HD), o1 = (unsigned)((T * 64 + 32 + sr) * NG * HD);
        k0[T] = load8(kp + o0); k1[T] = load8(kp + o1); v0[T] = load8(vp + o0); v1[T] = load8(vp + o1); }
#pragma unroll
    for (int T = 0; T < 4; ++T) if (T < NT) {
        *(bf16x8*)(K_lds + T * SHM_K + kws) = k0[T]; *(bf16x8*)(K_lds + T * SHM_K + kws + 32 * 256) = k1[T];
        *(bf16x8*)(V_lds + T * SHM_V + vst0) = v0[T]; *(bf16x8*)(V_lds + T * SHM_V + vst1) = v1[T]; }
}
__device__ __forceinline__ void cmp_load_q(const CmpPtrs& P, int b, int g, int tb, int wid, int r32, int hi, bf16x8* qr, float& gate) {
    const int pos = tb * 64 + 8 * wid + (r32 & 7), h = 4 * g + (r32 >> 3);
    const bf16* qp = P.Q + ((size_t)b * SEQ + pos) * DM + h * HD + hi * 8;
#pragma unroll
    for (int d0 = 0; d0 < 8; ++d0) qr[d0] = load8(qp + d0 * 16);
    gate = P.gates[((size_t)b * SEQ + pos) * 48 + h];
}
__device__ __forceinline__ void cmp_unit(char* lds, const CmpPtrs& P, int b, int g, int tb, const bf16x8* qr, float gate) {
    const int tid = threadIdx.x, wid = __builtin_amdgcn_readfirstlane(tid >> 6), lane = tid & 63, r32 = lane & 31, hi = lane >> 5;
    char* V_lds = lds; char* K_lds = lds + CMP_K_OFF; float* imp = (float*)(lds + CMP_IMP_OFF); float* li_l = (float*)(lds + CMP_WS_OFF) + wid * 64;
    const int t0 = tb * 64, tok = 8 * wid + (r32 & 7), pos = t0 + tok;
    const int nkeys = 4 * tb + 3 > 255 ? 255 : 4 * tb + 3, NT = (nkeys + 63) >> 6;
    const bool need_imp = tb >= 16;
    constexpr float C2 = 1.4426950408889634f * SCALE;
    const int cm = (pos - 31) >> 4;
    const int vb0 = (int)(uintptr_t)V_lds + v_rd_base(lane);
    float m_run = -1e30f, l_run = 0.f;
    f32x16 p0, p1;
#define CMP_PASS_A(T) if ((T) < NT) { SBAR(); qkt<T, MODE_WIN>(p0, p1, K_lds, nullptr, r32, hi, qr, 0.f); cmp_mask<T>(p0, p1, cm - 64 * (T) - 4 * hi);                      \
        float pmax = p0[0]; for (int r = 1; r < 16; ++r) pmax = fmaxf(pmax, p0[r]); for (int r = 0; r < 16; ++r) pmax = fmaxf(pmax, p1[r]);                                  \
        { auto rr = __builtin_amdgcn_permlane32_swap(__float_as_uint(pmax), __float_as_uint(pmax), false, false); pmax = fmaxf(__uint_as_float(rr[0]), __uint_as_float(rr[1])); } \
        const float mn = fmaxf(m_run, pmax), so = __builtin_amdgcn_exp2f((m_run - mn) * C2), mnL = -mn * C2; float ps = 0.f;                                                 \
        for (int r = 0; r < 16; ++r) ps += __builtin_amdgcn_exp2f(fmaf(p0[r], C2, mnL)) + __builtin_amdgcn_exp2f(fmaf(p1[r], C2, mnL));                                     \
        l_run = l_run * so + ps; m_run = mn; }
    CMP_PASS_A(0) CMP_PASS_A(1) CMP_PASS_A(2) CMP_PASS_A(3)
#undef CMP_PASS_A
    { auto rr = __builtin_amdgcn_permlane32_swap(__float_as_uint(l_run), __float_as_uint(l_run), false, false); l_run = __uint_as_float(rr[0]) + __uint_as_float(rr[1]); }
    const float inv_l = l_run > 0.f ? 1.0f / l_run : 0.f;
    const float mL = -m_run * C2;
    f32x16 o[4] = {}; float carry = 0.f; bf16x8 pa0, pa1, pa2, pa3;
#define CMP_IMP(P_, T, ph) do { float G_[4], x_[4];                                                                                            \
        for (int i = 0; i < 4; ++i) { G_[i] = (P_[4 * i] + P_[4 * i + 1]) + (P_[4 * i + 2] + P_[4 * i + 3]); x_[i] = xlane32(P_[4 * i + 3]); }  \
        for (int i = 0; i < 4; ++i) { const float ex = hi ? x_[i] : (i ? x_[i > 0 ? i - 1 : 0] : carry); float v = (G_[i] + ex) * inv_l;     \
            v += xlane8(v); v += __shfl_xor(v, 16);                                                                                     \
            if (r32 < 8) imp[(8 * wid + r32) * 65 + 16 * (T) + 8 * (ph) + 2 * i + hi] = v; }                                                  \
        carry = x_[3]; } while (0)
#define CMP_PASS_B(T) if ((T) < NT) { SBAR(); qkt<T, MODE_WIN>(p0, p1, K_lds, nullptr, r32, hi, qr, 0.f); cmp_mask<T>(p0, p1, cm - 64 * (T) - 4 * hi);   \
        for (int r = 0; r < 16; ++r) { p0[r] = __builtin_amdgcn_exp2f(fmaf(p0[r], C2, mL)); p1[r] = __builtin_amdgcn_exp2f(fmaf(p1[r], C2, mL)); }        \
        if (need_imp) { CMP_IMP(p0, T, 0); CMP_IMP(p1, T, 1); }                                                                                         \
        ATT_PK4(p0, 0, pa0); ATT_PK4(p0, 8, pa1); ATT_PK4(p1, 0, pa2); ATT_PK4(p1, 8, pa3); SBAR();                                                     \
        pv_tile<T>(o, vb0, pa0, pa1, pa2, pa3); }
    CMP_PASS_B(0) CMP_PASS_B(1) CMP_PASS_B(2) CMP_PASS_B(3)
#undef CMP_PASS_B
#undef CMP_IMP
    if (hi == 0) li_l[r32] = gate * inv_l; asm volatile("s_waitcnt lgkmcnt(0)" ::: "memory");
    float rli[16];
#pragma unroll
    for (int r = 0; r < 16; ++r) rli[r] = li_l[crow(r, hi)];
#pragma unroll
    for (int r = 0; r < 16; ++r) { const int rho = crow(r, hi); bf16* orow = P.O + ((size_t)b * SEQ + t0 + 8 * wid + (rho & 7)) * DM + (4 * g + (rho >> 3)) * HD;
#pragma unroll
        for (int d0 = 0; d0 < 4; ++d0) { const float v = o[d0][r] * rli[r]; const float vn = xlane1(v);
            if ((r32 & 1) == 0) *(unsigned*)(orow + d0 * 32 + r32) = cvtpk(v, vn); } }
    asm volatile("s_waitcnt lgkmcnt(0)" ::: "memory");
    const int jq = tb;
#pragma unroll 1
    for (int k = 0; k < 8; k += 2) {
        unsigned long long mask0, mask1;
        if (!need_imp) { mask0 = (1ull << (jq + 1)) - 1ull; mask1 = mask0; }
        else {
            const int n = lane; unsigned key0 = 0u, key1 = 0u;
            if (n <= jq) { const float bonus = (n == 0 || n == jq || n == jq - 1) ? 1000.0f : 0.0f;
                key0 = __float_as_uint(imp[(8 * wid + k) * 65 + n] + bonus) + 1u; key1 = __float_as_uint(imp[(8 * wid + k + 1) * 65 + n] + bonus) + 1u; }
            unsigned T0 = 0u, T1 = 0u;
#pragma unroll 1
            for (int bit = 31; bit >= 0; --bit) { const unsigned c0 = T0 | (1u << bit), c1 = T1 | (1u << bit);
                const unsigned long long b0 = __ballot(key0 >= c0), b1 = __ballot(key1 >= c1);
                if (__popcll(b0) >= 16) T0 = c0; if (__popcll(b1) >= 16) T1 = c1; }
            const unsigned long long lt = (1ull << lane) - 1ull;
            { const unsigned long long gt = __ballot(key0 > T0), eq = __ballot(key0 == T0); const int need = 16 - __popcll(gt); mask0 = __ballot(key0 > T0 || (key0 == T0 && __popcll(eq & lt) < need)); }
            { const unsigned long long gt = __ballot(key1 > T1), eq = __ballot(key1 == T1); const int need = 16 - __popcll(gt); mask1 = __ballot(key1 > T1 || (key1 == T1 && __popcll(eq & lt) < need)); }
        }
        if (lane == 0) { unsigned long long* sp = P.selm + ((size_t)b * NG + g) * SEQ + t0 + 8 * wid + k; sp[0] = mask0; sp[1] = mask1; }
    }
}
__device__ __forceinline__ void cmp_phase(char* lds, const CmpPtrs& P, int G, int c) {
    const int tid = threadIdx.x, wid = __builtin_amdgcn_readfirstlane(tid >> 6), lane = tid & 63, r32 = lane & 31, hi = lane >> 5;
#pragma unroll 1
    for (int L = c; L < NB * NG * 8; L += G) {
        const int b = L & 7, k = L >> 3, g = k & 3, j = (k >> 2) & 7;
        cmp_stage(lds, P, b, g, 4);
        bf16x8 qa[8], qb[8]; float ga, gb;
        cmp_load_q(P, b, g, j, wid, r32, hi, qa, ga);
        __syncthreads();
#define CMP_TB(u) (16 * ((u) >> 1) + (((u) & 1) ? 15 - j : j))
#pragma unroll 1
        for (int u = 0; u < 8; ++u) {
            if (u + 1 < 8) cmp_load_q(P, b, g, CMP_TB(u + 1), wid, r32, hi, qb, gb);
            cmp_unit(lds, P, b, g, CMP_TB(u), qa, ga);
#pragma unroll
            for (int d0 = 0; d0 < 8; ++d0) qa[d0] = qb[d0];
            ga = gb;
        }
#undef CMP_TB
        __syncthreads();
    }
}
}

constexpr size_t MiB = 1u << 20;
constexpr size_t WS_CTL = 0, CTL_ZERO_BYTES = 1 * MiB;
constexpr size_t WS_COS = 1 * MiB, WS_SIN = WS_COS + 256 * 1024;
constexpr size_t WS_PT = WS_SIN + 256 * 1024;
constexpr size_t WS_W2C = WS_PT + 64 * 1024;
constexpr size_t WS_RS = 3 * MiB;
constexpr size_t WS_RTE = 2 * MiB, WS_RTW = WS_RTE + 128 * 1024, WS_SLOT = WS_RTW + 256 * 1024;
constexpr size_t WS_WNSA = 4 * MiB, WS_WCMP1 = 25 * MiB, WS_WNO = 29 * MiB, WS_WFGU = 37 * MiB, WS_WFD = 81 * MiB, WS_WFOX = 103 * MiB, WS_WFO = 128 * MiB, WS_WMGU = 136 * MiB, WS_WMD = 360 * MiB;
constexpr size_t WS_HN = 472 * MiB, WS_HN8 = 472 * MiB;
constexpr size_t WS_Q = 600 * MiB, WS_KV = 728 * MiB, WS_GATES = 920 * MiB, WS_UV = 926 * MiB, WS_CK = 958 * MiB, WS_CV = 960 * MiB, WS_SELM = 962 * MiB;
constexpr size_t WS_O = 1096 * MiB, WS_MIX = 1224 * MiB;
constexpr size_t WS_ACT = 600 * MiB;
constexpr size_t WS_FQKV = 600 * MiB, WS_FL = 984 * MiB, WS_CS = 986 * MiB, WS_TOT = 988 * MiB;
constexpr size_t WS_XG = 600 * MiB, WS_H = 732 * MiB, WS_Y = 1194 * MiB, WS_XR = 1458 * MiB, WS_END = 1586 * MiB;
constexpr int MOE_MAX_TILES = 264, MOE_NCHUNK = 1;
constexpr float XG_SCALE = 16.f, H_SCALE = 8.f, W8_SCALE = 256.f;
constexpr int CW_BAR = 4096;
constexpr int CW_CNT = 64, CW_CWG = 1024;

constexpr int LDS_BYTES = 155648;
constexpr int LDSCTL_OFF = LDS_BYTES - 256;
constexpr int NWAVES = 8;

template <int CTRL, int ROWMASK> __device__ __forceinline__ float dpp_add(float v) {
    return v + __int_as_float(__builtin_amdgcn_update_dpp(0, __float_as_int(v), CTRL, ROWMASK, 0xF, false)); }
__device__ __forceinline__ float wave_sum(float v) {
    v = dpp_add<0xB1, 0xF>(v);
    v = dpp_add<0x4E, 0xF>(v);
    v = dpp_add<0x141, 0xF>(v);
    v = dpp_add<0x140, 0xF>(v);
    v = dpp_add<0x142, 0xA>(v);
    v = dpp_add<0x143, 0xC>(v);
    return __int_as_float(__builtin_amdgcn_readlane(__float_as_int(v), 63));
}
__device__ __forceinline__ float bfu_lo(unsigned w) { return __uint_as_float(w << 16); }
__device__ __forceinline__ float bfu_hi(unsigned w) { return __uint_as_float(w & 0xffff0000u); }
__device__ __forceinline__ void tr_item(const float* W, size_t ldw, int K, bf16* WT, size_t dst_row0, int k0, int n0, LAS float* scr, int lane, const float* gain = nullptr) {
    const int cq = lane & 15, rq = lane >> 4;
    f32x4 tv[16];
#pragma unroll
    for (int i = 0; i < 16; ++i) tv[i] = __builtin_nontemporal_load((const GAS f32x4*)(W + (size_t)(k0 + 4 * i + rq) * ldw + n0 + 4 * cq));
#pragma unroll
    for (int i = 0; i < 16; ++i) { const int kk = 4 * i + rq; f32x4 v = tv[i]; if (gain) v *= gain[k0 + kk];
        LAS float* s = scr + kk * 65 + 4 * cq; s[0] = v.x; s[1] = v.y; s[2] = v.z; s[3] = v.w; }
    LDS_WAIT(); asm volatile("" ::: "memory");
    const int c = lane & 7;
#pragma unroll
    for (int j = 0; j < 8; ++j) { const int n = (lane >> 3) + 8 * j; const LAS float* s = scr + (8 * c) * 65 + n;
        v4u o; o.x = pk2(s[0], s[65]); o.y = pk2(s[130], s[195]); o.z = pk2(s[260], s[325]); o.w = pk2(s[390], s[455]);
        *(GAS v4u*)(WT + (dst_row0 + n) * (size_t)K + k0 + 8 * c) = o; }
    LDS_WAIT(); asm volatile("" ::: "memory");
}
__device__ __forceinline__ void tr_item_f8(const float* W, size_t ldw, int K, unsigned char* WT, size_t dst_row0, int k0, int n0, LAS float* scr, int lane) {
    const int cq = lane & 7, rq = lane >> 3;
    f32x4 tv[16];
#pragma unroll
    for (int i = 0; i < 16; ++i) tv[i] = __builtin_nontemporal_load((const GAS f32x4*)(W + (size_t)(k0 + 8 * i + rq) * ldw + n0 + 4 * cq));
#pragma unroll
    for (int i = 0; i < 16; ++i) { const int kk = 8 * i + rq; const f32x4 v = tv[i];
        LAS float* s = scr + kk * 33 + 4 * cq; s[0] = v.x * W8_SCALE; s[1] = v.y * W8_SCALE; s[2] = v.z * W8_SCALE; s[3] = v.w * W8_SCALE; }
    LDS_WAIT(); asm volatile("" ::: "memory");
    const int c = lane & 7;
#pragma unroll
    for (int j = 0; j < 4; ++j) { const int n = (lane >> 3) + 8 * j; const LAS float* s = scr + (16 * c) * 33 + n;
        v4u o; o.x = pg8::pk4_fp8(s[0], s[33], s[66], s[99]); o.y = pg8::pk4_fp8(s[132], s[165], s[198], s[231]); o.z = pg8::pk4_fp8(s[264], s[297], s[330], s[363]); o.w = pg8::pk4_fp8(s[396], s[429], s[462], s[495]);
        *(GAS v4u*)(WT + (dst_row0 + n) * (size_t)K + k0 + 16 * c) = o; }
    LDS_WAIT(); asm volatile("" ::: "memory");
}
struct TrJob { const float* W; size_t ldw; int K, N; bf16* WT; int grp, gstride, roff; int f8; const float* gain; };
__device__ __forceinline__ int tr_items(const TrJob& j) { return (j.K / 64) * (j.N / 64); }
__device__ __forceinline__ void tr_run(const TrJob& j, int it, LAS float* scr, int lane) {
    if (j.f8) { const int nb = j.N / 32, kb = it / nb, n0 = (it % nb) * 32; const size_t r0 = (size_t)(n0 / j.grp) * j.gstride + (n0 % j.grp) + j.roff;
        tr_item_f8(j.W, j.ldw, j.K, (unsigned char*)j.WT, r0, kb * 128, n0, scr, lane); return; }
    const int nb = j.N / 64, kb = it / nb, n0 = (it % nb) * 64;
    const size_t r0 = (size_t)(n0 / j.grp) * j.gstride + (n0 % j.grp) + j.roff;
    tr_item(j.W, j.ldw, j.K, j.WT, r0, kb * 64, n0, scr, lane, j.gain);
}
__device__ __forceinline__ float gelu_tanh(float x) {
    const float u = 0.7978845608028654f * (x + 0.044715f * x * x * x);
    const float e = __builtin_amdgcn_exp2f(-2.0f * 1.4426950408889634f * u);
    const float th = (1.0f - e) * __builtin_amdgcn_rcpf(1.0f + e);
    return 0.5f * x * (1.0f + th);
}

enum Phase { PH_PRO = 0, PH_NSA_IN, PH_CMP1, PH_CMP2, PH_ATT_CMP, PH_ATT_SLC, PH_ATT_WIN, PH_NSA_OUT, PH_NORM_A, PH_FFN_GU, PH_FFN_DN, PH_NORM_B, PH_FOX_IN, PH_FOX_SCAN, PH_FOX_ATT, PH_FOX_OUT,
             PH_NORM_C, PH_MOE_DISP, PH_MOE0, PH_FINAL = PH_MOE0 + 2 * MOE_NCHUNK, PH_COUNT };
struct Args { const float* in[20]; float* out; unsigned char* ws; int ph_lo, ph_hi; };

typedef unsigned u32x2 __attribute__((ext_vector_type(2)));
struct Row8 { f32x4 v[8]; };
__device__ __forceinline__ Row8 ld_row_f32(const float* p, int lane) { Row8 r; const GAS f32x4* q = (const GAS f32x4*)p + lane;
#pragma unroll
    for (int j = 0; j < 8; ++j) r.v[j] = q[64 * j]; return r; }
__device__ __forceinline__ Row8 ld_row_bf16(const bf16* p, int lane) { Row8 r; const GAS u32x2* q = (const GAS u32x2*)p + lane;
#pragma unroll
    for (int j = 0; j < 8; ++j) { const u32x2 w = q[64 * j]; r.v[j] = (f32x4){bfu_lo(w.x), bfu_hi(w.x), bfu_lo(w.y), bfu_hi(w.y)}; } return r; }
__device__ __forceinline__ void st_row_f32(float* p, int lane, const Row8& r) { GAS f32x4* q = (GAS f32x4*)p + lane;
#pragma unroll
    for (int j = 0; j < 8; ++j) q[64 * j] = r.v[j]; }
__device__ __forceinline__ void st_row_bf16(bf16* p, int lane, const Row8& r) { GAS u32x2* q = (GAS u32x2*)p + lane;
#pragma unroll
    for (int j = 0; j < 8; ++j) { u32x2 w; w.x = pk2(r.v[j].x, r.v[j].y); w.y = pk2(r.v[j].z, r.v[j].w); q[64 * j] = w; } }
__device__ __forceinline__ Row8 ld_row_f32_nt(const float* p, int lane) { Row8 r; const GAS f32x4* q = (const GAS f32x4*)p + lane;
#pragma unroll
    for (int j = 0; j < 8; ++j) r.v[j] = __builtin_nontemporal_load(q + 64 * j); return r; }
__device__ __forceinline__ Row8 ld_row_bf16_nt(const bf16* p, int lane) { Row8 r; const GAS u32x2* q = (const GAS u32x2*)p + lane;
#pragma unroll
    for (int j = 0; j < 8; ++j) { const u32x2 w = __builtin_nontemporal_load(q + 64 * j); r.v[j] = (f32x4){bfu_lo(w.x), bfu_hi(w.x), bfu_lo(w.y), bfu_hi(w.y)}; } return r; }
__device__ __forceinline__ void st_row_f32_nt(float* p, int lane, const Row8& r) { GAS f32x4* q = (GAS f32x4*)p + lane;
#pragma unroll
    for (int j = 0; j < 8; ++j) __builtin_nontemporal_store(r.v[j], q + 64 * j); }
__device__ __forceinline__ void st_row_bf16_nt(bf16* p, int lane, const Row8& r) { GAS u32x2* q = (GAS u32x2*)p + lane;
#pragma unroll
    for (int j = 0; j < 8; ++j) { u32x2 w; w.x = pk2(r.v[j].x, r.v[j].y); w.y = pk2(r.v[j].z, r.v[j].w); __builtin_nontemporal_store(w, q + 64 * j); } }
__device__ __forceinline__ float row_rs(const Row8& r) { float s = 0.f;
#pragma unroll
    for (int j = 0; j < 8; ++j) s += (r.v[j].x * r.v[j].x + r.v[j].y * r.v[j].y) + (r.v[j].z * r.v[j].z + r.v[j].w * r.v[j].w);
    return 1.0f / sqrtf(wave_sum(s) * (1.0f / DM) + RMS_EPS); }

__global__ void __launch_bounds__(NWAVES * 64, 2) mk_fwd(Args args) {
    extern __shared__ __attribute__((aligned(1024))) unsigned char lds[];
    LAS unsigned char* ldsl = (LAS unsigned char*)lds;
    volatile LAS unsigned* LCTL = (volatile LAS unsigned*)(ldsl + LDSCTL_OFF);
    const int tid = threadIdx.x, lane = tid & 63, wave = __builtin_amdgcn_readfirstlane(tid >> 6);
    const int G = gridDim.x, bx = blockIdx.x;
    const int gw = bx * NWAVES + wave, NGW = G * NWAVES;
    unsigned char* ws = args.ws;
    gu32* ctl = (gu32*)(ws + WS_CTL);
    if (tid < 64) LCTL[tid] = 0u;
    __syncthreads();
    XcdBarrier bar; bar.bar = (unsigned*)ctl + CW_BAR; bar.x = 0; bar.st = nullptr;
    if (MK_N_LAUNCHES == 1) bar = xcd_barrier_post((unsigned*)ctl + CW_BAR, LCTL);
    const int lo = args.ph_lo, hi = args.ph_hi;
#ifdef MK_ONLY
#define IN(k) ((k) == MK_ONLY && lo <= (k) && (k) < hi)
#elif defined(MK_SKIP)
#define IN(k) ((k) != MK_SKIP && lo <= (k) && (k) < hi)
#else
#define IN(k) (lo <= (k) && (k) < hi)
#endif
#ifdef MK_PROBE_MASK
    unsigned long long pr_last = rt(), pr_acc = 0ull;
#define SEAM(k) do { if (IN(k) && IN((k) + 1)) xcd_barrier(bar); { const unsigned long long t_ = rt(); if ((MK_PROBE_MASK >> (k)) & 1ull) pr_acc += t_ - pr_last; pr_last = t_; } } while (0)
#else
#define SEAM(k) do { if (IN(k) && IN((k) + 1)) xcd_barrier(bar); } while (0)
#endif

    const float* x_in = args.in[0]; const float* ln_g = args.in[1];
    float* xout = args.out; bf16* XR = (bf16*)(ws + WS_XR);
    bf16* HN = (bf16*)(ws + WS_HN); bf16* OB = (bf16*)(ws + WS_O); bf16* MIX = (bf16*)(ws + WS_MIX);
    float* cosT = (float*)(ws + WS_COS); float* sinT = (float*)(ws + WS_SIN); float* PT = (float*)(ws + WS_PT); bf16* W2C = (bf16*)(ws + WS_W2C);
    unsigned* RTE = (unsigned*)(ws + WS_RTE); float2* RTW = (float2*)(ws + WS_RTW); int2* SLOT = (int2*)(ws + WS_SLOT);

    if (IN(PH_PRO)) {
        LAS float* scr = (LAS float*)(ldsl + wave * 16896);
        int it0 = gw;
#define RUN_JOB(job) do { const TrJob j_ = (job); const int n_ = tr_items(j_); for (; it0 < n_; it0 += NGW) tr_run(j_, it0, scr, lane); it0 -= n_; } while (0)
        RUN_JOB((TrJob{args.in[2], NSA_NV, DM, 5120, (bf16*)(ws + WS_WNSA), 1 << 30, 0, 0, 0}));
        RUN_JOB((TrJob{args.in[5], 256, DM, 256, (bf16*)(ws + WS_WCMP1), 1 << 30, 0, 0, 0}));
        RUN_JOB((TrJob{args.in[5] + (size_t)2048 * 256, 256, DM, 256, (bf16*)(ws + WS_WCMP1), 1 << 30, 0, 256, 0}));
        RUN_JOB((TrJob{args.in[7], 256, DM, 256, (bf16*)(ws + WS_WCMP1), 1 << 30, 0, 512, 0}));
        RUN_JOB((TrJob{args.in[7] + (size_t)2048 * 256, 256, DM, 256, (bf16*)(ws + WS_WCMP1), 1 << 30, 0, 768, 0}));
        RUN_JOB((TrJob{args.in[6], 128, 256, 128, W2C, 1 << 30, 0, 0, 0}));
        RUN_JOB((TrJob{args.in[8], 128, 256, 128, W2C + 128 * 256, 1 << 30, 0, 0, 0}));
        RUN_JOB((TrJob{args.in[9], DM, DM, DM, (bf16*)(ws + WS_WNO), 1 << 30, 0, 0, 0}));
        RUN_JOB((TrJob{args.in[13], FFD, DM, FFD, (bf16*)(ws + WS_WFGU), 128, 256, 0, 0, ln_g + 2 * DM}));
        RUN_JOB((TrJob{args.in[14], FFD, DM, FFD, (bf16*)(ws + WS_WFGU), 128, 256, 128, 0, ln_g + 2 * DM}));
        RUN_JOB((TrJob{args.in[15], DM, FFD, DM, (bf16*)(ws + WS_WFD), 1 << 30, 0, 0, 0}));
        RUN_JOB((TrJob{args.in[10], FOX_NV, DM, 6144, (bf16*)(ws + WS_WFOX), 1 << 30, 0, 0, 0, ln_g + 4 * DM}));
        RUN_JOB((TrJob{args.in[12], DM, DM, DM, (bf16*)(ws + WS_WFO), 1 << 30, 0, 0, 0}));
        for (int e = 0; e < NE; ++e) {
            RUN_JOB((TrJob{args.in[17] + (size_t)e * DM * FFE, FFE, DM, FFE, (bf16*)(ws + WS_WMGU + (size_t)e * 2 * FFE * DM), 128, 256, 0, 1}));
            RUN_JOB((TrJob{args.in[18] + (size_t)e * DM * FFE, FFE, DM, FFE, (bf16*)(ws + WS_WMGU + (size_t)e * 2 * FFE * DM), 128, 256, 128, 1}));
            RUN_JOB((TrJob{args.in[19] + (size_t)e * FFE * DM, DM, FFE, DM, (bf16*)(ws + WS_WMD + (size_t)e * DM * FFE), 1 << 30, 0, 0, 1}));
        }
#undef RUN_JOB
        const int gt = bx * (NWAVES * 64) + tid, NGT = G * NWAVES * 64;
        for (int i = gt; i < 48 * DM; i += NGT) { const int j = i / DM, k = i % DM; ((bf16*)(ws + WS_WNSA))[(size_t)(5120 + j) * DM + k] = (bf16)f2bf(args.in[2][(size_t)k * NSA_NV + 5120 + j]); }
        for (int i = gt; i < 16 * DM; i += NGT) { const int j = i / DM, k = i % DM; ((bf16*)(ws + WS_WFOX))[(size_t)(6144 + j) * DM + k] = (bf16)f2bf(args.in[10][(size_t)k * FOX_NV + 6144 + j] * ln_g[4 * DM + k]); }
        for (int i = gt; i < SEQ * 16; i += NGT) { const int pos = i >> 4, k = i & 15;
            const double inv = exp2(-(double)k * (18.931568569324174 / 16.0));
            double a = (double)pos * inv; a -= 6.283185307179586476925 * rint(a * 0.15915494309189533577);
            cosT[i] = cosf((float)a); sinT[i] = sinf((float)a); }
        for (int t = gw; t < 64; t += NGW) { const int kv = t >> 5, part = (t >> 2) & 7, hb = t & 3; const float* pos = args.in[kv ? 4 : 3]; const float* w1 = args.in[kv ? 7 : 5];
            float acc = 0.f; for (int k = part * 512; k < part * 512 + 512; ++k) acc = fmaf(pos[k], w1[(size_t)k * 256 + hb * 64 + lane], acc);
            PT[(kv * 8 + part) * 256 + hb * 64 + lane] = acc; }
        { const Row8 g0 = ld_row_f32(ln_g, lane);
          int m = gw; Row8 r; if (m < MTOK) r = ld_row_f32_nt(x_in + (size_t)m * DM, lane);
          for (; m < MTOK; m += NGW) { const int m2 = m + NGW; Row8 rn = r; if (m2 < MTOK) rn = ld_row_f32_nt(x_in + (size_t)m2 * DM, lane);
              const float rs = row_rs(r);
#pragma unroll
              for (int j = 0; j < 8; ++j) r.v[j] = r.v[j] * rs * g0.v[j];
              st_row_bf16(HN + (size_t)m * DM, lane, r); r = rn; } }
    }
    SEAM(PH_PRO);

    if (IN(PH_NSA_IN)) {
        pg8::Gemm g{(const pg8::bf16_t*)HN, (const pg8::bf16_t*)(ws + WS_WNSA), MTOK, 5120, DM}; pg8::StaticOrder S; S.init(MTOK, 5120, G, bx);
        pg8::EpiNsaIn E{(pg8::bf16_t*)(ws + WS_Q), (pg8::bf16_t*)(ws + WS_KV), (float*)(ws + WS_GATES), cosT, sinT};
        pg8::gemm_phase<pg8::EpiNsaIn, pg8::StaticOrder, true, true>(ldsl, g, S, E);
    }
    SEAM(PH_NSA_IN);

    if (IN(PH_CMP1)) {
        static_assert(WS_KV % MiB == 0 && WS_WCMP1 % MiB == 0 && WS_HN % MiB == 0 && WS_WNSA % MiB == 0, "absolute 1 MiB tile indices");
        pg8::Gemm g{(const pg8::bf16_t*)ws, (const pg8::bf16_t*)ws, 0, 0, DM};
        pg8::CmpGateOrder S{G, bx, (int)(WS_KV / MiB), (int)(WS_WCMP1 / MiB), (int)(WS_HN / MiB), (int)(WS_WNSA / MiB) + 20};
        pg8::EpiCmpGates E{(float*)(ws + WS_UV), 512, (float*)(ws + WS_GATES)};
        pg8::gemm_phase<pg8::EpiCmpGates, pg8::CmpGateOrder, false, true>(ldsl, g, S, E);
    }
    SEAM(PH_CMP1);

    if (IN(PH_CMP2)) {
        typedef float f32x4v __attribute__((ext_vector_type(4)));
        const float* UV = (const float*)(ws + WS_UV);
        for (int t = gw; t < 2 * NB * NG * 16; t += NGW) {
            const int kv = t >> 9, b = (t >> 6) & 7, g = (t >> 4) & 3, i0 = (t & 15) * 16;
            const int fr = lane & 15, fq = lane >> 4, i = i0 + fr;
            const bool valid = i < 255;
            const float* urow = UV + ((size_t)kv * 8192 + ((size_t)(b * 256 + i) * NG + g)) * 512;
            const float* vrow = UV + ((size_t)kv * 8192 + ((size_t)(b * 256 + (valid ? i + 1 : i)) * NG + g)) * 512 + 256;
            f32x4 acc[8];
#pragma unroll
            for (int n = 0; n < 8; ++n) acc[n] = (f32x4){0.f, 0.f, 0.f, 0.f};
            const bf16* w2 = W2C + (size_t)kv * 128 * 256;
#pragma unroll 2
            for (int ks = 0; ks < 8; ++ks) { const int h0 = 32 * ks + 8 * fq;
                float hv[8];
#pragma unroll
                for (int q = 0; q < 2; ++q) { const f32x4 a = *(const GAS f32x4*)(urow + h0 + 4 * q), c = *(const GAS f32x4*)(vrow + h0 + 4 * q);
                    f32x4 p = (f32x4){0.f, 0.f, 0.f, 0.f};
#pragma unroll
                    for (int pt = 0; pt < 8; ++pt) p += *(const GAS f32x4*)(PT + (kv * 8 + pt) * 256 + h0 + 4 * q);
#pragma unroll
                    for (int e = 0; e < 4; ++e) hv[4 * q + e] = gelu_tanh(a[e] + c[e] + p[e]); }
                v4u aw; aw.x = pk2(hv[0], hv[1]); aw.y = pk2(hv[2], hv[3]); aw.z = pk2(hv[4], hv[5]); aw.w = pk2(hv[6], hv[7]);
                const bf16x8 af = __builtin_bit_cast(bf16x8, aw);
#pragma unroll
                for (int n = 0; n < 8; ++n) { const bf16x8 bfr = *(const GAS bf16x8*)(w2 + (size_t)(16 * n + fr) * 256 + h0);
                    acc[n] = __builtin_amdgcn_mfma_f32_16x16x32_bf16(af, bfr, acc[n], 0, 0, 0); } }
            bf16* outp = (bf16*)(ws + (kv ? WS_CV : WS_CK));
#pragma unroll
            for (int n = 0; n < 8; ++n)
#pragma unroll
                for (int r = 0; r < 4; ++r) { const int ii = i0 + 4 * fq + r; outp[((size_t)(b * 256 + ii) * NG + g) * HD + 16 * n + fr] = (bf16)(ii < 255 ? f2bf(acc[n][r]) : 0u); }
        }
    }
    SEAM(PH_CMP2);

    if (IN(PH_ATT_CMP)) {
        att::CmpPtrs P{(const att::bf16*)(ws + WS_Q), (const att::bf16*)(ws + WS_CK), (const att::bf16*)(ws + WS_CV), (att::bf16*)OB, (const float*)(ws + WS_GATES), (unsigned long long*)(ws + WS_SELM)};
        att::cmp_phase((char*)lds, P, G, bx);
    }
    SEAM(PH_ATT_CMP);
    if (IN(PH_ATT_SLC)) {
        att::AttnPtrs P{(const att::bf16*)(ws + WS_Q), (const att::bf16*)(ws + WS_KV) + (size_t)2 * MTOK * 512, (const att::bf16*)(ws + WS_KV) + (size_t)3 * MTOK * 512, (att::bf16*)OB,
                        (const float*)(ws + WS_GATES), (const unsigned long long*)(ws + WS_SELM)};
        att::attn_phase<att::MODE_SLC, 512, true>((char*)lds, P, G, bx);
    }
    SEAM(PH_ATT_SLC);
    if (IN(PH_ATT_WIN)) {
        att::AttnPtrs P{(const att::bf16*)(ws + WS_Q), (const att::bf16*)(ws + WS_KV) + (size_t)4 * MTOK * 512, (const att::bf16*)(ws + WS_KV) + (size_t)5 * MTOK * 512, (att::bf16*)OB,
                        (const float*)(ws + WS_GATES), nullptr};
        att::attn_phase<att::MODE_WIN, 512, true>((char*)lds, P, G, bx);
    }
    SEAM(PH_ATT_WIN);

    if (IN(PH_NSA_OUT)) {
        pg8::Gemm g{(const pg8::bf16_t*)OB, (const pg8::bf16_t*)(ws + WS_WNO), MTOK, DM, DM}; pg8::StaticOrder S; S.init(MTOK, DM, G, bx);
        pg8::EpiBf16Plain E{(pg8::bf16_t*)MIX, DM};
        pg8::gemm_phase<pg8::EpiBf16Plain, pg8::StaticOrder, true, true>(ldsl, g, S, E);
    }
    SEAM(PH_NSA_OUT);

#define NORM_AB(LDX, gpost) do { const Row8 ga = ld_row_f32(gpost, lane); float* RS = (float*)(ws + WS_RS);                        \
        int m = gw; Row8 y, xr; if (m < MTOK) { y = ld_row_bf16_nt(MIX + (size_t)m * DM, lane); xr = LDX(m); }                    \
        for (; m < MTOK; m += NGW) { const int m2 = m + NGW; Row8 yn = y, xn = xr;                                               \
            if (m2 < MTOK) { yn = ld_row_bf16_nt(MIX + (size_t)m2 * DM, lane); xn = LDX(m2); }                                   \
            const float rs = row_rs(y);                                                                                           \
            _Pragma("unroll") for (int j = 0; j < 8; ++j) xr.v[j] = xr.v[j] + y.v[j] * rs * ga.v[j];                              \
            st_row_bf16(XR + (size_t)m * DM, lane, xr); const float rs2 = row_rs(xr);                                             \
            if (lane == 0) RS[m] = rs2; y = yn; xr = xn; } } while (0)
#define LDX_A(mm) ld_row_f32_nt(x_in + (size_t)(mm) * DM, lane)
#define LDX_B(mm) ld_row_bf16_nt(XR + (size_t)(mm) * DM, lane)
    if (IN(PH_NORM_A)) NORM_AB(LDX_A, ln_g + 1 * DM);
    SEAM(PH_NORM_A);

    if (IN(PH_FFN_GU)) {
        pg8::Gemm g{(const pg8::bf16_t*)XR, (const pg8::bf16_t*)(ws + WS_WFGU), MTOK, 2 * FFD, DM}; pg8::StaticOrder S; S.init(MTOK, 2 * FFD, G, bx);
        pg8::EpiSwiGLU E{(pg8::bf16_t*)(ws + WS_ACT), FFD, (const float*)(ws + WS_RS)};
        pg8::gemm_phase<pg8::EpiSwiGLU, pg8::StaticOrder, true, true>(ldsl, g, S, E);
    }
    SEAM(PH_FFN_GU);
    if (IN(PH_FFN_DN)) {
        pg8::Gemm g{(const pg8::bf16_t*)(ws + WS_ACT), (const pg8::bf16_t*)(ws + WS_WFD), MTOK, DM, FFD}; pg8::StaticOrder S; S.init(MTOK, DM, G, bx);
        pg8::EpiBf16Plain E{(pg8::bf16_t*)MIX, DM};
        pg8::gemm_phase<pg8::EpiBf16Plain, pg8::StaticOrder, true, true>(ldsl, g, S, E);
    }
    SEAM(PH_FFN_DN);
    if (IN(PH_NORM_B)) NORM_AB(LDX_B, ln_g + 3 * DM);
    SEAM(PH_NORM_B);

    if (IN(PH_FOX_IN)) {
        pg8::Gemm g{(const pg8::bf16_t*)XR, (const pg8::bf16_t*)(ws + WS_WFOX), MTOK, FOX_N, DM}; pg8::StaticOrder S; S.init(MTOK, FOX_N, G, bx);
        pg8::EpiFoxIn E{(pg8::bf16_t*)(ws + WS_FQKV), (float*)(ws + WS_FL), (float*)(ws + WS_TOT), args.in[11], (const float*)(ws + WS_RS)};
        pg8::gemm_phase<pg8::EpiFoxIn, pg8::StaticOrder, true, true>(ldsl, g, S, E);
    }
    SEAM(PH_FOX_IN);
    if (IN(PH_FOX_SCAN)) {
        const float* FL = (const float*)(ws + WS_FL); const float* TOT = (const float*)(ws + WS_TOT); float* CS = (float*)(ws + WS_CS);
        for (int t = gw; t < NB * 64; t += NGW) { const int b = t >> 6, c = t & 63;
            const GAS f32x4* src = (const GAS f32x4*)(FL + ((size_t)b * SEQ + c * 64 + lane) * 16); const GAS f32x4* tp = (const GAS f32x4*)(TOT + ((size_t)b * 64 + lane) * 16);
            f32x4 ls[4], tt[4];
#pragma unroll
            for (int q = 0; q < 4; ++q) { ls[q] = src[q]; tt[q] = tp[q]; }
#pragma unroll
            for (int q = 0; q < 4; ++q)
#pragma unroll
                for (int j = 0; j < 4; ++j) { const int h = 4 * q + j; const float pre = wave_sum(lane < c ? tt[q][j] : 0.f); float v = ls[q][j];
#pragma unroll
                    for (int o = 1; o < 64; o <<= 1) { const float n = __shfl_up(v, o); if (lane >= o) v += n; }
                    CS[((size_t)b * NH + h) * SEQ + c * 64 + lane] = (v + pre) * 11.313708498984761f; }
        }
    }
    SEAM(PH_FOX_SCAN);
    if (IN(PH_FOX_ATT)) {
        att::AttnPtrs P{(const att::bf16*)(ws + WS_FQKV), (const att::bf16*)(ws + WS_FQKV) + (size_t)MTOK * DM, (const att::bf16*)(ws + WS_FQKV) + (size_t)2 * MTOK * DM, (att::bf16*)OB,
                        (const float*)(ws + WS_CS), nullptr};
        att::attn_phase<att::MODE_FOX, DM, false>((char*)lds, P, G, bx);
    }
    SEAM(PH_FOX_ATT);
    if (IN(PH_FOX_OUT)) {
        pg8::Gemm g{(const pg8::bf16_t*)OB, (const pg8::bf16_t*)(ws + WS_WFO), MTOK, DM, DM}; pg8::StaticOrder S; S.init(MTOK, DM, G, bx);
        pg8::EpiBf16Plain E{(pg8::bf16_t*)MIX, DM};
        pg8::gemm_phase<pg8::EpiBf16Plain, pg8::StaticOrder, true, true>(ldsl, g, S, E);
    }
    SEAM(PH_FOX_OUT);

    if (IN(PH_NORM_C)) {
        LAS float* wrt = (LAS float*)ldsl;
        const float* wr = args.in[16];
        for (int i = tid; i < DM * NE; i += NWAVES * 64) wrt[(i & 7) * DM + (i >> 3)] = wr[i];
        __syncthreads();
        const Row8 ga = ld_row_f32(ln_g + 5 * DM, lane), gb = ld_row_f32(ln_g + 6 * DM, lane);
        int m = gw; Row8 y, xr; if (m < MTOK) { y = ld_row_bf16_nt(MIX + (size_t)m * DM, lane); xr = ld_row_bf16_nt(XR + (size_t)m * DM, lane); }
        for (; m < MTOK; m += NGW) { const int m2 = m + NGW; Row8 yn = y, xn = xr;
            if (m2 < MTOK) { yn = ld_row_bf16_nt(MIX + (size_t)m2 * DM, lane); xn = ld_row_bf16_nt(XR + (size_t)m2 * DM, lane); }
            const float rs = row_rs(y);
#pragma unroll
            for (int j = 0; j < 8; ++j) xr.v[j] = xr.v[j] + y.v[j] * rs * ga.v[j];
            st_row_bf16_nt(XR + (size_t)m * DM, lane, xr); const float rs2 = row_rs(xr);
#pragma unroll
            for (int j = 0; j < 8; ++j) xr.v[j] = xr.v[j] * rs2 * gb.v[j];
            { unsigned char* h8 = (unsigned char*)(ws + WS_HN8) + (size_t)m * DM + 4 * lane;
#pragma unroll
              for (int j = 0; j < 8; ++j) *(GAS unsigned*)(h8 + 256 * j) = pg8::pk4_fp8(xr.v[j].x * XG_SCALE, xr.v[j].y * XG_SCALE, xr.v[j].z * XG_SCALE, xr.v[j].w * XG_SCALE); }
            float lg[NE];
#pragma unroll
            for (int e = 0; e < NE; ++e) { float s = 0.f;
#pragma unroll
                for (int j = 0; j < 8; ++j) { const f32x4 w = *(const LAS f32x4*)(wrt + e * DM + 256 * j + 4 * lane); s += (xr.v[j].x * w.x + xr.v[j].y * w.y) + (xr.v[j].z * w.z + xr.v[j].w * w.w); }
                asm volatile("" : "+v"(s) :: "memory");
                lg[e] = wave_sum(s); }
            int e1 = 0; float v1 = lg[0];
#pragma unroll
            for (int e = 1; e < NE; ++e) if (lg[e] > v1) { v1 = lg[e]; e1 = e; }
            int e2 = -1; float v2 = -__builtin_inff();
#pragma unroll
            for (int e = 0; e < NE; ++e) if (e != e1 && lg[e] > v2) { v2 = lg[e]; e2 = e; }
            const float ex = expf(v2 - v1), w1 = 1.0f / (1.0f + ex), w2 = ex * w1;
            if (lane == 0) {
                const unsigned i1 = __hip_atomic_fetch_add((LAS unsigned*)(ldsl + LDSCTL_OFF) + 8 + e1, 1u, __ATOMIC_RELAXED, __HIP_MEMORY_SCOPE_WORKGROUP);
                const unsigned i2 = __hip_atomic_fetch_add((LAS unsigned*)(ldsl + LDSCTL_OFF) + 8 + e2, 1u, __ATOMIC_RELAXED, __HIP_MEMORY_SCOPE_WORKGROUP);
                RTE[m] = (unsigned)e1 | ((unsigned)e2 << 8) | (i1 << 16) | (i2 << 24); RTW[m] = make_float2(w1, w2); }
            y = yn; xr = xn;
        }
        __syncthreads();
        if (tid < NE) { const unsigned c = LCTL[8 + tid]; ctl[CW_CWG + bx * NE + tid] = c; if (c) __hip_atomic_fetch_add(ctl + CW_CNT + tid, c, RLX_AGENT); }
    }
    SEAM(PH_NORM_C);

    int tb[NE + 1];
#pragma unroll
    for (int e = 0; e <= NE; ++e) tb[e] = 0;
    if (hi > PH_NORM_C + 1) {
#pragma unroll
        for (int e = 0; e < NE; ++e) { const unsigned c = __builtin_amdgcn_readfirstlane(__hip_atomic_load(ctl + CW_CNT + e, RLX_AGENT)); tb[e + 1] = tb[e] + (int)((c + 255u) >> 8); }
    }
    const int ttot = tb[NE] < MOE_MAX_TILES ? tb[NE] : MOE_MAX_TILES;

    if (IN(PH_MOE_DISP)) {
        unsigned char* XG = ws + WS_XG; const unsigned char* HN8 = ws + WS_HN8;
        LAS unsigned* part = (LAS unsigned*)ldsl; LAS int* sbase = (LAS int*)(ldsl + 4096);
        { const int e = tid & 7, k = tid >> 3; unsigned s = 0; for (int j = k; j < bx; j += 64) s += ctl[CW_CWG + j * NE + e]; part[k * 8 + e] = s; }
        __syncthreads();
        if (tid < NE) { unsigned s = 0; for (int k = 0; k < 64; ++k) s += part[k * 8 + tid]; sbase[tid] = tb[tid] * 256 + (int)s; }
        __syncthreads();
        for (int i0 = 0; gw + NGW * i0 < MTOK; i0 += 8) {
            const int ml = gw + NGW * (i0 + (lane & 7)); int sa = 0, sb = 0;
            if (lane < 8 && ml < MTOK) { const unsigned re = RTE[ml]; sa = sbase[re & 0xff] + (int)((re >> 16) & 0xff); sb = sbase[(re >> 8) & 0xff] + (int)(re >> 24); SLOT[ml] = make_int2(sa, sb); }
            v4u v[8][2];
#pragma unroll
            for (int u = 0; u < 8; ++u) { const int m = gw + NGW * (i0 + u); if (m < MTOK) { const GAS v4u* src = (const GAS v4u*)(HN8 + (size_t)m * DM) + lane; v[u][0] = src[0]; v[u][1] = src[64]; } }
#pragma unroll
            for (int u = 0; u < 8; ++u) { const int m = gw + NGW * (i0 + u); const int ra = __builtin_amdgcn_readlane(sa, u), rb = __builtin_amdgcn_readlane(sb, u);
                if (m < MTOK) { GAS v4u* da = (GAS v4u*)(XG + (size_t)ra * DM) + lane; GAS v4u* db = (GAS v4u*)(XG + (size_t)rb * DM) + lane;
                    da[0] = v[u][0]; da[64] = v[u][1]; db[0] = v[u][0]; db[64] = v[u][1]; } }
        }
    }
    SEAM(PH_MOE_DISP);

    if (IN(PH_MOE0) && ttot > 0) {
        pg8::Gemm g{(const pg8::bf16_t*)(ws + WS_XG), (const pg8::bf16_t*)(ws + WS_WMGU), 0, 2 * FFE, DM};
        pg8::MoeOrder<false> S{0, ttot, 2 * FFE / 256, G, bx, tb[1], tb[2], tb[3], tb[4], tb[5], tb[6], tb[7]};
        pg8::EpiSwiGLU8 E{ws + WS_H, FFE, H_SCALE};
        pg8::gemm_phase<pg8::EpiSwiGLU8, pg8::MoeOrder<false>, true, true, true, 0x77777777, 0x7B7B7B7B>(ldsl, g, S, E);
    }
    SEAM(PH_MOE0);
    if (IN(PH_MOE0 + 1) && ttot > 0) {
        pg8::Gemm g{(const pg8::bf16_t*)(ws + WS_H), (const pg8::bf16_t*)(ws + WS_WMD), 0, DM, FFE};
        pg8::MoeOrder<true> S{0, ttot, DM / 256, G, bx, tb[1], tb[2], tb[3], tb[4], tb[5], tb[6], tb[7]};
        pg8::EpiBf16Plain E{(pg8::bf16_t*)(ws + WS_Y), DM};
        pg8::gemm_phase<pg8::EpiBf16Plain, pg8::MoeOrder<true>, true, true, true, 0x77777777, 0x7C7C7C7C>(ldsl, g, S, E);
    }
    SEAM(PH_MOE0 + 1);

    if (IN(PH_FINAL)) {
        const bf16* Y = (const bf16*)(ws + WS_Y); const Row8 ga = ld_row_f32(ln_g + 7 * DM, lane);
        int m = gw; int2 sl = make_int2(0, 0), sl2 = sl; float2 w = make_float2(0.f, 0.f), w2 = w; Row8 ya, yb, xr;
        if (m < MTOK) { sl = SLOT[m]; w = RTW[m]; ya = ld_row_bf16_nt(Y + (size_t)sl.x * DM, lane); yb = ld_row_bf16_nt(Y + (size_t)sl.y * DM, lane); xr = ld_row_bf16_nt(XR + (size_t)m * DM, lane); }
        if (m + NGW < MTOK) { sl2 = SLOT[m + NGW]; w2 = RTW[m + NGW]; }
        for (; m < MTOK; m += NGW) { const int m2 = m + NGW, m3 = m + 2 * NGW; Row8 yan = ya, ybn = yb, xn = xr; int2 sl3 = sl2; float2 w3 = w2;
            if (m2 < MTOK) { yan = ld_row_bf16_nt(Y + (size_t)sl2.x * DM, lane); ybn = ld_row_bf16_nt(Y + (size_t)sl2.y * DM, lane); xn = ld_row_bf16_nt(XR + (size_t)m2 * DM, lane); }
            if (m3 < MTOK) { sl3 = SLOT[m3]; w3 = RTW[m3]; }
            Row8 f;
#pragma unroll
            for (int j = 0; j < 8; ++j) f.v[j] = ya.v[j] * w.x + yb.v[j] * w.y;
            const float rs = row_rs(f);
#pragma unroll
            for (int j = 0; j < 8; ++j) xr.v[j] = xr.v[j] + f.v[j] * rs * ga.v[j];
            st_row_f32_nt(xout + (size_t)m * DM, lane, xr);
            ya = yan; yb = ybn; xr = xn; w = w2; sl2 = sl3; w2 = w3; }
    }
#ifdef MK_PROBE_MASK
    { const unsigned long long t_ = rt(); if ((MK_PROBE_MASK >> PH_FINAL) & 1ull) pr_acc += t_ - pr_last;
      if (bx == 0 && tid == 0) { const unsigned long long t0_ = rt(); while (rt() - t0_ < pr_acc) __builtin_amdgcn_s_sleep(8); } }
#endif
#undef IN
#undef SEAM
#undef NORM_AB
#undef LDX_A
#undef LDX_B
}

extern "C" void kernel_launch(void* const* d_in, const int* in_sizes, int n_in, void* d_out, int out_size, void* d_ws, size_t ws_size, hipStream_t stream) {
    static int grid = 0;
    if (grid == 0) {
        if (n_in != 20 || in_sizes[0] != MTOK * DM || out_size != MTOK * DM || ws_size < WS_END) { fprintf(stderr, "kernel_launch: unexpected shapes (n_in %d, ws %zu < %zu?)\n", n_in, ws_size, (size_t)WS_END); grid = -1; return; }
        int dev = 0, cus = 0, per_cu = 0;
        if (hipGetDevice(&dev) != hipSuccess || hipDeviceGetAttribute(&cus, hipDeviceAttributeMultiprocessorCount, dev) != hipSuccess) { grid = -1; return; }
        if (hipFuncSetAttribute((const void*)mk_fwd, hipFuncAttributeMaxDynamicSharedMemorySize, LDS_BYTES) != hipSuccess) { fprintf(stderr, "kernel_launch: hipFuncSetAttribute failed\n"); grid = -1; return; }
        if (hipOccupancyMaxActiveBlocksPerMultiprocessor(&per_cu, (const void*)mk_fwd, NWAVES * 64, LDS_BYTES) != hipSuccess || per_cu < 1) { fprintf(stderr, "kernel_launch: occupancy query says %d blocks per CU\n", per_cu); }
        (void)hipGetLastError();
        grid = cus;
    }
    if (grid < 0) return;
    (void)hipMemsetAsync((char*)d_ws + WS_CTL, 0, CTL_ZERO_BYTES, stream);
    Args a{};
    for (int i = 0; i < 20; ++i) a.in[i] = (const float*)d_in[i];
    a.out = (float*)d_out; a.ws = (unsigned char*)d_ws;
#if MK_N_LAUNCHES == 1
    a.ph_lo = 0; a.ph_hi = PH_COUNT;
    hipLaunchKernelGGL(mk_fwd, dim3(grid), dim3(NWAVES * 64), LDS_BYTES, stream, a);
#else
    for (int p = 0; p < PH_COUNT; ++p) { a.ph_lo = p; a.ph_hi = p + 1; hipLaunchKernelGGL(mk_fwd, dim3(grid), dim3(NWAVES * 64), LDS_BYTES, stream, a); }
#endif
}
```
